# Optimizing an MI355X kernel written in HIP

```python
import jax, jax.numpy as jnp
from jax import lax
import numpy as np

D_MODEL = 1024
BATCH = 16
SEQ = 2048
DEPTH = 1
DEC_BATCH = 16
DEC_SEQ = 64
PAST_LEN = 4096

CHUNK = 64
Q_BLOCK = 128
H_RET = 4
DK_RET = 128
DV_RET = 128
H_FOX = 8
D_FOX = 64
W_RET = H_RET * DV_RET
W_FOX = H_FOX * D_FOX
D_MIX = W_RET + W_FOX
D_IN = 2 * H_RET * DK_RET + 2 * W_RET + 3 * W_FOX + H_FOX
D_FF = ((8 * D_MODEL // 3 + 255) // 256) * 256
ROPE_BASE = 10000.0
NORM_EPS = 1e-6
GN_EPS = 1e-5
NEG_INF = -1e30

kernel_name = 'hybrid_retention_fox_stream_step'


def _rmsnorm(x, g):
    xf = x.astype(jnp.float32)
    r = lax.rsqrt(jnp.mean(xf * xf, axis=-1, keepdims=True) + NORM_EPS)
    return (xf * r * g.astype(jnp.float32)).astype(x.dtype)


def _rotary(x, pos):
    half = x.shape[-1] // 2
    inv = ROPE_BASE ** (-jnp.arange(half, dtype=jnp.float32) / half)
    ang = pos[:, None] * inv[None, :]
    cos = jnp.cos(ang)[None, :, None, :]
    sin = jnp.sin(ang)[None, :, None, :]
    x1, x2 = x[..., :half], x[..., half:]
    return jnp.concatenate([x1 * cos - x2 * sin, x1 * sin + x2 * cos], axis=-1)


def _project(h, w_in, b_f):
    B, T = h.shape[0], h.shape[1]
    z = jnp.einsum('btd,dc->btc', h, w_in).astype(jnp.float32)
    sizes = (H_RET * DK_RET, H_RET * DK_RET, W_RET, W_RET, W_FOX, W_FOX, W_FOX)
    idx = []
    acc = 0
    for s in sizes:
        acc += s
        idx.append(acc)
    q_r, k_r, v_r, g_r, q_f, k_f, v_f, f_logit = jnp.split(z, idx, axis=-1)
    log_f = jax.nn.log_sigmoid(f_logit + b_f.astype(jnp.float32))
    return (q_r.reshape(B, T, H_RET, DK_RET), k_r.reshape(B, T, H_RET, DK_RET),
            v_r.reshape(B, T, H_RET, DV_RET), g_r,
            q_f.reshape(B, T, H_FOX, D_FOX), k_f.reshape(B, T, H_FOX, D_FOX),
            v_f.reshape(B, T, H_FOX, D_FOX), log_f)


def _mixer_inputs(x, pos, g_mix, w_in, b_f):
    h = _rmsnorm(x, g_mix)
    q_r, k_r, v_r, g_r, q_f, k_f, v_f, log_f = _project(h, w_in, b_f)
    q_r = _rotary(q_r, pos) * (DK_RET ** -0.5)
    k_r = _rotary(k_r, pos)
    return q_r, k_r, v_r, g_r, q_f, k_f, v_f, log_f


def _ret_log_gamma():
    return jnp.log1p(-jnp.exp2(-5.0 - jnp.arange(H_RET, dtype=jnp.float32)))


def _ret_intra(q, k, v):
    n = q.shape[-3]
    lg = _ret_log_gamma()
    i = jnp.arange(n, dtype=jnp.float32)
    dec = jnp.exp(lg[:, None, None] * jnp.abs(i[:, None] - i[None, :]))
    s = jnp.einsum('...ihd,...jhd->...hij', q, k) * dec
    return jnp.einsum('...hij,...jhe->...ihe', s, v)


def _ret_inter(q, s_prev):
    n = q.shape[-3]
    lg = _ret_log_gamma()
    i = jnp.arange(n, dtype=jnp.float32)
    qdec = jnp.exp(lg[None, :] * (i[:, None] + 1.0))
    return jnp.einsum('...ihd,...hde->...ihe', q, s_prev) * qdec[:, :, None]


def _ret_update(k, v):
    n = k.shape[-3]
    lg = _ret_log_gamma()
    i = jnp.arange(n, dtype=jnp.float32)
    kdec = jnp.exp(lg[None, :] * (n - 1.0 - i)[:, None])
    return jnp.einsum('...jhd,...jhe->...hde', k * kdec[:, :, None], v)


def _ret_chunk_decay(n):
    return jnp.exp(_ret_log_gamma() * float(n))[:, None, None]


def _retention_prompt(q, k, v):
    B, T = q.shape[0], q.shape[1]
    N = T // CHUNK
    qc = q.reshape(B, N, CHUNK, H_RET, DK_RET)
    kc = k.reshape(B, N, CHUNK, H_RET, DK_RET)
    vc = v.reshape(B, N, CHUNK, H_RET, DV_RET)
    intra = _ret_intra(qc, kc, vc)
    u = _ret_update(kc, vc)
    cdec = _ret_chunk_decay(CHUNK)

    def step(s, u_c):
        return cdec * s + u_c, s

    s0 = jnp.zeros((B, H_RET, DK_RET, DV_RET), jnp.float32)
    s_fin, s_prev = lax.scan(step, s0, jnp.moveaxis(u, 1, 0))
    inter = _ret_inter(qc, jnp.moveaxis(s_prev, 0, 1))
    o = (intra + inter).reshape(B, T, H_RET, DV_RET)
    return o, s_fin


def _retention_sample(q, k, v, s):
    n = q.shape[1]
    o = _ret_intra(q, k, v) + _ret_inter(q, s)
    s_new = _ret_chunk_decay(n) * s + _ret_update(k, v)
    return o, s_new


def _ret_output(o, g_r, gn_gain):
    B, T = o.shape[0], o.shape[1]
    mu = jnp.mean(o, axis=-1, keepdims=True)
    var = jnp.mean(jnp.square(o - mu), axis=-1, keepdims=True)
    on = ((o - mu) * lax.rsqrt(var + GN_EPS)).reshape(B, T, W_RET)
    return on * gn_gain.astype(jnp.float32) * jax.nn.silu(g_r)


def _fox_prompt(q, k, v, log_f):
    T = q.shape[1]
    c = lax.cumsum(log_f, axis=1)
    c_h = jnp.moveaxis(c, 2, 1)
    scale = D_FOX ** -0.5
    outs = []
    for b0 in range(0, T, Q_BLOCK):
        e = b0 + Q_BLOCK
        s = jnp.einsum('bqhd,bkhd->bhqk', q[:, b0:e], k[:, :e]) * scale
        s = s + c_h[:, :, b0:e, None] - c_h[:, :, None, :e]
        causal = (b0 + jnp.arange(Q_BLOCK))[:, None] >= jnp.arange(e)[None, :]
        p = jax.nn.softmax(jnp.where(causal, s, NEG_INF), axis=-1)
        outs.append(jnp.einsum('bhqk,bkhd->bqhd', p, v[:, :e]))
    return jnp.concatenate(outs, axis=1)


def _fox_sample(q, k, v, log_f, cache_k, cache_v, cache_logf):
    n = q.shape[1]
    ck = cache_k.astype(jnp.float32)
    cv = cache_v.astype(jnp.float32)
    clf = cache_logf.astype(jnp.float32)
    P = ck.shape[1]
    scale = D_FOX ** -0.5
    a = lax.cumsum(clf, axis=1, reverse=True) - clf
    bq = lax.cumsum(log_f, axis=1)
    a_h = jnp.moveaxis(a, 2, 1)
    bq_h = jnp.moveaxis(bq, 2, 1)
    s_past = jnp.einsum('bqhd,bkhd->bhqk', q, ck) * scale + bq_h[:, :, :, None] + a_h[:, :, None, :]
    s_new = jnp.einsum('bqhd,bkhd->bhqk', q, k) * scale + bq_h[:, :, :, None] - bq_h[:, :, None, :]
    causal = jnp.arange(n)[:, None] >= jnp.arange(n)[None, :]
    s_new = jnp.where(causal, s_new, NEG_INF)
    p = jax.nn.softmax(jnp.concatenate([s_past, s_new], axis=-1), axis=-1)
    return (jnp.einsum('bhqk,bkhd->bqhd', p[..., :P], cv)
            + jnp.einsum('bhqk,bkhd->bqhd', p[..., P:], v))


def _swiglu(h, w_gate, w_up, w_down):
    g = jnp.einsum('btd,df->btf', h, w_gate)
    u = jnp.einsum('btd,df->btf', h, w_up)
    return jnp.einsum('btf,fd->btd', jax.nn.silu(g) * u, w_down)


def _merge_and_ffn(x, o_r, g_r, o_f, gn_gain, w_out, g_ffn, w_gate, w_up, w_down):
    B, T = x.shape[0], x.shape[1]
    mix = jnp.concatenate([_ret_output(o_r, g_r, gn_gain), o_f.reshape(B, T, W_FOX)], axis=-1)
    x = x + jnp.einsum('btc,cd->btd', mix, w_out.astype(jnp.float32)).astype(x.dtype)
    x = x + _swiglu(_rmsnorm(x, g_ffn), w_gate, w_up, w_down).astype(x.dtype)
    return x


def setup_inputs(seed: int = 0) -> dict:
    key = jax.random.key(seed)
    ks = jax.random.split(key, 20)
    f32 = jnp.float32
    nrm = lambda k, shape, s: jax.random.normal(k, shape, f32) * s
    return {
        'x_prompt': nrm(ks[0], (BATCH, SEQ, D_MODEL), 1.0),
        'x_sample': nrm(ks[1], (DEC_BATCH, DEC_SEQ, D_MODEL), 1.0),
        'cache_fox_k': nrm(ks[2], (DEPTH, DEC_BATCH, PAST_LEN, H_FOX, D_FOX), 1.0),
        'cache_fox_v': nrm(ks[3], (DEPTH, DEC_BATCH, PAST_LEN, H_FOX, D_FOX), 1.0),
        'cache_fox_logf': jax.nn.log_sigmoid(3.0 + nrm(ks[4], (DEPTH, DEC_BATCH, PAST_LEN, H_FOX), 1.0)),
        'state_ret': nrm(ks[5], (DEPTH, DEC_BATCH, H_RET, DK_RET, DV_RET), 2.0),
        'w_in': nrm(ks[6], (DEPTH, D_MODEL, D_IN), D_MODEL ** -0.5),
        'b_forget': 3.0 + nrm(ks[7], (DEPTH, H_FOX), 0.5),
        'ret_gn_gain': 1.0 + nrm(ks[8], (DEPTH, W_RET), 0.01),
        'w_out': nrm(ks[9], (DEPTH, D_MIX, D_MODEL), D_MIX ** -0.5),
        'norm_mix_gain': 1.0 + nrm(ks[10], (DEPTH, D_MODEL), 0.01),
        'norm_ffn_gain': 1.0 + nrm(ks[11], (DEPTH, D_MODEL), 0.01),
        'w_gate': nrm(ks[12], (DEPTH, D_MODEL, D_FF), D_MODEL ** -0.5),
        'w_up': nrm(ks[13], (DEPTH, D_MODEL, D_FF), D_MODEL ** -0.5),
        'w_down': nrm(ks[14], (DEPTH, D_FF, D_MODEL), D_FF ** -0.5),
        'norm_final_gain': 1.0 + nrm(ks[15], (D_MODEL,), 0.01),
    }


def reference(x_prompt, x_sample, cache_fox_k, cache_fox_v, cache_fox_logf, state_ret,
              w_in, b_forget, ret_gn_gain, w_out, norm_mix_gain, norm_ffn_gain,
              w_gate, w_up, w_down, norm_final_gain):
    xp, xs = x_prompt, x_sample
    T = xp.shape[1]
    n = xs.shape[1]
    past_len = cache_fox_k.shape[2]
    pos_p = jnp.arange(T, dtype=jnp.float32)
    pos_s = jnp.arange(n, dtype=jnp.float32) + float(past_len)
    sr_p, kf_p, vf_p, lf_p = [], [], [], []
    sr_s, kf_s, vf_s, lf_s = [], [], [], []
    for l in range(DEPTH):
        q_r, k_r, v_r, g_r, q_f, k_f, v_f, lf = _mixer_inputs(xp, pos_p, norm_mix_gain[l], w_in[l], b_forget[l])
        o_r, s_ret = _retention_prompt(q_r, k_r, v_r)
        o_f = _fox_prompt(q_f, k_f, v_f, lf)
        xp = _merge_and_ffn(xp, o_r, g_r, o_f, ret_gn_gain[l], w_out[l], norm_ffn_gain[l],
                            w_gate[l], w_up[l], w_down[l])
        sr_p.append(s_ret)
        kf_p.append(k_f.astype(x_prompt.dtype))
        vf_p.append(v_f.astype(x_prompt.dtype))
        lf_p.append(lf)
        q_r, k_r, v_r, g_r, q_f, k_f, v_f, lf = _mixer_inputs(xs, pos_s, norm_mix_gain[l], w_in[l], b_forget[l])
        o_r, s_ret = _retention_sample(q_r, k_r, v_r, state_ret[l].astype(jnp.float32))
        o_f = _fox_sample(q_f, k_f, v_f, lf, cache_fox_k[l], cache_fox_v[l], cache_fox_logf[l])
        xs = _merge_and_ffn(xs, o_r, g_r, o_f, ret_gn_gain[l], w_out[l], norm_ffn_gain[l],
                            w_gate[l], w_up[l], w_down[l])
        sr_s.append(s_ret)
        kf_s.append(k_f.astype(x_sample.dtype))
        vf_s.append(v_f.astype(x_sample.dtype))
        lf_s.append(lf)
    y_prompt = _rmsnorm(xp, norm_final_gain)
    y_sample = _rmsnorm(xs, norm_final_gain)
    return (y_prompt, y_sample,
            jnp.stack(sr_p, 0), jnp.stack(kf_p, 0), jnp.stack(vf_p, 0), jnp.stack(lf_p, 0),
            jnp.stack(sr_s, 0), jnp.stack(kf_s, 0), jnp.stack(vf_s, 0), jnp.stack(lf_s, 0))
```

```cpp
#include <hip/hip_runtime.h>
#include <hip/hip_cooperative_groups.h>
#include <hip/hip_bf16.h>
#include <cstdio>
#include <cstdint>
#include <cmath>
namespace cg = cooperative_groups;

constexpr int DM = 1024, NB = 16, TSEQ = 2048, MP = NB * TSEQ, NSMP = 64, MS = NB * NSMP, MTOK = MP + MS, PAST = 4096;
constexpr int DIN = 3592, NZ = 3584, DFF = 2816, NGU = 2 * DFF;
constexpr size_t O_Y = 0, O_SRP = (size_t)MTOK * DM, O_FKP = O_SRP + 1048576, O_FVP = O_FKP + 16777216, O_LFP = O_FVP + 16777216, O_SRS = O_LFP + 262144,
                 O_FKS = O_SRS + 1048576, O_FVS = O_FKS + 524288, O_LFS = O_FVS + 524288, O_END = O_LFS + 8192;
constexpr size_t MiB = 1u << 20;
constexpr size_t WS_CTL = 0, WS_SS1 = 64 * 1024, WS_SS2 = 256 * 1024, CTL_BYTES = 512 * 1024;
constexpr size_t WS_CS = 1 * MiB, WS_CB = 3 * MiB, WS_WIN = 4 * MiB, WS_WO = 11 * MiB, WS_WGU = 13 * MiB, WS_WD = 24 * MiB;
constexpr size_t WS_XN = 32 * MiB, WS_MIX = 98 * MiB, WS_Z = 164 * MiB, WS_H = WS_Z, WS_END = 395 * MiB;
constexpr float C2F = 0.125f * 1.4426950408889634f;

struct Params {
    const float *xp, *xs, *ck, *cv, *clf, *sr, *win, *bfg, *gn, *wout, *gmix, *gffn, *wg, *wu, *wd, *gfin;
    float* out; unsigned char* ws;
};

__device__ __forceinline__ int tid_fresh() { int t = threadIdx.x; asm volatile("" : "+v"(t)); return t; }

__device__ __forceinline__ Params fresh_params(const Params& p) {
    Params q = p;
    asm volatile("" : "+s"(q.out), "+s"(q.ws), "+s"(q.ck), "+s"(q.cv), "+s"(q.clf), "+s"(q.sr), "+s"(q.gn));
    return q;
}

namespace pg8 {
#define PG8_LAS __attribute__((address_space(3)))
typedef unsigned short bf16_t;
typedef short bf16x8 __attribute__((ext_vector_type(8)));
typedef float f32x4 __attribute__((ext_vector_type(4)));
typedef unsigned u32x4 __attribute__((ext_vector_type(4)));
constexpr int BM = 256, BK = 64, HALF = 128, HTB = HALF * BK * 2  , STAGE_BYTES = 8 * HTB, NXCD = 8, WGM = 8;

__host__ __device__ __forceinline__ int lds_byte(int r, int c) { const int st = (r >> 4) * 2 + (c >> 5), rr = r & 15, cc = c & 31, ob = rr * 64 + cc * 2; return st * 1024 + (ob ^ (((ob >> 9) & 1) << 5)); }
__host__ __device__ __forceinline__ void stage_rc(int b, int& R, int& C) { const int st = b / 1024, sb = b % 1024, swz = sb ^ (((sb >> 9) & 1) << 5); R = (st >> 1) * 16 + swz / 64; C = (st & 1) * 32 + (swz % 64) / 2; }
__host__ __device__ __forceinline__ int perm32(int rho) { const int n = rho >> 4, i = rho & 15; return 8 * (i >> 2) + 4 * n + (i & 3); }

struct Unit { int pm, pn; };
struct Gemm { const bf16_t* A; const bf16_t* Bt; int M, N, K; };

struct StaticOrder {
    int nM, nN, nwg, G, c;
    __host__ __device__ void init(int M, int N, int G_, int c_) { nM = M / BM; nN = N / BM; nwg = nM * nN; G = G_; c = c_; }
    __host__ __device__ bool next(int i, Unit& u) const {
        const long L = (long)i * G + c; if (L >= nwg) return false;
        int wgid = (int)L; { const int q = nwg / NXCD, r = nwg % NXCD, xcd = wgid % NXCD, off = wgid / NXCD; wgid = (xcd < r ? xcd * (q + 1) : r * (q + 1) + (xcd - r) * q) + off; }
        const int nig = WGM * nN, gid = wgid / nig, fm = gid * WGM, gsz = (nM - fm) < WGM ? (nM - fm) : WGM;
        u.pm = fm + ((wgid % nig) % gsz); u.pn = (wgid % nig) / gsz; return true;
    }
    __device__ __forceinline__ void a_ready(const Unit&) const {}
    __device__ __forceinline__ void done(const Unit&) const {}
};

typedef float f32x2 __attribute__((ext_vector_type(2)));
typedef __bf16 bf16x2_t __attribute__((ext_vector_type(2)));
typedef unsigned u32x2 __attribute__((ext_vector_type(2)));
__device__ __forceinline__ unsigned cvt_pk_bf16(float lo, float hi) { f32x2 v = {lo, hi}; bf16x2_t b = __builtin_convertvector(v, bf16x2_t); return __builtin_bit_cast(unsigned, b); }
__device__ __forceinline__ float silu_f(float x) { return x * __builtin_amdgcn_rcpf(1.f + __builtin_amdgcn_exp2f(x * -1.4426950408889634f)); }

struct EpiInProj {
    static constexpr bool PERM = true, AFTER_DRAIN = false;
    bf16_t* Z; float* out; const float* cs;
    __device__ __forceinline__ void operator()(const f32x4 (&acc)[2][2][4][2], const Unit& u, int wr, int wc, int fr, int fq) const {
        const int pn = u.pn, row0 = u.pm * BM + wr * 64 + fr; const bool prompt = u.pm < (MP / BM);
        if (pn < 4) {
            const float sc = pn < 2 ? 0.08838834764831845f : 1.f; const int d0 = 16 * wc + 4 * fq;
#pragma unroll
            for (int ai = 0; ai < 2; ++ai)
#pragma unroll
                for (int m = 0; m < 4; ++m) { const int row = row0 + ai * HALF + m * 16; const int tix = prompt ? (row & (TSEQ - 1)) : TSEQ + ((row - MP) & (NSMP - 1));
                    const float* cr = cs + (size_t)tix * 128 + 2 * d0; const f32x4 c01 = *(const f32x4*)cr, c23 = *(const f32x4*)(cr + 4);
                    bf16_t* zrow = Z + (size_t)row * NZ + pn * BM + d0;
#pragma unroll
                    for (int bj = 0; bj < 2; ++bj) { const f32x4 v0 = acc[ai][bj][m][0], v1 = acc[ai][bj][m][1];
                        const float a0 = (v0[0] * c01[0] - v0[1] * c01[1]) * sc, b0 = (v0[0] * c01[1] + v0[1] * c01[0]) * sc;
                        const float a1 = (v0[2] * c01[2] - v0[3] * c01[3]) * sc, b1 = (v0[2] * c01[3] + v0[3] * c01[2]) * sc;
                        const float a2 = (v1[0] * c23[0] - v1[1] * c23[1]) * sc, b2 = (v1[0] * c23[1] + v1[1] * c23[0]) * sc;
                        const float a3 = (v1[2] * c23[2] - v1[3] * c23[3]) * sc, b3 = (v1[2] * c23[3] + v1[3] * c23[2]) * sc;
                        u32x2 w1, w2; w1.x = cvt_pk_bf16(a0, a1); w1.y = cvt_pk_bf16(a2, a3); w2.x = cvt_pk_bf16(b0, b1); w2.y = cvt_pk_bf16(b2, b3);
                        *(u32x2*)(zrow + bj * HALF) = w1; *(u32x2*)(zrow + bj * HALF + 64) = w2; } }
        } else {
            const float sc = (pn == 8 || pn == 9) ? C2F : 1.f; const int cw = wc * 32 + 8 * fq;
            float* fo = nullptr; size_t fstride = 512;
            if (pn >= 10) { const bool isv = pn >= 12; const int cb = (pn - (isv ? 12 : 10)) * BM + cw;
                fo = prompt ? out + (isv ? O_FVP : O_FKP) + (size_t)row0 * 512 + cb : out + (isv ? O_FVS : O_FKS) + (size_t)(row0 - MP) * 512 + cb; }
#pragma unroll
            for (int ai = 0; ai < 2; ++ai)
#pragma unroll
                for (int m = 0; m < 4; ++m) { bf16_t* rowp = Z + (size_t)(row0 + ai * HALF + m * 16) * NZ + pn * BM + cw; float* fr_ = fo + (size_t)(ai * HALF + m * 16) * fstride;
#pragma unroll
                    for (int bj = 0; bj < 2; ++bj) { const f32x4 v0 = acc[ai][bj][m][0] * sc, v1 = acc[ai][bj][m][1] * sc;
                        u32x4 w; w.x = cvt_pk_bf16(v0[0], v0[1]); w.y = cvt_pk_bf16(v0[2], v0[3]); w.z = cvt_pk_bf16(v1[0], v1[1]); w.w = cvt_pk_bf16(v1[2], v1[3]);
                        *(u32x4*)(rowp + bj * HALF) = w;
                        if (fo) { *(f32x4*)(fr_ + bj * HALF) = v0; *(f32x4*)(fr_ + bj * HALF + 4) = v1; } } }
        }
    }
};
struct EpiResid {
    static constexpr bool PERM = false, AFTER_DRAIN = false;
    const float* xp; const float* xs; float* Y; bf16_t* Yb; float* ss;
    __device__ __forceinline__ void operator()(const f32x4 (&acc)[2][2][4][2], const Unit& u, int wr, int wc, int fr, int fq) const {
        const int row0 = u.pm * BM + wr * 64 + fr, col0 = u.pn * BM + wc * 32 + 4 * fq; const bool prompt = u.pm < (MP / BM);
#pragma unroll
        for (int ai = 0; ai < 2; ++ai)
#pragma unroll
            for (int m = 0; m < 4; ++m) { const int row = row0 + ai * HALF + m * 16; float* yr = Y + (size_t)row * DM + col0;
                const float* br = xp ? (prompt ? xp + (size_t)row * DM + col0 : xs + (size_t)(row - MP) * DM + col0) : yr; float s = 0.f;
#pragma unroll
                for (int bj = 0; bj < 2; ++bj)
#pragma unroll
                    for (int n = 0; n < 2; ++n) { const int co = bj * HALF + n * 16; const f32x4 v = acc[ai][bj][m][n] + *(const f32x4*)(br + co); *(f32x4*)(yr + co) = v;
                        s += (v[0] * v[0] + v[1] * v[1]) + (v[2] * v[2] + v[3] * v[3]);
                        if (Yb) { u32x2 w; w.x = cvt_pk_bf16(v[0], v[1]); w.y = cvt_pk_bf16(v[2], v[3]); *(u32x2*)(Yb + (size_t)row * DM + col0 + co) = w; } }
                s += __shfl_xor(s, 16); s += __shfl_xor(s, 32);
                if (fq == 0) atomicAdd(ss + row, s); }
    }
};
struct EpiGateUp {
    static constexpr bool PERM = true, AFTER_DRAIN = false;
    bf16_t* H; const float* ss;
    __device__ __forceinline__ void operator()(const f32x4 (&acc)[2][2][4][2], const Unit& u, int wr, int wc, int fr, int fq) const {
        const int row0 = u.pm * BM + wr * 64 + fr, f0 = u.pn * 128 + wc * 16 + 4 * fq;
#pragma unroll
        for (int ai = 0; ai < 2; ++ai)
#pragma unroll
            for (int m = 0; m < 4; ++m) { const int row = row0 + ai * HALF + m * 16; const float r = 1.0f / sqrtf(ss[row] * (1.0f / DM) + 1e-6f);
#pragma unroll
                for (int bj = 0; bj < 2; ++bj) { const f32x4 v0 = acc[ai][bj][m][0] * r, v1 = acc[ai][bj][m][1] * r;
                    u32x2 w; w.x = cvt_pk_bf16(silu_f(v0[0]) * v0[1], silu_f(v0[2]) * v0[3]); w.y = cvt_pk_bf16(silu_f(v1[0]) * v1[1], silu_f(v1[2]) * v1[3]);
                    *(u32x2*)(H + (size_t)row * DFF + f0 + bj * 64) = w; } }
    }
};

template <class Epi, class Sched, bool ALIGN_EPI = false, bool SP2 = false>
__device__ __forceinline__ void gemm_phase(PG8_LAS unsigned char* lds, const Gemm g, const Sched& S, const Epi& E) {
    const int tid = tid_fresh(), wid = __builtin_amdgcn_readfirstlane(tid >> 6), lane = tid & 63, wr = wid >> 2, wc = wid & 3, fr = lane & 15, fq = lane >> 4;
    const int K = g.K, nt = K / BK;
    unsigned voffA[2], voffB[2];
#pragma unroll
    for (int i = 0; i < 2; ++i) { int R, C; stage_rc(tid * 16 + i * 8192, R, C); const int Rb = Epi::PERM ? ((R & ~31) + perm32(R & 31)) : R;
        voffA[i] = (unsigned)(R * K + C) * 2u; voffB[i] = (unsigned)(Rb * K + C) * 2u; }
    const size_t kstep = (size_t)(BK * 2);
    const size_t hstep = (size_t)HALF * K * 2;
    const size_t tstep = 2 * hstep;
    const unsigned ldsw = (unsigned)wid * 1024u;
    const int aoff = lds_byte(wr * 64 + fr, fq * 8), boff = lds_byte(wc * 32 + fr, fq * 8);
#define PG8_SA(b, h) (((b) * 2 + (h)) * HTB)
#define PG8_SB(b, h) ((4 + (b) * 2 + (h)) * HTB)
#define PG8_STAGE(bufoff, gbase, voff) do { _Pragma("unroll") for (int _i = 0; _i < 2; ++_i) \
        __builtin_amdgcn_global_load_lds((const unsigned*)((const char*)(gbase) + (voff)[_i]), (PG8_LAS unsigned*)(lds + (bufoff) + ldsw + _i * 8192), 16, 0, 0); } while (0)
#define PG8_LDA(dst, b, h) do { _Pragma("unroll") for (int m = 0; m < 4; ++m) _Pragma("unroll") for (int k = 0; k < 2; ++k) dst[m][k] = *(const PG8_LAS bf16x8*)(lds + PG8_SA(b, h) + aoff + m * 2048 + k * 1024); } while (0)
#define PG8_LDB(dst, b, h) do { _Pragma("unroll") for (int n = 0; n < 2; ++n) _Pragma("unroll") for (int k = 0; k < 2; ++k) dst[n][k] = *(const PG8_LAS bf16x8*)(lds + PG8_SB(b, h) + boff + n * 2048 + k * 1024); } while (0)
#define PG8_MMA(ai, bj, At, Bt) do { __builtin_amdgcn_s_setprio(1); _Pragma("unroll") for (int m = 0; m < 4; ++m) _Pragma("unroll") for (int n = 0; n < 2; ++n) _Pragma("unroll") for (int k = 0; k < 2; ++k) \
        acc[ai][bj][m][n] = __builtin_amdgcn_mfma_f32_16x16x32_bf16(Bt[n][k], At[m][k], acc[ai][bj][m][n], 0, 0, 0); __builtin_amdgcn_s_setprio(0); } while (0)
#define PG8_WAIT_V(n) asm volatile("s_waitcnt vmcnt(" #n ")" ::: "memory")
#define PG8_WAIT_L(n) asm volatile("s_waitcnt lgkmcnt(" #n ")" ::: "memory")
#define PG8_BAR __builtin_amdgcn_s_barrier()
#define PG8_SCHED __builtin_amdgcn_sched_barrier(0)
    Unit cur, nxt; int ui = 0;
    if (!S.next(0, cur)) return;
    f32x4 acc[2][2][4][2];
#pragma unroll
    for (int a = 0; a < 2; ++a)
#pragma unroll
        for (int b = 0; b < 2; ++b)
#pragma unroll
            for (int m = 0; m < 4; ++m)
#pragma unroll
                for (int n = 0; n < 2; ++n) acc[a][b][m][n] = (f32x4){0.f, 0.f, 0.f, 0.f};
    bf16x8 At[4][2], B0[2][2], B1[2][2];
    const char* cA = (const char*)g.A + (size_t)cur.pm * tstep; const char* cB = (const char*)g.Bt + (size_t)cur.pn * tstep;
    S.a_ready(cur);
    if constexpr (SP2) {
        PG8_STAGE(PG8_SB(0, 0), cB, voffB); PG8_STAGE(PG8_SB(0, 1), cB + hstep, voffB); PG8_STAGE(PG8_SA(0, 0), cA, voffA); PG8_STAGE(PG8_SA(0, 1), cA + hstep, voffA);
        if (wr == 1) PG8_BAR;
        PG8_WAIT_V(2); PG8_BAR;
        PG8_STAGE(PG8_SB(1, 0), cB + kstep, voffB); PG8_STAGE(PG8_SA(1, 0), cA + kstep, voffA); PG8_STAGE(PG8_SB(1, 1), cB + hstep + kstep, voffB);
        PG8_WAIT_V(6); PG8_BAR;
    } else {
        PG8_STAGE(PG8_SB(0, 0), cB, voffB); PG8_STAGE(PG8_SA(0, 0), cA, voffA); PG8_STAGE(PG8_SB(0, 1), cB + hstep, voffB); PG8_STAGE(PG8_SA(0, 1), cA + hstep, voffA);
        if (wr == 1) PG8_BAR;
        PG8_WAIT_V(4); PG8_BAR;
        PG8_STAGE(PG8_SB(1, 0), cB + kstep, voffB); PG8_STAGE(PG8_SA(1, 0), cA + kstep, voffA); PG8_STAGE(PG8_SB(1, 1), cB + hstep + kstep, voffB);
        PG8_WAIT_V(6); PG8_BAR;
    }
    for (;;) {
        const bool has_next = S.next(ui + 1, nxt);
        const char* nA = has_next ? (const char*)g.A + (size_t)nxt.pm * tstep : cA; const char* nB = has_next ? (const char*)g.Bt + (size_t)nxt.pn * tstep : cB;
        for (int t = 0; t < nt; t += 2) {
            const bool last = (t == nt - 2);
            const char* a1 = cA + (size_t)(t + 1) * kstep;
            const char* a2 = last ? nA : cA + (size_t)(t + 2) * kstep; const char* b2 = last ? nB : cB + (size_t)(t + 2) * kstep;
            const char* a3 = a2 + kstep; const char* b3 = b2 + kstep;
            if (last && has_next) S.a_ready(nxt);
            if constexpr (SP2) {
            PG8_LDB(B0, 0, 0); PG8_LDB(B1, 0, 1); PG8_SCHED; PG8_LDA(At, 0, 0); PG8_STAGE(PG8_SA(1, 1), a1 + hstep, voffA);
            PG8_WAIT_V(8); PG8_WAIT_L(0); PG8_BAR; PG8_MMA(0, 0, At, B0); PG8_MMA(0, 1, At, B1); PG8_BAR; PG8_SCHED;
            PG8_LDA(At, 0, 1); PG8_STAGE(PG8_SB(0, 0), b2, voffB); PG8_STAGE(PG8_SB(0, 1), b2 + hstep, voffB); PG8_STAGE(PG8_SA(0, 0), a2, voffA);
            PG8_WAIT_V(8); PG8_WAIT_L(0); PG8_BAR; PG8_MMA(1, 0, At, B0); PG8_MMA(1, 1, At, B1); PG8_BAR; PG8_SCHED;
            PG8_LDB(B0, 1, 0); PG8_LDB(B1, 1, 1); PG8_SCHED; PG8_LDA(At, 1, 0); PG8_STAGE(PG8_SA(0, 1), a2 + hstep, voffA);
            PG8_WAIT_V(8); PG8_WAIT_L(0); PG8_BAR; PG8_MMA(0, 0, At, B0); PG8_MMA(0, 1, At, B1); PG8_BAR; PG8_SCHED;
            PG8_LDA(At, 1, 1); PG8_STAGE(PG8_SB(1, 0), b3, voffB); PG8_STAGE(PG8_SB(1, 1), b3 + hstep, voffB); PG8_STAGE(PG8_SA(1, 0), a3, voffA);
            PG8_WAIT_V(8); PG8_WAIT_L(0); PG8_BAR; PG8_MMA(1, 0, At, B0); PG8_MMA(1, 1, At, B1); PG8_BAR; PG8_SCHED;
            } else {
            PG8_LDB(B0, 0, 0); PG8_SCHED; PG8_LDA(At, 0, 0); PG8_STAGE(PG8_SA(1, 1), a1 + hstep, voffA);
            PG8_WAIT_L(8); PG8_BAR; PG8_WAIT_L(0); PG8_MMA(0, 0, At, B0); PG8_BAR; PG8_SCHED;
            PG8_LDB(B1, 0, 1); PG8_STAGE(PG8_SB(0, 0), b2, voffB);
            PG8_BAR; PG8_WAIT_L(0); PG8_MMA(0, 1, At, B1); PG8_BAR;
            PG8_LDA(At, 0, 1); PG8_STAGE(PG8_SA(0, 0), a2, voffA);
            PG8_BAR; PG8_WAIT_L(0); PG8_MMA(1, 0, At, B0); PG8_BAR; PG8_SCHED;
            PG8_STAGE(PG8_SB(0, 1), b2 + hstep, voffB);
            PG8_WAIT_V(6); PG8_BAR; PG8_MMA(1, 1, At, B1); PG8_BAR;
            PG8_LDB(B0, 1, 0); PG8_SCHED; PG8_LDA(At, 1, 0); PG8_STAGE(PG8_SA(0, 1), a2 + hstep, voffA);
            PG8_WAIT_L(8); PG8_BAR; PG8_WAIT_L(0); PG8_MMA(0, 0, At, B0); PG8_BAR; PG8_SCHED;
            PG8_LDB(B1, 1, 1); PG8_STAGE(PG8_SB(1, 0), b3, voffB);
            PG8_BAR; PG8_WAIT_L(0); PG8_MMA(0, 1, At, B1); PG8_BAR;
            PG8_LDA(At, 1, 1); PG8_STAGE(PG8_SA(1, 0), a3, voffA);
            PG8_BAR; PG8_WAIT_L(0); PG8_MMA(1, 0, At, B0); PG8_BAR; PG8_SCHED;
            PG8_STAGE(PG8_SB(1, 1), b3 + hstep, voffB);
            PG8_WAIT_V(6); PG8_BAR; PG8_MMA(1, 1, At, B1); PG8_BAR;
            }
        }
        if constexpr (ALIGN_EPI) { if (wr == 0) PG8_BAR; }
        if constexpr (!Epi::AFTER_DRAIN) { E(acc, cur, wr, wc, fr, fq); S.done(cur); }
        if (!has_next) break;
#pragma unroll
        for (int a = 0; a < 2; ++a)
#pragma unroll
            for (int b = 0; b < 2; ++b)
#pragma unroll
                for (int m = 0; m < 4; ++m)
#pragma unroll
                    for (int n = 0; n < 2; ++n) acc[a][b][m][n] = (f32x4){0.f, 0.f, 0.f, 0.f};
        cur = nxt; cA = nA; cB = nB; ++ui;
        if constexpr (ALIGN_EPI) { if (wr == 1) PG8_BAR; }
    }
    PG8_WAIT_V(0);
    if constexpr (!ALIGN_EPI) { if (wr == 0) PG8_BAR; }
    PG8_BAR;
    if constexpr (Epi::AFTER_DRAIN) { E.fused(acc, cur, wr, wc, fr, fq, lds, wid, lane); S.done(cur); }
#undef PG8_SA
#undef PG8_SB
#undef PG8_STAGE
#undef PG8_LDA
#undef PG8_LDB
#undef PG8_MMA
#undef PG8_WAIT_V
#undef PG8_WAIT_L
#undef PG8_BAR
#undef PG8_SCHED
}
}
#include <hip/hip_bf16.h>
#include <cmath>
namespace attn_body {
using bf16=__hip_bfloat16;
using bf16x8=__attribute__((ext_vector_type(8)))short;
using s16x4=__attribute__((ext_vector_type(4)))short;
using f32x16=__attribute__((ext_vector_type(16)))float;
using u32x4=__attribute__((ext_vector_type(4)))unsigned;
using f32x4b=__attribute__((ext_vector_type(4)))float;
constexpr int BATCH=16,NHEAD=8,SEQ=2048,D=64,PQ=3584,PO=1024;
constexpr int NW=8,QBLK=32,QB=QBLK*NW,KVBLK=64,NQB=SEQ/QB;
constexpr int ATTN_UNIT_ROWS=QB;
__device__ __forceinline__ int crow(int r,int hi){return (r&3)+8*(r>>2)+4*hi;}
#define SBAR() __builtin_amdgcn_sched_barrier(0)
__device__ __forceinline__ void cmask(f32x16&p0,f32x16&p1,int jb,int qrel,int hi){
  const float NEG=-INFINITY; int kb=64*jb+4*hi;
  #pragma unroll
  for(int r=0;r<16;++r){int kv=kb+(r&3)+8*(r>>2); if(kv>qrel)p0[r]=NEG; if(kv+32>qrel)p1[r]=NEG;}
}

constexpr int NSLOT=3, SLOTB=8192;
constexpr int LDS_K=0, LDS_V=NSLOT*SLOTB, LDS_WS=2*NSLOT*SLOTB, LDS_OST=LDS_WS+NW*64*4, LDS_BIAS=LDS_OST+NW*4096, LDS_BYTES=LDS_BIAS+SEQ*4;
constexpr float C2=0.125f*1.4426950408889634f;
__device__ __forceinline__ void glds16(const void*gsrc,unsigned lds_dst){unsigned keep;
  asm volatile("s_mov_b32 %0, m0\n\ts_mov_b32 m0, %2\n\ts_nop 0\n\tglobal_load_lds_dwordx4 %1, off\n\ts_mov_b32 m0, %0":"=&s"(keep):"v"(gsrc),"s"(lds_dst):"memory");}
__device__ __forceinline__ float max3f(float a,float b,float c){float r;asm("v_max3_f32 %0, %1, %2, %3":"=v"(r):"v"(a),"v"(b),"v"(c));return r;}
__device__ __forceinline__ float max2f(float a,float b){float r;asm("v_max_f32_e32 %0, %1, %2":"=v"(r):"v"(a),"v"(b));return r;}
__device__ __forceinline__ float fadd_s(float a,float b){float r;asm("v_add_f32_e32 %0, %1, %2":"=v"(r):"v"(a),"v"(b));return r;}
__device__ __forceinline__ float fsub_s(float a,float b){float r;asm("v_sub_f32_e32 %0, %1, %2":"=v"(r):"v"(a),"v"(b));return r;}
typedef float f32x2_t __attribute__((ext_vector_type(2))); typedef __bf16 bf16x2_t __attribute__((ext_vector_type(2)));
__device__ __forceinline__ unsigned cvtpk_s(float lo,float hi){f32x2_t v={lo,hi};bf16x2_t b=__builtin_convertvector(v,bf16x2_t);return __builtin_bit_cast(unsigned,b);}
#define WAIT_BAR(N) asm volatile("s_waitcnt vmcnt(" #N ") lgkmcnt(0)\n\ts_barrier":::"memory")

__device__ __forceinline__ void qkt(f32x16&p0,f32x16&p1,const char*Kslot,const bf16x8*qr,const f32x16&negm,int r32,int hi){
  const char*kb=Kslot+hi*1024+r32*16;
  #pragma unroll
  for(int d0=0;d0<4;++d0){
    const bf16x8 b0=*reinterpret_cast<const bf16x8*>(kb+d0*2048);
    const bf16x8 b1=*reinterpret_cast<const bf16x8*>(kb+d0*2048+512);
    if(d0==0){p0=__builtin_amdgcn_mfma_f32_32x32x16_bf16(b0,qr[0],negm,0,0,0);p1=__builtin_amdgcn_mfma_f32_32x32x16_bf16(b1,qr[0],negm,0,0,0);}
    else{p0=__builtin_amdgcn_mfma_f32_32x32x16_bf16(b0,qr[d0],p0,0,0,0);p1=__builtin_amdgcn_mfma_f32_32x32x16_bf16(b1,qr[d0],p1,0,0,0);}}
}
typedef __attribute__((address_space(3))) const char* lds_cptr;
typedef short v4i16_t __attribute__((ext_vector_type(4)));
__device__ __forceinline__ void kload8(bf16x8*kf,lds_cptr kp){
  kf[0]=*(const __attribute__((address_space(3))) bf16x8*)(kp);      kf[1]=*(const __attribute__((address_space(3))) bf16x8*)(kp+512);
  kf[2]=*(const __attribute__((address_space(3))) bf16x8*)(kp+2048); kf[3]=*(const __attribute__((address_space(3))) bf16x8*)(kp+2560);
  kf[4]=*(const __attribute__((address_space(3))) bf16x8*)(kp+4096); kf[5]=*(const __attribute__((address_space(3))) bf16x8*)(kp+4608);
  kf[6]=*(const __attribute__((address_space(3))) bf16x8*)(kp+6144); kf[7]=*(const __attribute__((address_space(3))) bf16x8*)(kp+6656);
}
__device__ __forceinline__ void kload2(bf16x8*kf,lds_cptr kp,int j){ kf[2*j]=*(const __attribute__((address_space(3))) bf16x8*)(kp+j*2048); kf[2*j+1]=*(const __attribute__((address_space(3))) bf16x8*)(kp+j*2048+512); }
__device__ __forceinline__ s16x4 vtr(lds_cptr p){ return __builtin_bit_cast(s16x4,__builtin_amdgcn_ds_read_tr16_b64_v4i16((__attribute__((address_space(3))) v4i16_t*)p)); }
__device__ __forceinline__ float rowmax(const f32x16&p0,const f32x16&p1){
  float a=max3f(p0[0],p0[1],p1[0]),b=max3f(p0[2],p0[3],p1[1]);a=max3f(a,p1[2],p1[3]);
  #pragma unroll
  for(int r=4;r<16;r+=4){a=max3f(a,p0[r],p0[r+1]);b=max3f(b,p0[r+2],p0[r+3]);a=max3f(a,p1[r],p1[r+1]);b=max3f(b,p1[r+2],p1[r+3]);}
  const float m=max2f(a,b);
  auto rr=__builtin_amdgcn_permlane32_swap(__float_as_uint(m),__float_as_uint(m),false,false);
  return max2f(__uint_as_float(rr[0]),__uint_as_float(rr[1]));
}
__device__ __forceinline__ void pv(f32x16*o,int vb,bf16x8 pa0,bf16x8 pa1,bf16x8 pa2,bf16x8 pa3){
  #pragma unroll
  for(int d0=0;d0<2;++d0){s16x4 lo[4],hi[4];
    #pragma unroll
    for(int ks=0;ks<4;++ks){
      asm volatile("ds_read_b64_tr_b16 %0,%1 offset:%c2":"=&v"(lo[ks]):"v"(vb),"i"(d0*4096+ks*1024):"memory");
      asm volatile("ds_read_b64_tr_b16 %0,%1 offset:%c2":"=&v"(hi[ks]):"v"(vb),"i"(d0*4096+ks*1024+512):"memory");}
    asm volatile("s_waitcnt lgkmcnt(0)":::"memory");SBAR();
    #define PK(k) (bf16x8){lo[k][0],lo[k][1],lo[k][2],lo[k][3],hi[k][0],hi[k][1],hi[k][2],hi[k][3]}
    o[d0]=__builtin_amdgcn_mfma_f32_32x32x16_bf16(pa0,PK(0),o[d0],0,0,0);
    o[d0]=__builtin_amdgcn_mfma_f32_32x32x16_bf16(pa1,PK(1),o[d0],0,0,0);
    o[d0]=__builtin_amdgcn_mfma_f32_32x32x16_bf16(pa2,PK(2),o[d0],0,0,0);
    o[d0]=__builtin_amdgcn_mfma_f32_32x32x16_bf16(pa3,PK(3),o[d0],0,0,0);
    #undef PK
  }
}

#ifndef ATTN_STORE16
#define ATTN_STORE16(p,v) (*(u32x4*)(p)=(v))
#endif
template<int THRL> __device__ __forceinline__ void attn_unit(int b,int h,int qb,const bf16*Q,const bf16*__restrict__ K,const bf16*__restrict__ V,bf16*O,const float*__restrict__ CB,char*shm){
  const int tid=tid_fresh(),lane=tid&63,r32=lane&31,hi=lane>>5; const int wid=__builtin_amdgcn_readfirstlane(tid>>6);
  const long rowbase=(long)b*SEQ; const int q0=qb*QB;
  const bf16*Qw=Q+(rowbase+q0+wid*QBLK)*PQ+h*D;
  const bf16*Kh=K+rowbase*PQ+h*D,*Vh=V+rowbase*PQ+h*D;
  const unsigned lds0=(unsigned)(uintptr_t)shm;
  float*wsf=(float*)(shm+LDS_WS)+wid*64;
  const bf16*ksrc=Kh+(long)lane*PQ+wid*8;
  const bf16*vsrc=Vh+(long)(16*(wid&3)+(lane>>2))*PQ+(wid>>2)*32+(lane&3)*8;
  const unsigned kdst=lds0+LDS_K+wid*1024, vdst=lds0+LDS_V+wid*1024;
  #define DMA_K(t,slot) glds16(ksrc+(long)(t)*KVBLK*PQ,(unsigned)__builtin_amdgcn_readfirstlane(kdst+(slot)))
  #define DMA_V(t,slot) glds16(vsrc+(long)(t)*KVBLK*PQ,(unsigned)__builtin_amdgcn_readfirstlane(vdst+(slot)))
  const int vb0=(int)(lds0+LDS_V)+((lane>>4)&1)*32+(lane&3)*8+(4*hi+((lane&15)>>2))*64;
  const char*Kbase=shm+LDS_K; bf16x8 kf[8];
  const lds_cptr shm3=(lds_cptr)shm; const lds_cptr kp0=shm3+LDS_K+hi*1024+r32*16; const lds_cptr vp0=shm3+LDS_V+((lane>>4)&1)*32+(lane&3)*8+(4*hi+((lane&15)>>2))*64;
  const int NT=(q0+QB)/KVBLK;
  { const float*cb=CB+(long)(b*NHEAD+h)*SEQ; float*bl=(float*)(shm+LDS_BIAS); for(int i=tid;i<NT*KVBLK;i+=NW*64)bl[i]=cb[i]*(-1.4426950408889634f); }
  const lds_cptr bp0=(lds_cptr)shm+LDS_BIAS+hi*16;
  #define KBIAS(P0,P1,t) do{ const lds_cptr bp_=bp0+(t)*256; _Pragma("unroll") for(int g_=0;g_<4;++g_){ const f32x4b a_=*(const __attribute__((address_space(3))) f32x4b*)(bp_+g_*32); const f32x4b c_=*(const __attribute__((address_space(3))) f32x4b*)(bp_+128+g_*32); \
      P0[4*g_]+=a_[0];P0[4*g_+1]+=a_[1];P0[4*g_+2]+=a_[2];P0[4*g_+3]+=a_[3]; P1[4*g_]+=c_[0];P1[4*g_+1]+=c_[1];P1[4*g_+2]+=c_[2];P1[4*g_+3]+=c_[3]; } }while(0)
  DMA_K(0,0);DMA_V(0,0);DMA_K(1,SLOTB);
  bf16x8 qr[4];
  #pragma unroll
  for(int d0=0;d0<4;++d0)qr[d0]=*reinterpret_cast<const bf16x8*>(&Qw[(long)r32*PQ+d0*16+hi*8]);
  float mhat=0.f,l_reg=0.f;f32x16 o[2];o[0]=f32x16{};o[1]=f32x16{};f32x16 negm=f32x16{};asm volatile("":"+v"(negm));
  const int qrel=wid*QBLK+r32;
  #define CMASK(P0,P1,t) do{int jb_=(t)-(NT-4); if(jb_>=0)cmask(P0,P1,jb_,qrel,hi);}while(0)
  bool resc=false;
  #define START(P0,P1) do{ const float rm=rowmax(P0,P1); resc=false; \
    { const float dl=rm; mhat=fadd_s(mhat,dl); \
      _Pragma("unroll") for(int r=0;r<16;++r){P0[r]=fsub_s(P0[r],dl);P1[r]=fsub_s(P1[r],dl);} \
      _Pragma("unroll") for(int r=0;r<16;++r)negm[r]=-mhat; asm volatile("":"+v"(negm)); } \
    _Pragma("unroll") for(int r=0;r<16;++r)P0[r]=__builtin_amdgcn_exp2f(P0[r]); }while(0)
  #define RESC() do{ if(resc){ asm volatile("s_waitcnt lgkmcnt(0)":::"memory"); \
      _Pragma("unroll") for(int d_=0;d_<2;++d_) _Pragma("unroll") for(int r=0;r<16;++r)o[d_][r]*=wsf[crow(r,hi)]; } }while(0)
  f32x16 pA0,pA1,pB0,pB1;
  int sl_prev=0,sl_cur=0,sl_next=SLOTB;
  #define ROT() do{sl_prev=sl_cur;sl_cur=sl_next;sl_next=(sl_next==(NSLOT-1)*SLOTB)?0:sl_next+SLOTB;}while(0)
  DMA_K(2,2*SLOTB);
  WAIT_BAR(3);
  qkt(pA0,pA1,Kbase,qr,negm,r32,hi);KBIAS(pA0,pA1,0);asm volatile("s_nop 15\n\ts_nop 7":"+v"(pA0),"+v"(pA1));CMASK(pA0,pA1,0);
  START(pA0,pA1);
  _Pragma("unroll") for(int r=0;r<16;++r)pA1[r]=__builtin_amdgcn_exp2f(pA1[r]);
  WAIT_BAR(0);
  DMA_K(3,0);DMA_V(1,SLOTB);
  ROT();
  kload8(kf,kp0+sl_cur);
  WAIT_BAR(2);
  s16x4 vlo[8],vhi[8]; u32x4 pw0,pw1,pw2,pw3;
  #define PKW(P,B) cvtpk_s(P[B],P[B+1])
  #define PAF(k) __builtin_bit_cast(bf16x8,pw##k)
  #define VFR(i) (bf16x8){vlo[i][0],vlo[i][1],vlo[i][2],vlo[i][3],vhi[i][0],vhi[i][1],vhi[i][2],vhi[i][3]}
  #define PIN(x) asm volatile("":"+v"(x))
  #define MX3(a,b,c) __builtin_fmaxf(__builtin_fmaxf((a),(b)),(c))
  #define GAPA(MF,A0,A1,A2,A3,W0,W1,PW) do{ MF; sacc+=A0; sacc+=A1; sacc+=A2; sacc+=A3; PIN(sacc); W0; W1; PIN(PW); SBAR(); }while(0)
  #define EX(v) __builtin_amdgcn_exp2f(v)
  #define GAPB(MF,X,B) do{ MF; X[B]=EX(X[B]); X[B+1]=EX(X[B+1]); X[B+2]=EX(X[B+2]); X[B+3]=EX(X[B+3]); PIN(X); SBAR(); }while(0)
  #define VRD(i) do{ vlo[i]=vtr(vp_+(((i)>>2)*4096+((i)&3)*1024)); vhi[i]=vtr(vp_+(((i)>>2)*4096+((i)&3)*1024+512)); }while(0)
  #define KRD(G,j) do{ if(G){ kload2(kf,kp0+sl_next,j); SBAR(); } }while(0)
  #define STEP(C0,C1,P0,P1,t,GK,GV,GL) do{ SBAR(); \
    const lds_cptr vp_=vp0+sl_prev; \
    VRD(0); SBAR(); float sacc=(P0[0]+P0[1]); \
    GAPA(C0=__builtin_amdgcn_mfma_f32_32x32x16_bf16(kf[0],qr[0],negm,0,0,0), P0[2],P0[3],P0[4],P0[5],     pw0[0]=PKW(P0,0), pw0[1]=PKW(P0,2), pw0); \
    VRD(4); SBAR(); GAPA(C1=__builtin_amdgcn_mfma_f32_32x32x16_bf16(kf[1],qr[0],negm,0,0,0), P0[6],P0[7],P0[8],P0[9],     pw0[2]=PKW(P0,4), pw0[3]=PKW(P0,6), pw0); \
    VRD(1); SBAR(); GAPA(C0=__builtin_amdgcn_mfma_f32_32x32x16_bf16(kf[2],qr[1],C0,0,0,0),   P0[10],P0[11],P0[12],P0[13], pw1[0]=PKW(P0,8), pw1[1]=PKW(P0,10), pw1); \
    VRD(5); SBAR(); GAPA(C1=__builtin_amdgcn_mfma_f32_32x32x16_bf16(kf[3],qr[1],C1,0,0,0),   P0[14],P0[15],P1[0],P1[1],   pw1[2]=PKW(P0,12),pw1[3]=PKW(P0,14), pw1); \
    VRD(2); SBAR(); GAPA(C0=__builtin_amdgcn_mfma_f32_32x32x16_bf16(kf[4],qr[2],C0,0,0,0),   P1[2],P1[3],P1[4],P1[5],     pw2[0]=PKW(P1,0), pw2[1]=PKW(P1,2), pw2); \
    VRD(6); SBAR(); GAPA(C1=__builtin_amdgcn_mfma_f32_32x32x16_bf16(kf[5],qr[2],C1,0,0,0),   P1[6],P1[7],P1[8],P1[9],     pw2[2]=PKW(P1,4), pw2[3]=PKW(P1,6), pw2); \
    VRD(3); SBAR(); GAPA(C0=__builtin_amdgcn_mfma_f32_32x32x16_bf16(kf[6],qr[3],C0,0,0,0),   P1[10],P1[11],P1[12],P1[13], pw3[0]=PKW(P1,8), pw3[1]=PKW(P1,10), pw3); \
    VRD(7); SBAR(); GAPA(C1=__builtin_amdgcn_mfma_f32_32x32x16_bf16(kf[7],qr[3],C1,0,0,0),   P1[14],P1[15],0.f,0.f,       pw3[2]=PKW(P1,12),pw3[3]=PKW(P1,14), pw3); \
    l_reg+=sacc; \
    if(GK){DMA_K((t)+3,sl_cur);} if(GV){DMA_V((t)+1,sl_next);} \
    KBIAS(C0,C1,t); CMASK(C0,C1,t); \
    { float a=MX3(C0[0],C0[1],C1[0]),b=MX3(C0[2],C0[3],C1[1]); a=MX3(a,C1[2],C1[3]); \
      _Pragma("unroll") for(int r=4;r<16;r+=4){a=MX3(a,C0[r],C0[r+1]);b=MX3(b,C0[r+2],C0[r+3]);a=MX3(a,C1[r],C1[r+1]);b=MX3(b,C1[r+2],C1[r+3]);} \
      float rm=__builtin_fmaxf(a,b); { auto rr=__builtin_amdgcn_permlane32_swap(__float_as_uint(rm),__float_as_uint(rm),false,false); rm=__builtin_fmaxf(__uint_as_float(rr[0]),__uint_as_float(rr[1])); } \
      resc=false; \
      if(__builtin_expect(__any(rm>(float)THRL),0)){ const float dl=__builtin_fmaxf(rm,0.f); mhat+=dl; \
        _Pragma("unroll") for(int r=0;r<16;++r){C0[r]-=dl;C1[r]-=dl;} \
        _Pragma("unroll") for(int r=0;r<16;++r)negm[r]=-mhat; asm volatile("":"+v"(negm)); \
        const float f=__builtin_amdgcn_exp2f(-dl); l_reg*=f; if(hi==0)wsf[r32]=f; resc=true; } } \
    SBAR(); \
    GAPB(o[0]=__builtin_amdgcn_mfma_f32_32x32x16_bf16(PAF(0),VFR(0),o[0],0,0,0), C0,0); \
    GAPB(o[1]=__builtin_amdgcn_mfma_f32_32x32x16_bf16(PAF(0),VFR(4),o[1],0,0,0), C0,4); \
    KRD(GL,0); GAPB(o[0]=__builtin_amdgcn_mfma_f32_32x32x16_bf16(PAF(1),VFR(1),o[0],0,0,0), C0,8); \
    KRD(GL,1); GAPB(o[1]=__builtin_amdgcn_mfma_f32_32x32x16_bf16(PAF(1),VFR(5),o[1],0,0,0), C0,12); \
    KRD(GL,2); GAPB(o[0]=__builtin_amdgcn_mfma_f32_32x32x16_bf16(PAF(2),VFR(2),o[0],0,0,0), C1,0); \
    KRD(GL,3); GAPB(o[1]=__builtin_amdgcn_mfma_f32_32x32x16_bf16(PAF(2),VFR(6),o[1],0,0,0), C1,4); \
    GAPB(o[0]=__builtin_amdgcn_mfma_f32_32x32x16_bf16(PAF(3),VFR(3),o[0],0,0,0), C1,8); \
    GAPB(o[1]=__builtin_amdgcn_mfma_f32_32x32x16_bf16(PAF(3),VFR(7),o[1],0,0,0), C1,12); \
    }while(0)
  int t=1;
  #undef CMASK
  #define CMASK(P0,P1,t) do{}while(0)
  for(;t+5<NT;t+=2){
    STEP(pB0,pB1,pA0,pA1,t,true,true,true);     WAIT_BAR(2); RESC(); ROT();
    STEP(pA0,pA1,pB0,pB1,t+1,true,true,true);   WAIT_BAR(2); RESC(); ROT();
  }
  #undef CMASK
  #define CMASK(P0,P1,t) do{int jb_=(t)-(NT-4); if(jb_>=0)cmask(P0,P1,jb_,qrel,hi);}while(0)
  #define ENDW(tt) do{ if((tt)+3<NT){WAIT_BAR(2);} else if((tt)+2<NT){WAIT_BAR(1);} else {WAIT_BAR(0);} }while(0)
  for(;t+1<NT;t+=2){
    STEP(pB0,pB1,pA0,pA1,t,(t+3<NT),(t+1<NT),(t+1<NT));       ENDW(t);   RESC(); ROT();
    STEP(pA0,pA1,pB0,pB1,t+1,(t+4<NT),(t+2<NT),(t+2<NT));     ENDW(t+1); RESC(); ROT();
  }
  STEP(pB0,pB1,pA0,pA1,NT-1,false,false,false); RESC();
  { float sacc=pB0[0]+pB0[1]; _Pragma("unroll") for(int r=2;r<16;++r)sacc+=pB0[r]; _Pragma("unroll") for(int r=0;r<16;++r)sacc+=pB1[r]; l_reg+=sacc;
    pw0=(u32x4){PKW(pB0,0),PKW(pB0,2),PKW(pB0,4),PKW(pB0,6)};pw1=(u32x4){PKW(pB0,8),PKW(pB0,10),PKW(pB0,12),PKW(pB0,14)};pw2=(u32x4){PKW(pB1,0),PKW(pB1,2),PKW(pB1,4),PKW(pB1,6)};pw3=(u32x4){PKW(pB1,8),PKW(pB1,10),PKW(pB1,12),PKW(pB1,14)};
    SBAR(); pv(o,vb0+sl_cur,PAF(0),PAF(1),PAF(2),PAF(3)); }
  #undef PKW
  #undef PAF
  #undef VFR
  #undef PIN
  #undef MX3
  #undef GAPA
  #undef GAPB
  #undef EX
  #undef VRD
  #undef KRD
  #undef STEP
  #undef ENDW
  {auto rr=__builtin_amdgcn_permlane32_swap(__float_as_uint(l_reg),__float_as_uint(l_reg),false,false);l_reg=__uint_as_float(rr[0])+__uint_as_float(rr[1]);}
  if(hi==0)wsf[32+r32]=l_reg;asm volatile("s_waitcnt lgkmcnt(0)":::"memory");
  float rli[16];
  #pragma unroll
  for(int r=0;r<16;++r)rli[r]=__builtin_amdgcn_rcpf(wsf[32+crow(r,hi)]);
  bf16*Ow=O+(rowbase+q0+wid*QBLK)*PO+h*D;
  { bf16*stg=(bf16*)(shm+LDS_OST)+wid*2048;
    #pragma unroll
    for(int r=0;r<16;++r){const int orow=crow(r,hi);
      #pragma unroll
      for(int d0=0;d0<2;++d0)stg[orow*64+d0*32+r32]=__float2bfloat16(o[d0][r]*rli[r]);}
    asm volatile("s_waitcnt lgkmcnt(0)":::"memory");
    #pragma unroll
    for(int i=0;i<4;++i){const int row=i*8+(lane>>3),ch=lane&7; const u32x4 v=*(const u32x4*)(stg+row*64+ch*8); ATTN_STORE16(Ow+(long)row*PO+ch*8,v);} }
  asm volatile("s_waitcnt lgkmcnt(0)\n\ts_barrier":::"memory");
  #undef KBIAS
  #undef DMA_K
  #undef DMA_V
  #undef CMASK
  #undef START
  #undef RESC
  #undef ROT
}
constexpr int ATTN_LDS_BYTES=LDS_BYTES;
#undef SBAR
#undef WAIT_BAR
}
#define LAS __attribute__((address_space(3)))
typedef unsigned short bf16;
typedef unsigned u32x4 __attribute__((ext_vector_type(4)));
typedef unsigned u32x2 __attribute__((ext_vector_type(2)));
typedef float f32x4 __attribute__((ext_vector_type(4)));
typedef float f32x2 __attribute__((ext_vector_type(2)));
typedef float f32x16 __attribute__((ext_vector_type(16)));
typedef short bf16x8 __attribute__((ext_vector_type(8)));
constexpr int NWAVES = 8, NTHR = 512;
constexpr int LDS_BYTES = 147456, MISC_OFF = 131072 + 8192;
constexpr float LOG2E = 1.4426950408889634f;
__device__ __forceinline__ unsigned pk2(float lo, float hi) { return pg8::cvt_pk_bf16(lo, hi); }
__device__ __forceinline__ float bf2f(unsigned u16) { return __uint_as_float(u16 << 16); }
__device__ __forceinline__ int crow(int r, int hi) { return (r & 3) + 8 * (r >> 2) + 4 * hi; }
__device__ __forceinline__ float wave_sum(float v) {
#pragma unroll
    for (int o = 1; o < 64; o <<= 1) v += __shfl_xor(v, o);
    return v;
}
__device__ __forceinline__ void sincos_cw(float x, float& s, float& c) {
    const float k = rintf(x * 0.636619772367581343f);
    float r = fmaf(k, -1.5703125f, x); r = fmaf(k, -4.837512969970703125e-4f, r); r = fmaf(k, -7.54978995489188216e-8f, r);
    const float z = r * r;
    const float sp = r + r * z * (-1.6666654611e-1f + z * (8.3321608736e-3f + z * -1.9515295891e-4f));
    const float cp = 1.0f - 0.5f * z + z * z * (4.166664568298827e-2f + z * (-1.388731625493765e-3f + z * 2.443315711809948e-5f));
    const int q = ((int)k) & 3;
    s = (q == 0) ? sp : (q == 1) ? cp : (q == 2) ? -sp : -cp;
    c = (q == 0) ? cp : (q == 1) ? -sp : (q == 2) ? -cp : sp;
}
__device__ __forceinline__ float block_scan(float v, float& tot, LAS float* scr, int lane, int wid) {
#pragma unroll
    for (int o = 1; o < 64; o <<= 1) { const float n = __shfl_up(v, o); if (lane >= o) v += n; }
    if (lane == 63) scr[wid] = v;
    __syncthreads();
    float off = 0.f; tot = 0.f;
#pragma unroll
    for (int w = 0; w < NWAVES; ++w) { const float x = scr[w]; if (w < wid) off += x; tot += x; }
    __syncthreads();
    return v + off;
}

template <int MODE> __device__ __forceinline__ int rowmap(int n) {
    if (MODE == 1) return n < 1024 ? ((n & ~127) | ((n & 63) << 1) | ((n >> 6) & 1)) : n;
    if (MODE == 2) return 2 * n;
    if (MODE == 3) return 2 * n + 1;
    return n;
}
template <int MODE> __device__ __forceinline__ void p0_transpose_item(const float* W, int ldw, int K, int N, const float* ks, bf16* WT, LAS float* scr, int item, int lane) {
    const int nblk = N / 32, kb = item / nblk, nb = item % nblk, k0 = 64 * kb, n0 = 32 * nb;
#pragma unroll 8
    for (int i = 0; i < 32; ++i) { const int kk = 2 * i + (lane >> 5); float w = W[(size_t)(k0 + kk) * ldw + n0 + (lane & 31)]; if (ks) w *= ks[k0 + kk]; scr[kk * 33 + (lane & 31)] = w; }
    asm volatile("s_waitcnt lgkmcnt(0)" ::: "memory");
    const int c = lane & 7;
#pragma unroll
    for (int j = 0; j < 4; ++j) { const int n = (lane >> 3) + 8 * j; const LAS float* s = scr + (8 * c) * 33 + n;
        u32x4 o; o.x = pk2(s[0 * 33], s[1 * 33]); o.y = pk2(s[2 * 33], s[3 * 33]); o.z = pk2(s[4 * 33], s[5 * 33]); o.w = pk2(s[6 * 33], s[7 * 33]);
        *(u32x4*)(WT + (size_t)rowmap<MODE>(n0 + n) * K + k0 + 8 * c) = o; }
    asm volatile("s_waitcnt lgkmcnt(0)" ::: "memory");
}
__device__ __forceinline__ void p0_prep(const Params& p, LAS unsigned char* lds, int vcu, int G) {
    const int tid = tid_fresh(), lane = tid & 63, wid = __builtin_amdgcn_readfirstlane(tid >> 6);
    unsigned char* ws = p.ws;
    for (int i = blockIdx.x * NTHR + tid; i < (int)(CTL_BYTES / 4); i += G * NTHR) ((unsigned*)(ws + WS_CTL))[i] = 0u;
    { float* cs = (float*)(ws + WS_CS);
      for (int i = blockIdx.x * NTHR + tid; i < (TSEQ + NSMP) * 64; i += G * NTHR) { const int tix = i >> 6, d = i & 63; const float pos = (float)(tix < TSEQ ? tix : PAST + tix - TSEQ);
          const float inv = exp2f((float)d * (-13.287712379549449f / 64.0f)); float s, c; sincos_cw(pos * inv, s, c); cs[2 * i] = c; cs[2 * i + 1] = s; } }
    LAS float* scr = (LAS float*)(lds + wid * 16384);
    const int gw = vcu * NWAVES + wid, NGW = G * NWAVES;
    constexpr int I_IN = (DM / 64) * (NZ / 32), I_O = (DM / 64) * (DM / 32), I_G = (DM / 64) * (DFF / 32), I_D = (DFF / 64) * (DM / 32);
    for (int it = gw; it < I_IN + I_O + 2 * I_G + I_D; it += NGW) {
        int r = it;
        if (r < I_IN) { p0_transpose_item<1>(p.win, DIN, DM, NZ, nullptr, (bf16*)(ws + WS_WIN), scr, r, lane); continue; } r -= I_IN;
        if (r < I_O) { p0_transpose_item<0>(p.wout, DM, DM, DM, nullptr, (bf16*)(ws + WS_WO), scr, r, lane); continue; } r -= I_O;
        if (r < I_G) { p0_transpose_item<2>(p.wg, DFF, DM, DFF, p.gffn, (bf16*)(ws + WS_WGU), scr, r, lane); continue; } r -= I_G;
        if (r < I_G) { p0_transpose_item<3>(p.wu, DFF, DM, DFF, p.gffn, (bf16*)(ws + WS_WGU), scr, r, lane); continue; } r -= I_G;
        p0_transpose_item<0>(p.wd, DM, DFF, DM, nullptr, (bf16*)(ws + WS_WD), scr, r, lane);
    }
    f32x4 wf[4][4][2], gm[4];
#pragma unroll
    for (int j = 0; j < 4; ++j) { gm[j] = *(const f32x4*)(p.gmix + 4 * lane + 256 * j);
#pragma unroll
        for (int e = 0; e < 4; ++e) { const float* wp = p.win + (size_t)(4 * lane + 256 * j + e) * DIN + NZ; wf[j][e][0] = *(const f32x4*)wp; wf[j][e][1] = *(const f32x4*)(wp + 4); } }
    const float bfv = p.bfg[lane & 7];
    bf16* XN = (bf16*)(ws + WS_XN);
    for (int m = gw; m < MTOK; m += NGW) {
        const float* xr = (m < MP) ? p.xp + (size_t)m * DM : p.xs + (size_t)(m - MP) * DM;
        f32x4 v[4]; float s = 0.f;
#pragma unroll
        for (int j = 0; j < 4; ++j) { v[j] = *(const f32x4*)(xr + 4 * lane + 256 * j); s += (v[j][0] * v[j][0] + v[j][1] * v[j][1]) + (v[j][2] * v[j][2] + v[j][3] * v[j][3]); }
        const float r = 1.0f / sqrtf(wave_sum(s) * (1.0f / DM) + 1e-6f);
        f32x4 a0 = {0.f, 0.f, 0.f, 0.f}, a1 = {0.f, 0.f, 0.f, 0.f};
#pragma unroll
        for (int j = 0; j < 4; ++j) { v[j] = v[j] * r * gm[j];
#pragma unroll
            for (int e = 0; e < 4; ++e) { a0 += wf[j][e][0] * v[j][e]; a1 += wf[j][e][1] * v[j][e]; }
            u32x2 w; w.x = pk2(v[j][0], v[j][1]); w.y = pk2(v[j][2], v[j][3]); *(u32x2*)(XN + (size_t)m * DM + 4 * lane + 256 * j) = w; }
        float fl[8];
#pragma unroll
        for (int e = 0; e < 4; ++e) { fl[e] = wave_sum(a0[e]); fl[4 + e] = wave_sum(a1[e]); }
        float mine = fl[0];
#pragma unroll
        for (int e = 1; e < 8; ++e) mine = ((lane & 7) == e) ? fl[e] : mine;
        if (lane < 8) { const float t = mine + bfv; const float lf = fminf(t, 0.f) - log1pf(expf(-fabsf(t)));
            float* o = (m < MP) ? p.out + O_LFP + (size_t)m * 8 : p.out + O_LFS + (size_t)(m - MP) * 8; o[lane] = lf; }
    }
}
__device__ __forceinline__ void p1_cumsum(const Params& p, LAS unsigned char* lds) {
    const int tid = tid_fresh(), lane = tid & 63, wid = __builtin_amdgcn_readfirstlane(tid >> 6);
    const int bh = blockIdx.x; if (bh >= NB * 8) return;
    const int b = bh >> 3, h = bh & 7; const float* lf = p.out + O_LFP + (size_t)b * TSEQ * 8 + h;
    float c[4]; float run = 0.f;
#pragma unroll
    for (int e = 0; e < 4; ++e) { run += lf[(size_t)(4 * tid + e) * 8]; c[e] = run; }
    float tot; const float inc = block_scan(run, tot, (LAS float*)lds, lane, wid); const float exc = inc - run;
    float* cb = (float*)(p.ws + WS_CB) + (size_t)bh * TSEQ + 4 * tid;
    *(f32x4*)cb = (f32x4){exc + c[0], exc + c[1], exc + c[2], exc + c[3]};
}
__device__ __forceinline__ void p6_final(const Params& p, int vcu, int G) {
    const int tid = tid_fresh(), lane = tid & 63, wid = __builtin_amdgcn_readfirstlane(tid >> 6);
    const float* ss = (const float*)(p.ws + WS_SS2);
    f32x4 gf[4];
#pragma unroll
    for (int j = 0; j < 4; ++j) gf[j] = *(const f32x4*)(p.gfin + 4 * lane + 256 * j);
    for (int m = vcu * NWAVES + wid; m < MTOK; m += G * NWAVES) { const float r = 1.0f / sqrtf(ss[m] * (1.0f / DM) + 1e-6f); float* y = p.out + O_Y + (size_t)m * DM + 4 * lane;
#pragma unroll
        for (int j = 0; j < 4; ++j) { const f32x4 v = *(const f32x4*)(y + 256 * j); *(f32x4*)(y + 256 * j) = v * r * gf[j]; } }
}
#ifndef RJ_SKIP
#define RJ_SKIP 0
#endif
#define MFMA32(a, b, c) __builtin_amdgcn_mfma_f32_32x32x16_bf16((a), (b), (c), 0, 0, 0)
__device__ __forceinline__ void ret_job(LAS unsigned char* lds, const Params& p_, const bool sample, const int b, const int h) {
    const Params p = fresh_params(p_);
    const int tid = tid_fresh(), lane = tid & 63, wid = __builtin_amdgcn_readfirstlane(tid >> 6), r32 = lane & 31, hi = lane >> 5;
    constexpr int PQK = 272, PT = 144;
    LAS unsigned char* Qr = lds; LAS unsigned char* Kr = lds + 17408; LAS unsigned char* Kdt = lds + 34816; LAS unsigned char* Vt = lds + 53248;
    LAS unsigned char* St = lds + 71680; LAS unsigned char* Am = lds + 106496; LAS f32x2* stats = (LAS f32x2*)(lds + 115712);
    const float lg2 = log1pf(-exp2f(-5.0f - (float)h)) * LOG2E;
    const float cdec = exp2f(lg2 * 64.0f);
    const int nch = sample ? 1 : TSEQ / 64; const size_t row0 = sample ? (size_t)MP + b * NSMP : (size_t)b * TSEQ;
    const bf16* Z = (const bf16*)(p.ws + WS_Z); bf16* MIX = (bf16*)(p.ws + WS_MIX);
    const int dkb = wid & 3, dvh = wid >> 2;
    f32x16 S0, S1;
    if (sample) { const float* sp = p.sr + (size_t)(b * 4 + h) * 16384 + 64 * dvh + r32;
#pragma unroll
        for (int r = 0; r < 16; ++r) { const int dk = 32 * dkb + crow(r, hi); S0[r] = sp[dk * 128]; S1[r] = sp[dk * 128 + 32]; } }
    else {
#pragma unroll
        for (int r = 0; r < 16; ++r) { S0[r] = 0.f; S1[r] = 0.f; } }
    for (int c = 0; c < nch; ++c) {
        const size_t r0 = row0 + (size_t)c * 64;
#if !(RJ_SKIP & 1)
#pragma unroll
        for (int i = 0; i < 2; ++i) { const int id = tid + NTHR * i, row = id >> 4, ch = id & 15;
            const bf16* zr = Z + (r0 + row) * NZ + h * 128 + ch * 8;
            const u32x4 q = *(const u32x4*)zr, k = *(const u32x4*)(zr + 512), v = *(const u32x4*)(zr + 1024);
            *(LAS u32x4*)(Qr + row * PQK + ch * 16) = q; *(LAS u32x4*)(Kr + row * PQK + ch * 16) = k;
            const float kd = exp2f(lg2 * (float)(63 - row));
#pragma unroll
            for (int e = 0; e < 8; ++e) { const unsigned kw = k[e >> 1], vw = v[e >> 1]; const unsigned ke = (e & 1) ? (kw >> 16) : (kw & 0xffffu), ve = (e & 1) ? (vw >> 16) : (vw & 0xffffu);
                *(LAS unsigned short*)(Kdt + (ch * 8 + e) * PT + row * 2) = (unsigned short)(pk2(bf2f(ke) * kd, 0.f) & 0xffffu);
                *(LAS unsigned short*)(Vt + (ch * 8 + e) * PT + row * 2) = (unsigned short)ve; } }
#pragma unroll
        for (int g = 0; g < 4; ++g) { const int dk0 = 32 * dkb + 8 * g + 4 * hi;
            u32x2 w0, w1; w0.x = pk2(S0[4 * g], S0[4 * g + 1]); w0.y = pk2(S0[4 * g + 2], S0[4 * g + 3]); w1.x = pk2(S1[4 * g], S1[4 * g + 1]); w1.y = pk2(S1[4 * g + 2], S1[4 * g + 3]);
            *(LAS u32x2*)(St + (64 * dvh + r32) * PQK + dk0 * 2) = w0; *(LAS u32x2*)(St + (64 * dvh + 32 + r32) * PQK + dk0 * 2) = w1; }
#endif
        __syncthreads();
#if !(RJ_SKIP & 2)
        if (wid < 4) { const int jb = wid >> 1, ib = wid & 1; f32x16 a;
#pragma unroll
            for (int r = 0; r < 16; ++r) a[r] = 0.f;
#pragma unroll 2
            for (int ks = 0; ks < 8; ++ks) { const bf16x8 kf = *(const LAS bf16x8*)(Kr + (32 * jb + r32) * PQK + (16 * ks + 8 * hi) * 2), qf = *(const LAS bf16x8*)(Qr + (32 * ib + r32) * PQK + (16 * ks + 8 * hi) * 2);
                a = MFMA32(kf, qf, a); }
            const int i = 32 * ib + r32;
#pragma unroll
            for (int g = 0; g < 4; ++g) { const int j0 = 32 * jb + 8 * g + 4 * hi; float t[4];
#pragma unroll
                for (int e = 0; e < 4; ++e) t[e] = a[4 * g + e] * exp2f(lg2 * fabsf((float)(i - (j0 + e))));
                u32x2 w; w.x = pk2(t[0], t[1]); w.y = pk2(t[2], t[3]); *(LAS u32x2*)(Am + i * PT + j0 * 2) = w; } }
#endif
        __syncthreads();
#if !(RJ_SKIP & 4)
        { const int dvb = wid >> 1, ib = wid & 1; f32x16 oi, ox;
#pragma unroll
            for (int r = 0; r < 16; ++r) { oi[r] = 0.f; ox[r] = 0.f; }
#pragma unroll
            for (int ks = 0; ks < 4; ++ks) { const bf16x8 vf = *(const LAS bf16x8*)(Vt + (32 * dvb + r32) * PT + (16 * ks + 8 * hi) * 2), af = *(const LAS bf16x8*)(Am + (32 * ib + r32) * PT + (16 * ks + 8 * hi) * 2);
                oi = MFMA32(vf, af, oi); }
#pragma unroll 2
            for (int ks = 0; ks < 8; ++ks) { const bf16x8 sf = *(const LAS bf16x8*)(St + (32 * dvb + r32) * PQK + (16 * ks + 8 * hi) * 2), qf = *(const LAS bf16x8*)(Qr + (32 * ib + r32) * PQK + (16 * ks + 8 * hi) * 2);
                ox = MFMA32(sf, qf, ox); }
            const int i = 32 * ib + r32; const float qd = exp2f(lg2 * (float)(i + 1)); float s1 = 0.f, s2 = 0.f;
#pragma unroll
            for (int r = 0; r < 16; ++r) { oi[r] += ox[r] * qd; s1 += oi[r]; s2 += oi[r] * oi[r]; }
            s1 += __shfl_xor(s1, 32); s2 += __shfl_xor(s2, 32);
            if (hi == 0) stats[i * 4 + dvb] = (f32x2){s1, s2};
            __syncthreads();
            float m1 = 0.f, m2 = 0.f;
#pragma unroll
            for (int t = 0; t < 4; ++t) { const f32x2 st = stats[i * 4 + t]; m1 += st.x; m2 += st.y; }
            const float mu = m1 * (1.0f / 128.0f), var = fmaxf(m2 * (1.0f / 128.0f) - mu * mu, 0.f), rstd = 1.0f / sqrtf(var + 1e-5f);
            const bf16* grow = Z + (r0 + i) * NZ + 1536 + h * 128; bf16* mrow = MIX + (r0 + i) * DM + h * 128;
#pragma unroll
            for (int g = 0; g < 4; ++g) { const int dv0 = 32 * dvb + 8 * g + 4 * hi; const u32x2 gw = *(const u32x2*)(grow + dv0); const f32x4 gn = *(const f32x4*)(p.gn + h * 128 + dv0);
                const float g0 = bf2f(gw.x & 0xffffu), g1 = bf2f(gw.x >> 16), g2 = bf2f(gw.y & 0xffffu), g3 = bf2f(gw.y >> 16);
                const float y0 = (oi[4 * g] - mu) * rstd * gn[0] * pg8::silu_f(g0), y1 = (oi[4 * g + 1] - mu) * rstd * gn[1] * pg8::silu_f(g1);
                const float y2 = (oi[4 * g + 2] - mu) * rstd * gn[2] * pg8::silu_f(g2), y3 = (oi[4 * g + 3] - mu) * rstd * gn[3] * pg8::silu_f(g3);
                u32x2 w; w.x = pk2(y0, y1); w.y = pk2(y2, y3); *(u32x2*)(mrow + dv0) = w; } }
#endif
#if !(RJ_SKIP & 8)
#pragma unroll
        for (int r = 0; r < 16; ++r) { S0[r] *= cdec; S1[r] *= cdec; }
#pragma unroll
        for (int ks = 0; ks < 4; ++ks) { const bf16x8 kdf = *(const LAS bf16x8*)(Kdt + (32 * dkb + r32) * PT + (16 * ks + 8 * hi) * 2);
            const bf16x8 v0 = *(const LAS bf16x8*)(Vt + (64 * dvh + r32) * PT + (16 * ks + 8 * hi) * 2), v1 = *(const LAS bf16x8*)(Vt + (64 * dvh + 32 + r32) * PT + (16 * ks + 8 * hi) * 2);
            S0 = MFMA32(kdf, v0, S0); S1 = MFMA32(kdf, v1, S1); }
#endif
        __syncthreads();
    }
    { float* so = p.out + (sample ? O_SRS : O_SRP) + (size_t)(b * 4 + h) * 16384 + 64 * dvh + r32;
#pragma unroll
        for (int r = 0; r < 16; ++r) { const int dk = 32 * dkb + crow(r, hi); so[dk * 128] = S0[r]; so[dk * 128 + 32] = S1[r]; } }
}

__device__ __forceinline__ void fox_sample_job(LAS unsigned char* lds, const Params& p_, const int b, const int h) {
    const Params p = fresh_params(p_);
    const int tid = tid_fresh(), lane = tid & 63, wid = __builtin_amdgcn_readfirstlane(tid >> 6), r32 = lane & 31, hi = lane >> 5;
    LAS float* ab = (LAS float*)lds;
    LAS float* scr = (LAS float*)(lds + 16640);
    LAS unsigned char* vtw = lds + 20480 + wid * 5120;
    { const float* clf = p.clf + (size_t)b * PAST * 8 + h; float v[8]; float tt = 0.f;
#pragma unroll
      for (int e = 0; e < 8; ++e) { v[e] = clf[(size_t)(8 * tid + e) * 8]; tt += v[e]; }
      float tot; const float inc = block_scan(tt, tot, scr, lane, wid); float suf = tot - inc;
#pragma unroll
      for (int e = 7; e >= 0; --e) { ab[8 * tid + e] = suf * LOG2E; suf += v[e]; }
      if (wid == 0) { float x = p.out[O_LFS + (size_t)(b * NSMP + lane) * 8 + h];
#pragma unroll
          for (int o = 1; o < 64; o <<= 1) { const float n = __shfl_up(x, o); if (lane >= o) x += n; }
          ab[PAST + lane] = -x * LOG2E; } }
    __syncthreads();
    const bf16* Zq = (const bf16*)(p.ws + WS_Z) + ((size_t)MP + b * NSMP) * NZ + 2048 + h * 64;
    bf16x8 qr[2][4];
#pragma unroll
    for (int qb = 0; qb < 2; ++qb)
#pragma unroll
        for (int d0 = 0; d0 < 4; ++d0) qr[qb][d0] = *(const bf16x8*)(Zq + (size_t)(32 * qb + r32) * NZ + 16 * d0 + 8 * hi);
    f32x16 o[2][2]; float mrun[2] = {-1e30f, -1e30f}, lrun[2] = {0.f, 0.f};
#pragma unroll
    for (int a = 0; a < 2; ++a)
#pragma unroll
        for (int c = 0; c < 2; ++c)
#pragma unroll
            for (int r = 0; r < 16; ++r) o[a][c][r] = 0.f;
    const size_t hoff = (size_t)h * 64;
    const float* ckb = p.ck + (size_t)b * PAST * 512 + hoff; const float* cvb = p.cv + (size_t)b * PAST * 512 + hoff;
    const float* nkb = p.out + O_FKS + (size_t)b * NSMP * 512 + hoff; const float* nvb = p.out + O_FVS + (size_t)b * NSMP * 512 + hoff;
    constexpr int NSTEP = PAST / 32 + 2;
    f32x4 kraw[8], vraw[8];
#define FS_LOAD(s_) do { const int s__ = (s_); const float* kp = s__ < PAST / 32 ? ckb + (size_t)s__ * 32 * 512 : nkb + (size_t)(s__ - PAST / 32) * 32 * 512; \
        const float* vp = s__ < PAST / 32 ? cvb + (size_t)s__ * 32 * 512 : nvb + (size_t)(s__ - PAST / 32) * 32 * 512; \
        _Pragma("unroll") for (int d0 = 0; d0 < 4; ++d0) { kraw[2 * d0] = *(const f32x4*)(kp + r32 * 512 + 16 * d0 + 8 * hi); kraw[2 * d0 + 1] = *(const f32x4*)(kp + r32 * 512 + 16 * d0 + 8 * hi + 4); } \
        _Pragma("unroll") for (int i = 0; i < 4; ++i) { const int pr = 4 * i + (lane >> 4); vraw[2 * i] = *(const f32x4*)(vp + (2 * pr) * 512 + 4 * (lane & 15)); vraw[2 * i + 1] = *(const f32x4*)(vp + (2 * pr + 1) * 512 + 4 * (lane & 15)); } } while (0)
    FS_LOAD(wid);
    for (int s = wid; s < NSTEP; s += NWAVES) {
        bf16x8 kf[4];
#pragma unroll
        for (int d0 = 0; d0 < 4; ++d0) { u32x4 w; w.x = pk2(kraw[2 * d0][0], kraw[2 * d0][1]); w.y = pk2(kraw[2 * d0][2], kraw[2 * d0][3]); w.z = pk2(kraw[2 * d0 + 1][0], kraw[2 * d0 + 1][1]); w.w = pk2(kraw[2 * d0 + 1][2], kraw[2 * d0 + 1][3]);
            kf[d0] = __builtin_bit_cast(bf16x8, w); }
#pragma unroll
        for (int i = 0; i < 4; ++i) { const int kap = 2 * (4 * i + (lane >> 4)); const int pos = (kap & ~12) | ((kap & 4) << 1) | ((kap & 8) >> 1);
#pragma unroll
            for (int e = 0; e < 4; ++e) *(LAS unsigned*)(vtw + (4 * (lane & 15) + e) * 80 + pos * 2) = pk2(vraw[2 * i][e], vraw[2 * i + 1][e]); }
        if (s + NWAVES < NSTEP) FS_LOAD(s + NWAVES);
        f32x16 sc[2];
#pragma unroll
        for (int qb = 0; qb < 2; ++qb) {
#pragma unroll
            for (int r = 0; r < 16; ++r) sc[qb][r] = 0.f;
#pragma unroll
            for (int d0 = 0; d0 < 4; ++d0) sc[qb] = MFMA32(kf[d0], qr[qb][d0], sc[qb]); }
        const int key0 = 32 * s;
#pragma unroll
        for (int g = 0; g < 4; ++g) { const f32x4 bv = *(const LAS f32x4*)(ab + key0 + 8 * g + 4 * hi);
#pragma unroll
            for (int e = 0; e < 4; ++e) { sc[0][4 * g + e] += bv[e]; sc[1][4 * g + e] += bv[e]; } }
        if (s >= PAST / 32) {
#pragma unroll
            for (int qb = 0; qb < 2; ++qb)
#pragma unroll
                for (int r = 0; r < 16; ++r) { const int kn = key0 - PAST + crow(r, hi); if (kn > 32 * qb + r32) sc[qb][r] = -INFINITY; } }
        bf16x8 pf[2][2];
#pragma unroll
        for (int qb = 0; qb < 2; ++qb) { float rm = sc[qb][0];
#pragma unroll
            for (int r = 1; r < 16; ++r) rm = fmaxf(rm, sc[qb][r]);
            rm = fmaxf(rm, __shfl_xor(rm, 32));
            const float mn = fmaxf(mrun[qb], rm), alpha = __builtin_amdgcn_exp2f(mrun[qb] - mn); mrun[qb] = mn; float ps = 0.f;
#pragma unroll
            for (int r = 0; r < 16; ++r) { const float e_ = __builtin_amdgcn_exp2f(sc[qb][r] - mn); sc[qb][r] = e_; ps += e_; }
            lrun[qb] = lrun[qb] * alpha + ps;
#pragma unroll
            for (int r = 0; r < 16; ++r) { o[qb][0][r] *= alpha; o[qb][1][r] *= alpha; }
#pragma unroll
            for (int ks = 0; ks < 2; ++ks) { u32x4 w; w.x = pk2(sc[qb][8 * ks], sc[qb][8 * ks + 1]); w.y = pk2(sc[qb][8 * ks + 2], sc[qb][8 * ks + 3]); w.z = pk2(sc[qb][8 * ks + 4], sc[qb][8 * ks + 5]); w.w = pk2(sc[qb][8 * ks + 6], sc[qb][8 * ks + 7]);
                pf[qb][ks] = __builtin_bit_cast(bf16x8, w); } }
#pragma unroll
        for (int db = 0; db < 2; ++db)
#pragma unroll
            for (int ks = 0; ks < 2; ++ks) { const bf16x8 vf = *(const LAS bf16x8*)(vtw + (32 * db + r32) * 80 + (16 * ks + 8 * hi) * 2);
                o[0][db] = MFMA32(vf, pf[0][ks], o[0][db]); o[1][db] = MFMA32(vf, pf[1][ks], o[1][db]); }
    }
#undef FS_LOAD
    lrun[0] += __shfl_xor(lrun[0], 32); lrun[1] += __shfl_xor(lrun[1], 32);
    bf16* MIX = (bf16*)(p.ws + WS_MIX);
#pragma unroll
    for (int qb = 0; qb < 2; ++qb) {
        __syncthreads();
        LAS float* cw = (LAS float*)(lds + wid * 8576);
        if (hi == 0) { cw[2080 + r32] = mrun[qb]; cw[2112 + r32] = lrun[qb]; }
#pragma unroll
        for (int db = 0; db < 2; ++db)
#pragma unroll
            for (int r = 0; r < 16; ++r) cw[r32 * 65 + 32 * db + crow(r, hi)] = o[qb][db][r];
        __syncthreads();
        const int q = tid >> 4, dg = tid & 15; float M = -3e38f;
#pragma unroll
        for (int w = 0; w < NWAVES; ++w) M = fmaxf(M, ((LAS float*)(lds + w * 8576))[2080 + q]);
        float L = 0.f, a0 = 0.f, a1 = 0.f, a2 = 0.f, a3 = 0.f;
#pragma unroll
        for (int w = 0; w < NWAVES; ++w) { LAS float* c = (LAS float*)(lds + w * 8576); const float wg = __builtin_amdgcn_exp2f(c[2080 + q] - M); L += wg * c[2112 + q];
            a0 += wg * c[q * 65 + 4 * dg]; a1 += wg * c[q * 65 + 4 * dg + 1]; a2 += wg * c[q * 65 + 4 * dg + 2]; a3 += wg * c[q * 65 + 4 * dg + 3]; }
        const float inv = 1.0f / L; u32x2 w; w.x = pk2(a0 * inv, a1 * inv); w.y = pk2(a2 * inv, a3 * inv);
        *(u32x2*)(MIX + ((size_t)MP + b * NSMP + 32 * qb + q) * DM + 512 + h * 64 + 4 * dg) = w;
    }
    __syncthreads();
}
constexpr int NJ_RETP = NB * 4, NJ_FS = NB * 8, NJ_FP = NB * 8 * (TSEQ / 256), NJ_RETS = NB * 4, NJOBS = NJ_RETP + NJ_FS + NJ_FP + NJ_RETS;
__global__ void __launch_bounds__(NTHR, 2) hybrid_fwd(Params p) {
    extern __shared__ __attribute__((aligned(16))) unsigned char lds_raw[];
    LAS unsigned char* lds = (LAS unsigned char*)lds_raw;
    cg::grid_group grid = cg::this_grid();
    const int G = gridDim.x, bx = blockIdx.x, vcu = (G % 8 == 0) ? (bx % 8) * (G / 8) + bx / 8 : bx;
    unsigned char* ws = p.ws;
    bf16* XN = (bf16*)(ws + WS_XN); bf16* MIX = (bf16*)(ws + WS_MIX); bf16* Z = (bf16*)(ws + WS_Z); bf16* H = (bf16*)(ws + WS_H);
    float* SS1 = (float*)(ws + WS_SS1); float* SS2 = (float*)(ws + WS_SS2);

#ifndef PHMASK
#define PHMASK 0xffff
#endif
    if (PHMASK & 1) p0_prep(p, lds, vcu, G);
    grid.sync();
    if (PHMASK & 2) p1_cumsum(p, lds);
    __syncthreads();
    if (PHMASK & 4) { pg8::Gemm g{XN, (const bf16*)(ws + WS_WIN), MTOK, NZ, DM}; pg8::StaticOrder S; S.init(MTOK, NZ, G, bx);
      pg8::EpiInProj E{Z, p.out, (const float*)(ws + WS_CS)};
      pg8::gemm_phase<pg8::EpiInProj, pg8::StaticOrder, true, true>(lds, g, S, E); }
    grid.sync();
    { unsigned* ctr = (unsigned*)(ws + WS_CTL); volatile LAS int* MISC = (volatile LAS int*)(lds + MISC_OFF);
      for (;;) {
          if (tid_fresh() == 0) MISC[0] = (int)atomicAdd(ctr, 1u);
          __syncthreads();
          const int job = __builtin_amdgcn_readfirstlane(MISC[0]);
          __syncthreads();
          if (job >= NJOBS) break;
          if (job < NJ_RETP) { if (PHMASK & 8) ret_job(lds, p, false, job >> 2, job & 3); }
          else if (job < NJ_RETP + NJ_FS) { const int j = job - NJ_RETP; if (PHMASK & 16) fox_sample_job(lds, p, j >> 3, j & 7); }
          else if (job < NJ_RETP + NJ_FS + NJ_FP) { const Params q = fresh_params(p); bf16* Z = (bf16*)(q.ws + WS_Z); bf16* MIX = (bf16*)(q.ws + WS_MIX); unsigned char* ws = q.ws; const int j = job - NJ_RETP - NJ_FS; const int qb = (TSEQ / 256 - 1) - (j >> 7), bh = j & 127;
              if (PHMASK & 32) attn_body::attn_unit<8>(bh >> 3, bh & 7, qb, (const attn_body::bf16*)(Z + 2048), (const attn_body::bf16*)(Z + 2560), (const attn_body::bf16*)(Z + 3072),
                                      (attn_body::bf16*)(MIX + 512), (const float*)(ws + WS_CB), (char*)lds_raw); }
          else { const int j = job - NJ_RETP - NJ_FS - NJ_FP; if (PHMASK & 8) ret_job(lds, p, true, j >> 2, j & 3); }
          __syncthreads();
      } }
    grid.sync();
    if (PHMASK & 64) { pg8::Gemm g{MIX, (const bf16*)(ws + WS_WO), MTOK, DM, DM}; pg8::StaticOrder S; S.init(MTOK, DM, G, bx);
      pg8::EpiResid E{p.xp, p.xs, p.out + O_Y, XN, SS1};
      pg8::gemm_phase<pg8::EpiResid, pg8::StaticOrder, true, true>(lds, g, S, E); }
    grid.sync();
    if (PHMASK & 128) { pg8::Gemm g{XN, (const bf16*)(ws + WS_WGU), MTOK, NGU, DM}; pg8::StaticOrder S; S.init(MTOK, NGU, G, bx);
      pg8::EpiGateUp E{H, SS1};
      pg8::gemm_phase<pg8::EpiGateUp, pg8::StaticOrder, true, true>(lds, g, S, E); }
    grid.sync();
    if (PHMASK & 256) { pg8::Gemm g{H, (const bf16*)(ws + WS_WD), MTOK, DM, DFF}; pg8::StaticOrder S; S.init(MTOK, DM, G, bx);
      pg8::EpiResid E{nullptr, nullptr, p.out + O_Y, nullptr, SS2};
      pg8::gemm_phase<pg8::EpiResid, pg8::StaticOrder, true, true>(lds, g, S, E); }
    grid.sync();
    if (PHMASK & 512) p6_final(p, vcu, G);
}

extern "C" void kernel_launch(void* const* d_in, const int* in_sizes, int n_in, void* d_out, int out_size, void* d_ws, size_t ws_size, hipStream_t stream) {
    static int grid = 0;
    if (grid == 0) {
        if (n_in != 16 || out_size != (int)O_END || ws_size < WS_END) { fprintf(stderr, "kernel_launch: unexpected shapes (n_in %d, out %d, ws %zu); nothing launched\n", n_in, out_size, ws_size); grid = -1; return; }
        int dev = 0, cus = 0, per_cu = 0;
        if (hipGetDevice(&dev) != hipSuccess || hipDeviceGetAttribute(&cus, hipDeviceAttributeMultiprocessorCount, dev) != hipSuccess) { grid = -1; return; }
        if (hipFuncSetAttribute((const void*)hybrid_fwd, hipFuncAttributeMaxDynamicSharedMemorySize, LDS_BYTES) != hipSuccess) { fprintf(stderr, "kernel_launch: hipFuncSetAttribute failed\n"); grid = -1; return; }
        if (hipOccupancyMaxActiveBlocksPerMultiprocessor(&per_cu, (const void*)hybrid_fwd, NTHR, LDS_BYTES) != hipSuccess || per_cu < 1) { fprintf(stderr, "kernel_launch: occupancy query says %d blocks per CU\n", per_cu); per_cu = 1; }
        (void)hipGetLastError();
        grid = cus * per_cu;
    }
    if (grid < 0) return;
    Params p{};
    p.xp = (const float*)d_in[0]; p.xs = (const float*)d_in[1]; p.ck = (const float*)d_in[2]; p.cv = (const float*)d_in[3]; p.clf = (const float*)d_in[4]; p.sr = (const float*)d_in[5];
    p.win = (const float*)d_in[6]; p.bfg = (const float*)d_in[7]; p.gn = (const float*)d_in[8]; p.wout = (const float*)d_in[9]; p.gmix = (const float*)d_in[10]; p.gffn = (const float*)d_in[11];
    p.wg = (const float*)d_in[12]; p.wu = (const float*)d_in[13]; p.wd = (const float*)d_in[14]; p.gfin = (const float*)d_in[15];
    p.out = (float*)d_out; p.ws = (unsigned char*)d_ws;
    void* args[] = {&p};
    const hipError_t e = hipLaunchCooperativeKernel((const void*)hybrid_fwd, dim3(grid), dim3(NTHR), args, LDS_BYTES, stream);
    if (e != hipSuccess) fprintf(stderr, "kernel_launch: cooperative launch failed: %s (grid %d)\n", hipGetErrorString(e), grid);
}
```

```cpp
#include <hip/hip_runtime.h>
#include <hip/hip_cooperative_groups.h>
#include <hip/hip_bf16.h>
#include <cstdio>
#include <cstdint>
#include <cmath>
namespace cg = cooperative_groups;

constexpr int DM = 1024, NB = 16, TSEQ = 2048, MP = NB * TSEQ, NSMP = 64, MS = NB * NSMP, MTOK = MP + MS, PAST = 4096;
constexpr int DIN = 3592, NZ = 3584, DFF = 2816, NGU = 2 * DFF;
constexpr size_t O_Y = 0, O_SRP = (size_t)MTOK * DM, O_FKP = O_SRP + 1048576, O_FVP = O_FKP + 16777216, O_LFP = O_FVP + 16777216, O_SRS = O_LFP + 262144,
                 O_FKS = O_SRS + 1048576, O_FVS = O_FKS + 524288, O_LFS = O_FVS + 524288, O_END = O_LFS + 8192;
constexpr size_t MiB = 1u << 20;
constexpr size_t WS_CTL = 0, WS_SS1 = 64 * 1024, WS_SS2 = 256 * 1024, CTL_BYTES = 512 * 1024;
constexpr size_t WS_CS = 1 * MiB, WS_CB = 3 * MiB, WS_WIN = 4 * MiB, WS_WO = 11 * MiB, WS_WGU = 13 * MiB, WS_WD = 24 * MiB;
constexpr size_t WS_XN = 32 * MiB, WS_MIX = 98 * MiB, WS_Z = 164 * MiB, WS_H = WS_Z, WS_END = 395 * MiB;
constexpr float C2F = 0.125f * 1.4426950408889634f;

struct Params {
    const float *xp, *xs, *ck, *cv, *clf, *sr, *win, *bfg, *gn, *wout, *gmix, *gffn, *wg, *wu, *wd, *gfin;
    float* out; unsigned char* ws;
};

__device__ __forceinline__ int tid_fresh() { int t = threadIdx.x; asm volatile("" : "+v"(t)); return t; }

__device__ __forceinline__ Params fresh_params(const Params& p) {
    Params q = p;
    asm volatile("" : "+s"(q.out), "+s"(q.ws), "+s"(q.ck), "+s"(q.cv), "+s"(q.clf), "+s"(q.sr), "+s"(q.gn));
    return q;
}

namespace pg8 {
#define PG8_LAS __attribute__((address_space(3)))
typedef unsigned short bf16_t;
typedef short bf16x8 __attribute__((ext_vector_type(8)));
typedef float f32x4 __attribute__((ext_vector_type(4)));
typedef unsigned u32x4 __attribute__((ext_vector_type(4)));
constexpr int BM = 256, BK = 64, HALF = 128, HTB = HALF * BK * 2  , STAGE_BYTES = 8 * HTB, NXCD = 8, WGM = 8;

__host__ __device__ __forceinline__ int lds_byte(int r, int c) { const int st = (r >> 4) * 2 + (c >> 5), rr = r & 15, cc = c & 31, ob = rr * 64 + cc * 2; return st * 1024 + (ob ^ (((ob >> 9) & 1) << 5)); }
__host__ __device__ __forceinline__ void stage_rc(int b, int& R, int& C) { const int st = b / 1024, sb = b % 1024, swz = sb ^ (((sb >> 9) & 1) << 5); R = (st >> 1) * 16 + swz / 64; C = (st & 1) * 32 + (swz % 64) / 2; }
__host__ __device__ __forceinline__ int perm32(int rho) { const int n = rho >> 4, i = rho & 15; return 8 * (i >> 2) + 4 * n + (i & 3); }

struct Unit { int pm, pn; };
struct Gemm { const bf16_t* A; const bf16_t* Bt; int M, N, K; };

struct StaticOrder {
    int nM, nN, nwg, G, c;
    __host__ __device__ void init(int M, int N, int G_, int c_) { nM = M / BM; nN = N / BM; nwg = nM * nN; G = G_; c = c_; }
    __host__ __device__ bool next(int i, Unit& u) const {
        const long L = (long)i * G + c; if (L >= nwg) return false;
        int wgid = (int)L; { const int q = nwg / NXCD, r = nwg % NXCD, xcd = wgid % NXCD, off = wgid / NXCD; wgid = (xcd < r ? xcd * (q + 1) : r * (q + 1) + (xcd - r) * q) + off; }
        const int nig = WGM * nN, gid = wgid / nig, fm = gid * WGM, gsz = (nM - fm) < WGM ? (nM - fm) : WGM;
        u.pm = fm + ((wgid % nig) % gsz); u.pn = (wgid % nig) / gsz; return true;
    }
    __device__ __forceinline__ void a_ready(const Unit&) const {}
    __device__ __forceinline__ void done(const Unit&) const {}
};

typedef float f32x2 __attribute__((ext_vector_type(2)));
typedef __bf16 bf16x2_t __attribute__((ext_vector_type(2)));
typedef unsigned u32x2 __attribute__((ext_vector_type(2)));
__device__ __forceinline__ unsigned cvt_pk_bf16(float lo, float hi) { f32x2 v = {lo, hi}; bf16x2_t b = __builtin_convertvector(v, bf16x2_t); return __builtin_bit_cast(unsigned, b); }
__device__ __forceinline__ float silu_f(float x) { return x * __builtin_amdgcn_rcpf(1.f + __builtin_amdgcn_exp2f(x * -1.4426950408889634f)); }

struct EpiInProj {
    static constexpr bool PERM = true, AFTER_DRAIN = false;
    bf16_t* Z; float* out; const float* cs;
    __device__ __forceinline__ void operator()(const f32x4 (&acc)[2][2][4][2], const Unit& u, int wr, int wc, int fr, int fq) const {
        const int pn = u.pn, row0 = u.pm * BM + wr * 64 + fr; const bool prompt = u.pm < (MP / BM);
        if (pn < 4) {
            const float sc = pn < 2 ? 0.08838834764831845f : 1.f; const int d0 = 16 * wc + 4 * fq;
#pragma unroll
            for (int ai = 0; ai < 2; ++ai)
#pragma unroll
                for (int m = 0; m < 4; ++m) { const int row = row0 + ai * HALF + m * 16; const int tix = prompt ? (row & (TSEQ - 1)) : TSEQ + ((row - MP) & (NSMP - 1));
                    const float* cr = cs + (size_t)tix * 128 + 2 * d0; const f32x4 c01 = *(const f32x4*)cr, c23 = *(const f32x4*)(cr + 4);
                    bf16_t* zrow = Z + (size_t)row * NZ + pn * BM + d0;
#pragma unroll
                    for (int bj = 0; bj < 2; ++bj) { const f32x4 v0 = acc[ai][bj][m][0], v1 = acc[ai][bj][m][1];
                        const float a0 = (v0[0] * c01[0] - v0[1] * c01[1]) * sc, b0 = (v0[0] * c01[1] + v0[1] * c01[0]) * sc;
                        const float a1 = (v0[2] * c01[2] - v0[3] * c01[3]) * sc, b1 = (v0[2] * c01[3] + v0[3] * c01[2]) * sc;
                        const float a2 = (v1[0] * c23[0] - v1[1] * c23[1]) * sc, b2 = (v1[0] * c23[1] + v1[1] * c23[0]) * sc;
                        const float a3 = (v1[2] * c23[2] - v1[3] * c23[3]) * sc, b3 = (v1[2] * c23[3] + v1[3] * c23[2]) * sc;
                        u32x2 w1, w2; w1.x = cvt_pk_bf16(a0, a1); w1.y = cvt_pk_bf16(a2, a3); w2.x = cvt_pk_bf16(b0, b1); w2.y = cvt_pk_bf16(b2, b3);
                        *(u32x2*)(zrow + bj * HALF) = w1; *(u32x2*)(zrow + bj * HALF + 64) = w2; } }
        } else {
            const float sc = (pn == 8 || pn == 9) ? C2F : 1.f; const int cw = wc * 32 + 8 * fq;
            float* fo = nullptr; size_t fstride = 512;
            if (pn >= 10) { const bool isv = pn >= 12; const int cb = (pn - (isv ? 12 : 10)) * BM + cw;
                fo = prompt ? out + (isv ? O_FVP : O_FKP) + (size_t)row0 * 512 + cb : out + (isv ? O_FVS : O_FKS) + (size_t)(row0 - MP) * 512 + cb; }
#pragma unroll
            for (int ai = 0; ai < 2; ++ai)
#pragma unroll
                for (int m = 0; m < 4; ++m) { bf16_t* rowp = Z + (size_t)(row0 + ai * HALF + m * 16) * NZ + pn * BM + cw; float* fr_ = fo + (size_t)(ai * HALF + m * 16) * fstride;
#pragma unroll
                    for (int bj = 0; bj < 2; ++bj) { const f32x4 v0 = acc[ai][bj][m][0] * sc, v1 = acc[ai][bj][m][1] * sc;
                        u32x4 w; w.x = cvt_pk_bf16(v0[0], v0[1]); w.y = cvt_pk_bf16(v0[2], v0[3]); w.z = cvt_pk_bf16(v1[0], v1[1]); w.w = cvt_pk_bf16(v1[2], v1[3]);
                        *(u32x4*)(rowp + bj * HALF) = w;
                        if (fo) { *(f32x4*)(fr_ + bj * HALF) = v0; *(f32x4*)(fr_ + bj * HALF + 4) = v1; } } }
        }
    }
};
struct EpiResid {
    static constexpr bool PERM = false, AFTER_DRAIN = false;
    const float* xp; const float* xs; float* Y; bf16_t* Yb; float* ss;
    __device__ __forceinline__ void operator()(const f32x4 (&acc)[2][2][4][2], const Unit& u, int wr, int wc, int fr, int fq) const {
        const int row0 = u.pm * BM + wr * 64 + fr, col0 = u.pn * BM + wc * 32 + 4 * fq; const bool prompt = u.pm < (MP / BM);
#pragma unroll
        for (int ai = 0; ai < 2; ++ai)
#pragma unroll
            for (int m = 0; m < 4; ++m) { const int row = row0 + ai * HALF + m * 16; float* yr = Y + (size_t)row * DM + col0;
                const float* br = xp ? (prompt ? xp + (size_t)row * DM + col0 : xs + (size_t)(row - MP) * DM + col0) : yr; float s = 0.f;
#pragma unroll
                for (int bj = 0; bj < 2; ++bj)
#pragma unroll
                    for (int n = 0; n < 2; ++n) { const int co = bj * HALF + n * 16; const f32x4 v = acc[ai][bj][m][n] + *(const f32x4*)(br + co); *(f32x4*)(yr + co) = v;
                        s += (v[0] * v[0] + v[1] * v[1]) + (v[2] * v[2] + v[3] * v[3]);
                        if (Yb) { u32x2 w; w.x = cvt_pk_bf16(v[0], v[1]); w.y = cvt_pk_bf16(v[2], v[3]); *(u32x2*)(Yb + (size_t)row * DM + col0 + co) = w; } }
                s += __shfl_xor(s, 16); s += __shfl_xor(s, 32);
                if (fq == 0) atomicAdd(ss + row, s); }
    }
};
struct EpiGateUp {
    static constexpr bool PERM = true, AFTER_DRAIN = false;
    bf16_t* H; const float* ss;
    __device__ __forceinline__ void operator()(const f32x4 (&acc)[2][2][4][2], const Unit& u, int wr, int wc, int fr, int fq) const {
        const int row0 = u.pm * BM + wr * 64 + fr, f0 = u.pn * 128 + wc * 16 + 4 * fq;
#pragma unroll
        for (int ai = 0; ai < 2; ++ai)
#pragma unroll
            for (int m = 0; m < 4; ++m) { const int row = row0 + ai * HALF + m * 16; const float r = 1.0f / sqrtf(ss[row] * (1.0f / DM) + 1e-6f);
#pragma unroll
                for (int bj = 0; bj < 2; ++bj) { const f32x4 v0 = acc[ai][bj][m][0] * r, v1 = acc[ai][bj][m][1] * r;
                    u32x2 w; w.x = cvt_pk_bf16(silu_f(v0[0]) * v0[1], silu_f(v0[2]) * v0[3]); w.y = cvt_pk_bf16(silu_f(v1[0]) * v1[1], silu_f(v1[2]) * v1[3]);
                    *(u32x2*)(H + (size_t)row * DFF + f0 + bj * 64) = w; } }
    }
};

template <class Epi, class Sched, bool ALIGN_EPI = false, bool SP2 = false>
__device__ __forceinline__ void gemm_phase(PG8_LAS unsigned char* lds, const Gemm g, const Sched& S, const Epi& E) {
    const int tid = tid_fresh(), wid = __builtin_amdgcn_readfirstlane(tid >> 6), lane = tid & 63, wr = wid >> 2, wc = wid & 3, fr = lane & 15, fq = lane >> 4;
    const int K = g.K, nt = K / BK;
    unsigned voffA[2], voffB[2];
#pragma unroll
    for (int i = 0; i < 2; ++i) { int R, C; stage_rc(tid * 16 + i * 8192, R, C); const int Rb = Epi::PERM ? ((R & ~31) + perm32(R & 31)) : R;
        voffA[i] = (unsigned)(R * K + C) * 2u; voffB[i] = (unsigned)(Rb * K + C) * 2u; }
    const size_t kstep = (size_t)(BK * 2);
    const size_t hstep = (size_t)HALF * K * 2;
    const size_t tstep = 2 * hstep;
    const unsigned ldsw = (unsigned)wid * 1024u;
    const int aoff = lds_byte(wr * 64 + fr, fq * 8), boff = lds_byte(wc * 32 + fr, fq * 8);
#define PG8_SA(b, h) (((b) * 2 + (h)) * HTB)
#define PG8_SB(b, h) ((4 + (b) * 2 + (h)) * HTB)
#define PG8_STAGE(bufoff, gbase, voff) do { _Pragma("unroll") for (int _i = 0; _i < 2; ++_i) \
        __builtin_amdgcn_global_load_lds((const unsigned*)((const char*)(gbase) + (voff)[_i]), (PG8_LAS unsigned*)(lds + (bufoff) + ldsw + _i * 8192), 16, 0, 0); } while (0)
#define PG8_LDA(dst, b, h) do { _Pragma("unroll") for (int m = 0; m < 4; ++m) _Pragma("unroll") for (int k = 0; k < 2; ++k) dst[m][k] = *(const PG8_LAS bf16x8*)(lds + PG8_SA(b, h) + aoff + m * 2048 + k * 1024); } while (0)
#define PG8_LDB(dst, b, h) do { _Pragma("unroll") for (int n = 0; n < 2; ++n) _Pragma("unroll") for (int k = 0; k < 2; ++k) dst[n][k] = *(const PG8_LAS bf16x8*)(lds + PG8_SB(b, h) + boff + n * 2048 + k * 1024); } while (0)
#define PG8_MMA(ai, bj, At, Bt) do { __builtin_amdgcn_s_setprio(1); _Pragma("unroll") for (int m = 0; m < 4; ++m) _Pragma("unroll") for (int n = 0; n < 2; ++n) _Pragma("unroll") for (int k = 0; k < 2; ++k) \
        acc[ai][bj][m][n] = __builtin_amdgcn_mfma_f32_16x16x32_bf16(Bt[n][k], At[m][k], acc[ai][bj][m][n], 0, 0, 0); __builtin_amdgcn_s_setprio(0); } while (0)
#define PG8_WAIT_V(n) asm volatile("s_waitcnt vmcnt(" #n ")" ::: "memory")
#define PG8_WAIT_L(n) asm volatile("s_waitcnt lgkmcnt(" #n ")" ::: "memory")
#define PG8_BAR __builtin_amdgcn_s_barrier()
#define PG8_SCHED __builtin_amdgcn_sched_barrier(0)
    Unit cur, nxt; int ui = 0;
    if (!S.next(0, cur)) return;
    f32x4 acc[2][2][4][2];
#pragma unroll
    for (int a = 0; a < 2; ++a)
#pragma unroll
        for (int b = 0; b < 2; ++b)
#pragma unroll
            for (int m = 0; m < 4; ++m)
#pragma unroll
                for (int n = 0; n < 2; ++n) acc[a][b][m][n] = (f32x4){0.f, 0.f, 0.f, 0.f};
    bf16x8 At[4][2], B0[2][2], B1[2][2];
    const char* cA = (const char*)g.A + (size_t)cur.pm * tstep; const char* cB = (const char*)g.Bt + (size_t)cur.pn * tstep;
    S.a_ready(cur);
    if constexpr (SP2) {
        PG8_STAGE(PG8_SB(0, 0), cB, voffB); PG8_STAGE(PG8_SB(0, 1), cB + hstep, voffB); PG8_STAGE(PG8_SA(0, 0), cA, voffA); PG8_STAGE(PG8_SA(0, 1), cA + hstep, voffA);
        if (wr == 1) PG8_BAR;
        PG8_WAIT_V(2); PG8_BAR;
        PG8_STAGE(PG8_SB(1, 0), cB + kstep, voffB); PG8_STAGE(PG8_SA(1, 0), cA + kstep, voffA); PG8_STAGE(PG8_SB(1, 1), cB + hstep + kstep, voffB);
        PG8_WAIT_V(6); PG8_BAR;
    } else {
        PG8_STAGE(PG8_SB(0, 0), cB, voffB); PG8_STAGE(PG8_SA(0, 0), cA, voffA); PG8_STAGE(PG8_SB(0, 1), cB + hstep, voffB); PG8_STAGE(PG8_SA(0, 1), cA + hstep, voffA);
        if (wr == 1) PG8_BAR;
        PG8_WAIT_V(4); PG8_BAR;
        PG8_STAGE(PG8_SB(1, 0), cB + kstep, voffB); PG8_STAGE(PG8_SA(1, 0), cA + kstep, voffA); PG8_STAGE(PG8_SB(1, 1), cB + hstep + kstep, voffB);
        PG8_WAIT_V(6); PG8_BAR;
    }
    for (;;) {
        const bool has_next = S.next(ui + 1, nxt);
        const char* nA = has_next ? (const char*)g.A + (size_t)nxt.pm * tstep : cA; const char* nB = has_next ? (const char*)g.Bt + (size_t)nxt.pn * tstep : cB;
        for (int t = 0; t < nt; t += 2) {
            const bool last = (t == nt - 2);
            const char* a1 = cA + (size_t)(t + 1) * kstep;
            const char* a2 = last ? nA : cA + (size_t)(t + 2) * kstep; const char* b2 = last ? nB : cB + (size_t)(t + 2) * kstep;
            const char* a3 = a2 + kstep; const char* b3 = b2 + kstep;
            if (last && has_next) S.a_ready(nxt);
            if constexpr (SP2) {
            PG8_LDB(B0, 0, 0); PG8_LDB(B1, 0, 1); PG8_SCHED; PG8_LDA(At, 0, 0); PG8_STAGE(PG8_SA(1, 1), a1 + hstep, voffA);
            PG8_WAIT_V(8); PG8_WAIT_L(0); PG8_BAR; PG8_MMA(0, 0, At, B0); PG8_MMA(0, 1, At, B1); PG8_BAR; PG8_SCHED;
            PG8_LDA(At, 0, 1); PG8_STAGE(PG8_SB(0, 0), b2, voffB); PG8_STAGE(PG8_SB(0, 1), b2 + hstep, voffB); PG8_STAGE(PG8_SA(0, 0), a2, voffA);
            PG8_WAIT_V(8); PG8_WAIT_L(0); PG8_BAR; PG8_MMA(1, 0, At, B0); PG8_MMA(1, 1, At, B1); PG8_BAR; PG8_SCHED;
            PG8_LDB(B0, 1, 0); PG8_LDB(B1, 1, 1); PG8_SCHED; PG8_LDA(At, 1, 0); PG8_STAGE(PG8_SA(0, 1), a2 + hstep, voffA);
            PG8_WAIT_V(8); PG8_WAIT_L(0); PG8_BAR; PG8_MMA(0, 0, At, B0); PG8_MMA(0, 1, At, B1); PG8_BAR; PG8_SCHED;
            PG8_LDA(At, 1, 1); PG8_STAGE(PG8_SB(1, 0), b3, voffB); PG8_STAGE(PG8_SB(1, 1), b3 + hstep, voffB); PG8_STAGE(PG8_SA(1, 0), a3, voffA);
            PG8_WAIT_V(8); PG8_WAIT_L(0); PG8_BAR; PG8_MMA(1, 0, At, B0); PG8_MMA(1, 1, At, B1); PG8_BAR; PG8_SCHED;
            } else {
            PG8_LDB(B0, 0, 0); PG8_SCHED; PG8_LDA(At, 0, 0); PG8_STAGE(PG8_SA(1, 1), a1 + hstep, voffA);
            PG8_WAIT_L(8); PG8_BAR; PG8_WAIT_L(0); PG8_MMA(0, 0, At, B0); PG8_BAR; PG8_SCHED;
            PG8_LDB(B1, 0, 1); PG8_STAGE(PG8_SB(0, 0), b2, voffB);
            PG8_BAR; PG8_WAIT_L(0); PG8_MMA(0, 1, At, B1); PG8_BAR;
            PG8_LDA(At, 0, 1); PG8_STAGE(PG8_SA(0, 0), a2, voffA);
            PG8_BAR; PG8_WAIT_L(0); PG8_MMA(1, 0, At, B0); PG8_BAR; PG8_SCHED;
            PG8_STAGE(PG8_SB(0, 1), b2 + hstep, voffB);
            PG8_WAIT_V(6); PG8_BAR; PG8_MMA(1, 1, At, B1); PG8_BAR;
            PG8_LDB(B0, 1, 0); PG8_SCHED; PG8_LDA(At, 1, 0); PG8_STAGE(PG8_SA(0, 1), a2 + hstep, voffA);
            PG8_WAIT_L(8); PG8_BAR; PG8_WAIT_L(0); PG8_MMA(0, 0, At, B0); PG8_BAR; PG8_SCHED;
            PG8_LDB(B1, 1, 1); PG8_STAGE(PG8_SB(1, 0), b3, voffB);
            PG8_BAR; PG8_WAIT_L(0); PG8_MMA(0, 1, At, B1); PG8_BAR;
            PG8_LDA(At, 1, 1); PG8_STAGE(PG8_SA(1, 0), a3, voffA);
            PG8_BAR; PG8_WAIT_L(0); PG8_MMA(1, 0, At, B0); PG8_BAR; PG8_SCHED;
            PG8_STAGE(PG8_SB(1, 1), b3 + hstep, voffB);
            PG8_WAIT_V(6); PG8_BAR; PG8_MMA(1, 1, At, B1); PG8_BAR;
            }
        }
        if constexpr (ALIGN_EPI) { if (wr == 0) PG8_BAR; }
        if constexpr (!Epi::AFTER_DRAIN) { E(acc, cur, wr, wc, fr, fq); S.done(cur); }
        if (!has_next) break;
#pragma unroll
        for (int a = 0; a < 2; ++a)
#pragma unroll
            for (int b = 0; b < 2; ++b)
#pragma unroll
                for (int m = 0; m < 4; ++m)
#pragma unroll
                    for (int n = 0; n < 2; ++n) acc[a][b][m][n] = (f32x4){0.f, 0.f, 0.f, 0.f};
        cur = nxt; cA = nA; cB = nB; ++ui;
        if constexpr (ALIGN_EPI) { if (wr == 1) PG8_BAR; }
    }
    PG8_WAIT_V(0);
    if constexpr (!ALIGN_EPI) { if (wr == 0) PG8_BAR; }
    PG8_BAR;
    if constexpr (Epi::AFTER_DRAIN) { E.fused(acc, cur, wr, wc, fr, fq, lds, wid, lane); S.done(cur); }
#undef PG8_SA
#undef PG8_SB
#undef PG8_STAGE
#undef PG8_LDA
#undef PG8_LDB
#undef PG8_MMA
#undef PG8_WAIT_V
#undef PG8_WAIT_L
#undef PG8_BAR
#undef PG8_SCHED
}
}
#include <hip/hip_bf16.h>
#include <cmath>
namespace attn_body {
using bf16=__hip_bfloat16;
using bf16x8=__attribute__((ext_vector_type(8)))short;
using s16x4=__attribute__((ext_vector_type(4)))short;
using f32x16=__attribute__((ext_vector_type(16)))float;
using u32x4=__attribute__((ext_vector_type(4)))unsigned;
using f32x4b=__attribute__((ext_vector_type(4)))float;
constexpr int BATCH=16,NHEAD=8,SEQ=2048,D=64,PQ=3584,PO=1024;
constexpr int NW=8,QBLK=32,QB=QBLK*NW,KVBLK=64,NQB=SEQ/QB;
constexpr int ATTN_UNIT_ROWS=QB;
__device__ __forceinline__ int crow(int r,int hi){return (r&3)+8*(r>>2)+4*hi;}
#define SBAR() __builtin_amdgcn_sched_barrier(0)
__device__ __forceinline__ void cmask(f32x16&p0,f32x16&p1,int jb,int qrel,int hi){
  const float NEG=-INFINITY; int kb=64*jb+4*hi;
  #pragma unroll
  for(int r=0;r<16;++r){int kv=kb+(r&3)+8*(r>>2); if(kv>qrel)p0[r]=NEG; if(kv+32>qrel)p1[r]=NEG;}
}

constexpr int NSLOT=3, SLOTB=8192;
constexpr int LDS_K=0, LDS_V=NSLOT*SLOTB, LDS_WS=2*NSLOT*SLOTB, LDS_OST=LDS_WS+NW*64*4, LDS_BIAS=LDS_OST+NW*4096, LDS_BYTES=LDS_BIAS+SEQ*4;
constexpr float C2=0.125f*1.4426950408889634f;
__device__ __forceinline__ void glds16(const void*gsrc,unsigned lds_dst){unsigned keep;
  asm volatile("s_mov_b32 %0, m0\n\ts_mov_b32 m0, %2\n\ts_nop 0\n\tglobal_load_lds_dwordx4 %1, off\n\ts_mov_b32 m0, %0":"=&s"(keep):"v"(gsrc),"s"(lds_dst):"memory");}
__device__ __forceinline__ float max3f(float a,float b,float c){float r;asm("v_max3_f32 %0, %1, %2, %3":"=v"(r):"v"(a),"v"(b),"v"(c));return r;}
__device__ __forceinline__ float max2f(float a,float b){float r;asm("v_max_f32_e32 %0, %1, %2":"=v"(r):"v"(a),"v"(b));return r;}
__device__ __forceinline__ float fadd_s(float a,float b){float r;asm("v_add_f32_e32 %0, %1, %2":"=v"(r):"v"(a),"v"(b));return r;}
__device__ __forceinline__ float fsub_s(float a,float b){float r;asm("v_sub_f32_e32 %0, %1, %2":"=v"(r):"v"(a),"v"(b));return r;}
typedef float f32x2_t __attribute__((ext_vector_type(2))); typedef __bf16 bf16x2_t __attribute__((ext_vector_type(2)));
__device__ __forceinline__ unsigned cvtpk_s(float lo,float hi){f32x2_t v={lo,hi};bf16x2_t b=__builtin_convertvector(v,bf16x2_t);return __builtin_bit_cast(unsigned,b);}
#define WAIT_BAR(N) asm volatile("s_waitcnt vmcnt(" #N ") lgkmcnt(0)\n\ts_barrier":::"memory")

__device__ __forceinline__ void qkt(f32x16&p0,f32x16&p1,const char*Kslot,const bf16x8*qr,const f32x16&negm,int r32,int hi){
  const char*kb=Kslot+hi*1024+r32*16;
  #pragma unroll
  for(int d0=0;d0<4;++d0){
    const bf16x8 b0=*reinterpret_cast<const bf16x8*>(kb+d0*2048);
    const bf16x8 b1=*reinterpret_cast<const bf16x8*>(kb+d0*2048+512);
    if(d0==0){p0=__builtin_amdgcn_mfma_f32_32x32x16_bf16(b0,qr[0],negm,0,0,0);p1=__builtin_amdgcn_mfma_f32_32x32x16_bf16(b1,qr[0],negm,0,0,0);}
    else{p0=__builtin_amdgcn_mfma_f32_32x32x16_bf16(b0,qr[d0],p0,0,0,0);p1=__builtin_amdgcn_mfma_f32_32x32x16_bf16(b1,qr[d0],p1,0,0,0);}}
}
typedef __attribute__((address_space(3))) const char* lds_cptr;
typedef short v4i16_t __attribute__((ext_vector_type(4)));
__device__ __forceinline__ void kload8(bf16x8*kf,lds_cptr kp){
  kf[0]=*(const __attribute__((address_space(3))) bf16x8*)(kp);      kf[1]=*(const __attribute__((address_space(3))) bf16x8*)(kp+512);
  kf[2]=*(const __attribute__((address_space(3))) bf16x8*)(kp+2048); kf[3]=*(const __attribute__((address_space(3))) bf16x8*)(kp+2560);
  kf[4]=*(const __attribute__((address_space(3))) bf16x8*)(kp+4096); kf[5]=*(const __attribute__((address_space(3))) bf16x8*)(kp+4608);
  kf[6]=*(const __attribute__((address_space(3))) bf16x8*)(kp+6144); kf[7]=*(const __attribute__((address_space(3))) bf16x8*)(kp+6656);
}
__device__ __forceinline__ void kload2(bf16x8*kf,lds_cptr kp,int j){ kf[2*j]=*(const __attribute__((address_space(3))) bf16x8*)(kp+j*2048); kf[2*j+1]=*(const __attribute__((address_space(3))) bf16x8*)(kp+j*2048+512); }
__device__ __forceinline__ s16x4 vtr(lds_cptr p){ return __builtin_bit_cast(s16x4,__builtin_amdgcn_ds_read_tr16_b64_v4i16((__attribute__((address_space(3))) v4i16_t*)p)); }
__device__ __forceinline__ float rowmax(const f32x16&p0,const f32x16&p1){
  float a=max3f(p0[0],p0[1],p1[0]),b=max3f(p0[2],p0[3],p1[1]);a=max3f(a,p1[2],p1[3]);
  #pragma unroll
  for(int r=4;r<16;r+=4){a=max3f(a,p0[r],p0[r+1]);b=max3f(b,p0[r+2],p0[r+3]);a=max3f(a,p1[r],p1[r+1]);b=max3f(b,p1[r+2],p1[r+3]);}
  const float m=max2f(a,b);
  auto rr=__builtin_amdgcn_permlane32_swap(__float_as_uint(m),__float_as_uint(m),false,false);
  return max2f(__uint_as_float(rr[0]),__uint_as_float(rr[1]));
}
__device__ __forceinline__ void pv(f32x16*o,int vb,bf16x8 pa0,bf16x8 pa1,bf16x8 pa2,bf16x8 pa3){
  #pragma unroll
  for(int d0=0;d0<2;++d0){s16x4 lo[4],hi[4];
    #pragma unroll
    for(int ks=0;ks<4;++ks){
      asm volatile("ds_read_b64_tr_b16 %0,%1 offset:%c2":"=&v"(lo[ks]):"v"(vb),"i"(d0*4096+ks*1024):"memory");
      asm volatile("ds_read_b64_tr_b16 %0,%1 offset:%c2":"=&v"(hi[ks]):"v"(vb),"i"(d0*4096+ks*1024+512):"memory");}
    asm volatile("s_waitcnt lgkmcnt(0)":::"memory");SBAR();
    #define PK(k) (bf16x8){lo[k][0],lo[k][1],lo[k][2],lo[k][3],hi[k][0],hi[k][1],hi[k][2],hi[k][3]}
    o[d0]=__builtin_amdgcn_mfma_f32_32x32x16_bf16(pa0,PK(0),o[d0],0,0,0);
    o[d0]=__builtin_amdgcn_mfma_f32_32x32x16_bf16(pa1,PK(1),o[d0],0,0,0);
    o[d0]=__builtin_amdgcn_mfma_f32_32x32x16_bf16(pa2,PK(2),o[d0],0,0,0);
    o[d0]=__builtin_amdgcn_mfma_f32_32x32x16_bf16(pa3,PK(3),o[d0],0,0,0);
    #undef PK
  }
}

#ifndef ATTN_STORE16
#define ATTN_STORE16(p,v) (*(u32x4*)(p)=(v))
#endif
template<int THRL> __device__ __forceinline__ void attn_unit(int b,int h,int qb,const bf16*Q,const bf16*__restrict__ K,const bf16*__restrict__ V,bf16*O,const float*__restrict__ CB,char*shm){
  const int tid=tid_fresh(),lane=tid&63,r32=lane&31,hi=lane>>5; const int wid=__builtin_amdgcn_readfirstlane(tid>>6);
  const long rowbase=(long)b*SEQ; const int q0=qb*QB;
  const bf16*Qw=Q+(rowbase+q0+wid*QBLK)*PQ+h*D;
  const bf16*Kh=K+rowbase*PQ+h*D,*Vh=V+rowbase*PQ+h*D;
  const unsigned lds0=(unsigned)(uintptr_t)shm;
  float*wsf=(float*)(shm+LDS_WS)+wid*64;
  const bf16*ksrc=Kh+(long)lane*PQ+wid*8;
  const bf16*vsrc=Vh+(long)(16*(wid&3)+(lane>>2))*PQ+(wid>>2)*32+(lane&3)*8;
  const unsigned kdst=lds0+LDS_K+wid*1024, vdst=lds0+LDS_V+wid*1024;
  #define DMA_K(t,slot) glds16(ksrc+(long)(t)*KVBLK*PQ,(unsigned)__builtin_amdgcn_readfirstlane(kdst+(slot)))
  #define DMA_V(t,slot) glds16(vsrc+(long)(t)*KVBLK*PQ,(unsigned)__builtin_amdgcn_readfirstlane(vdst+(slot)))
  const int vb0=(int)(lds0+LDS_V)+((lane>>4)&1)*32+(lane&3)*8+(4*hi+((lane&15)>>2))*64;
  const char*Kbase=shm+LDS_K; bf16x8 kf[8];
  const lds_cptr shm3=(lds_cptr)shm; const lds_cptr kp0=shm3+LDS_K+hi*1024+r32*16; const lds_cptr vp0=shm3+LDS_V+((lane>>4)&1)*32+(lane&3)*8+(4*hi+((lane&15)>>2))*64;
  const int NT=(q0+QB)/KVBLK;
  { const float*cb=CB+(long)(b*NHEAD+h)*SEQ; float*bl=(float*)(shm+LDS_BIAS); for(int i=tid;i<NT*KVBLK;i+=NW*64)bl[i]=cb[i]*(-1.4426950408889634f); }
  const lds_cptr bp0=(lds_cptr)shm+LDS_BIAS+hi*16;
  #define KBIAS(P0,P1,t) do{ const lds_cptr bp_=bp0+(t)*256; _Pragma("unroll") for(int g_=0;g_<4;++g_){ const f32x4b a_=*(const __attribute__((address_space(3))) f32x4b*)(bp_+g_*32); const f32x4b c_=*(const __attribute__((address_space(3))) f32x4b*)(bp_+128+g_*32); \
      P0[4*g_]+=a_[0];P0[4*g_+1]+=a_[1];P0[4*g_+2]+=a_[2];P0[4*g_+3]+=a_[3]; P1[4*g_]+=c_[0];P1[4*g_+1]+=c_[1];P1[4*g_+2]+=c_[2];P1[4*g_+3]+=c_[3]; } }while(0)
  DMA_K(0,0);DMA_V(0,0);DMA_K(1,SLOTB);
  bf16x8 qr[4];
  #pragma unroll
  for(int d0=0;d0<4;++d0)qr[d0]=*reinterpret_cast<const bf16x8*>(&Qw[(long)r32*PQ+d0*16+hi*8]);
  float mhat=0.f,l_reg=0.f;f32x16 o[2];o[0]=f32x16{};o[1]=f32x16{};f32x16 negm=f32x16{};asm volatile("":"+v"(negm));
  const int qrel=wid*QBLK+r32;
  #define CMASK(P0,P1,t) do{int jb_=(t)-(NT-4); if(jb_>=0)cmask(P0,P1,jb_,qrel,hi);}while(0)
  bool resc=false;
  #define START(P0,P1) do{ const float rm=rowmax(P0,P1); resc=false; \
    { const float dl=rm; mhat=fadd_s(mhat,dl); \
      _Pragma("unroll") for(int r=0;r<16;++r){P0[r]=fsub_s(P0[r],dl);P1[r]=fsub_s(P1[r],dl);} \
      _Pragma("unroll") for(int r=0;r<16;++r)negm[r]=-mhat; asm volatile("":"+v"(negm)); } \
    _Pragma("unroll") for(int r=0;r<16;++r)P0[r]=__builtin_amdgcn_exp2f(P0[r]); }while(0)
  #define RESC() do{ if(resc){ asm volatile("s_waitcnt lgkmcnt(0)":::"memory"); \
      _Pragma("unroll") for(int d_=0;d_<2;++d_) _Pragma("unroll") for(int r=0;r<16;++r)o[d_][r]*=wsf[crow(r,hi)]; } }while(0)
  f32x16 pA0,pA1,pB0,pB1;
  int sl_prev=0,sl_cur=0,sl_next=SLOTB;
  #define ROT() do{sl_prev=sl_cur;sl_cur=sl_next;sl_next=(sl_next==(NSLOT-1)*SLOTB)?0:sl_next+SLOTB;}while(0)
  DMA_K(2,2*SLOTB);
  WAIT_BAR(3);
  qkt(pA0,pA1,Kbase,qr,negm,r32,hi);KBIAS(pA0,pA1,0);asm volatile("s_nop 15\n\ts_nop 7":"+v"(pA0),"+v"(pA1));CMASK(pA0,pA1,0);
  START(pA0,pA1);
  _Pragma("unroll") for(int r=0;r<16;++r)pA1[r]=__builtin_amdgcn_exp2f(pA1[r]);
  WAIT_BAR(0);
  DMA_K(3,0);DMA_V(1,SLOTB);
  ROT();
  kload8(kf,kp0+sl_cur);
  WAIT_BAR(2);
  s16x4 vlo[8],vhi[8]; u32x4 pw0,pw1,pw2,pw3;
  #define PKW(P,B) cvtpk_s(P[B],P[B+1])
  #define PAF(k) __builtin_bit_cast(bf16x8,pw##k)
  #define VFR(i) (bf16x8){vlo[i][0],vlo[i][1],vlo[i][2],vlo[i][3],vhi[i][0],vhi[i][1],vhi[i][2],vhi[i][3]}
  #define PIN(x) asm volatile("":"+v"(x))
  #define MX3(a,b,c) __builtin_fmaxf(__builtin_fmaxf((a),(b)),(c))
  #define GAPA(MF,A0,A1,A2,A3,W0,W1,PW) do{ MF; sacc+=A0; sacc+=A1; sacc+=A2; sacc+=A3; PIN(sacc); W0; W1; PIN(PW); SBAR(); }while(0)
  #define EX(v) __builtin_amdgcn_exp2f(v)
  #define GAPB(MF,X,B) do{ MF; X[B]=EX(X[B]); X[B+1]=EX(X[B+1]); X[B+2]=EX(X[B+2]); X[B+3]=EX(X[B+3]); PIN(X); SBAR(); }while(0)
  #define VRD(i) do{ vlo[i]=vtr(vp_+(((i)>>2)*4096+((i)&3)*1024)); vhi[i]=vtr(vp_+(((i)>>2)*4096+((i)&3)*1024+512)); }while(0)
  #define KRD(G,j) do{ if(G){ kload2(kf,kp0+sl_next,j); SBAR(); } }while(0)
  #define STEP(C0,C1,P0,P1,t,GK,GV,GL) do{ SBAR(); \
    const lds_cptr vp_=vp0+sl_prev; \
    VRD(0); SBAR(); float sacc=(P0[0]+P0[1]); \
    GAPA(C0=__builtin_amdgcn_mfma_f32_32x32x16_bf16(kf[0],qr[0],negm,0,0,0), P0[2],P0[3],P0[4],P0[5],     pw0[0]=PKW(P0,0), pw0[1]=PKW(P0,2), pw0); \
    VRD(4); SBAR(); GAPA(C1=__builtin_amdgcn_mfma_f32_32x32x16_bf16(kf[1],qr[0],negm,0,0,0), P0[6],P0[7],P0[8],P0[9],     pw0[2]=PKW(P0,4), pw0[3]=PKW(P0,6), pw0); \
    VRD(1); SBAR(); GAPA(C0=__builtin_amdgcn_mfma_f32_32x32x16_bf16(kf[2],qr[1],C0,0,0,0),   P0[10],P0[11],P0[12],P0[13], pw1[0]=PKW(P0,8), pw1[1]=PKW(P0,10), pw1); \
    VRD(5); SBAR(); GAPA(C1=__builtin_amdgcn_mfma_f32_32x32x16_bf16(kf[3],qr[1],C1,0,0,0),   P0[14],P0[15],P1[0],P1[1],   pw1[2]=PKW(P0,12),pw1[3]=PKW(P0,14), pw1); \
    VRD(2); SBAR(); GAPA(C0=__builtin_amdgcn_mfma_f32_32x32x16_bf16(kf[4],qr[2],C0,0,0,0),   P1[2],P1[3],P1[4],P1[5],     pw2[0]=PKW(P1,0), pw2[1]=PKW(P1,2), pw2); \
    VRD(6); SBAR(); GAPA(C1=__builtin_amdgcn_mfma_f32_32x32x16_bf16(kf[5],qr[2],C1,0,0,0),   P1[6],P1[7],P1[8],P1[9],     pw2[2]=PKW(P1,4), pw2[3]=PKW(P1,6), pw2); \
    VRD(3); SBAR(); GAPA(C0=__builtin_amdgcn_mfma_f32_32x32x16_bf16(kf[6],qr[3],C0,0,0,0),   P1[10],P1[11],P1[12],P1[13], pw3[0]=PKW(P1,8), pw3[1]=PKW(P1,10), pw3); \
    VRD(7); SBAR(); GAPA(C1=__builtin_amdgcn_mfma_f32_32x32x16_bf16(kf[7],qr[3],C1,0,0,0),   P1[14],P1[15],0.f,0.f,       pw3[2]=PKW(P1,12),pw3[3]=PKW(P1,14), pw3); \
    l_reg+=sacc; \
    if(GK){DMA_K((t)+3,sl_cur);} if(GV){DMA_V((t)+1,sl_next);} \
    KBIAS(C0,C1,t); CMASK(C0,C1,t); \
    { float a=MX3(C0[0],C0[1],C1[0]),b=MX3(C0[2],C0[3],C1[1]); a=MX3(a,C1[2],C1[3]); \
      _Pragma("unroll") for(int r=4;r<16;r+=4){a=MX3(a,C0[r],C0[r+1]);b=MX3(b,C0[r+2],C0[r+3]);a=MX3(a,C1[r],C1[r+1]);b=MX3(b,C1[r+2],C1[r+3]);} \
      float rm=__builtin_fmaxf(a,b); { auto rr=__builtin_amdgcn_permlane32_swap(__float_as_uint(rm),__float_as_uint(rm),false,false); rm=__builtin_fmaxf(__uint_as_float(rr[0]),__uint_as_float(rr[1])); } \
      resc=false; \
      if(__builtin_expect(__any(rm>(float)THRL),0)){ const float dl=__builtin_fmaxf(rm,0.f); mhat+=dl; \
        _Pragma("unroll") for(int r=0;r<16;++r){C0[r]-=dl;C1[r]-=dl;} \
        _Pragma("unroll") for(int r=0;r<16;++r)negm[r]=-mhat; asm volatile("":"+v"(negm)); \
        const float f=__builtin_amdgcn_exp2f(-dl); l_reg*=f; if(hi==0)wsf[r32]=f; resc=true; } } \
    SBAR(); \
    GAPB(o[0]=__builtin_amdgcn_mfma_f32_32x32x16_bf16(PAF(0),VFR(0),o[0],0,0,0), C0,0); \
    GAPB(o[1]=__builtin_amdgcn_mfma_f32_32x32x16_bf16(PAF(0),VFR(4),o[1],0,0,0), C0,4); \
    KRD(GL,0); GAPB(o[0]=__builtin_amdgcn_mfma_f32_32x32x16_bf16(PAF(1),VFR(1),o[0],0,0,0), C0,8); \
    KRD(GL,1); GAPB(o[1]=__builtin_amdgcn_mfma_f32_32x32x16_bf16(PAF(1),VFR(5),o[1],0,0,0), C0,12); \
    KRD(GL,2); GAPB(o[0]=__builtin_amdgcn_mfma_f32_32x32x16_bf16(PAF(2),VFR(2),o[0],0,0,0), C1,0); \
    KRD(GL,3); GAPB(o[1]=__builtin_amdgcn_mfma_f32_32x32x16_bf16(PAF(2),VFR(6),o[1],0,0,0), C1,4); \
    GAPB(o[0]=__builtin_amdgcn_mfma_f32_32x32x16_bf16(PAF(3),VFR(3),o[0],0,0,0), C1,8); \
    GAPB(o[1]=__builtin_amdgcn_mfma_f32_32x32x16_bf16(PAF(3),VFR(7),o[1],0,0,0), C1,12); \
    }while(0)
  int t=1;
  #undef CMASK
  #define CMASK(P0,P1,t) do{}while(0)
  for(;t+5<NT;t+=2){
    STEP(pB0,pB1,pA0,pA1,t,true,true,true);     WAIT_BAR(2); RESC(); ROT();
    STEP(pA0,pA1,pB0,pB1,t+1,true,true,true);   WAIT_BAR(2); RESC(); ROT();
  }
  #undef CMASK
  #define CMASK(P0,P1,t) do{int jb_=(t)-(NT-4); if(jb_>=0)cmask(P0,P1,jb_,qrel,hi);}while(0)
  #define ENDW(tt) do{ if((tt)+3<NT){WAIT_BAR(2);} else if((tt)+2<NT){WAIT_BAR(1);} else {WAIT_BAR(0);} }while(0)
  for(;t+1<NT;t+=2){
    STEP(pB0,pB1,pA0,pA1,t,(t+3<NT),(t+1<NT),(t+1<NT));       ENDW(t);   RESC(); ROT();
    STEP(pA0,pA1,pB0,pB1,t+1,(t+4<NT),(t+2<NT),(t+2<NT));     ENDW(t+1); RESC(); ROT();
  }
  STEP(pB0,pB1,pA0,pA1,NT-1,false,false,false); RESC();
  { float sacc=pB0[0]+pB0[1]; _Pragma("unroll") for(int r=2;r<16;++r)sacc+=pB0[r]; _Pragma("unroll") for(int r=0;r<16;++r)sacc+=pB1[r]; l_reg+=sacc;
    pw0=(u32x4){PKW(pB0,0),PKW(pB0,2),PKW(pB0,4),PKW(pB0,6)};pw1=(u32x4){PKW(pB0,8),PKW(pB0,10),PKW(pB0,12),PKW(pB0,14)};pw2=(u32x4){PKW(pB1,0),PKW(pB1,2),PKW(pB1,4),PKW(pB1,6)};pw3=(u32x4){PKW(pB1,8),PKW(pB1,10),PKW(pB1,12),PKW(pB1,14)};
    SBAR(); pv(o,vb0+sl_cur,PAF(0),PAF(1),PAF(2),PAF(3)); }
  #undef PKW
  #undef PAF
  #undef VFR
  #undef PIN
  #undef MX3
  #undef GAPA
  #undef GAPB
  #undef EX
  #undef VRD
  #undef KRD
  #undef STEP
  #undef ENDW
  {auto rr=__builtin_amdgcn_permlane32_swap(__float_as_uint(l_reg),__float_as_uint(l_reg),false,false);l_reg=__uint_as_float(rr[0])+__uint_as_float(rr[1]);}
  if(hi==0)wsf[32+r32]=l_reg;asm volatile("s_waitcnt lgkmcnt(0)":::"memory");
  float rli[16];
  #pragma unroll
  for(int r=0;r<16;++r)rli[r]=__builtin_amdgcn_rcpf(wsf[32+crow(r,hi)]);
  bf16*Ow=O+(rowbase+q0+wid*QBLK)*PO+h*D;
  { bf16*stg=(bf16*)(shm+LDS_OST)+wid*2048;
    #pragma unroll
    for(int r=0;r<16;++r){const int orow=crow(r,hi);
      #pragma unroll
      for(int d0=0;d0<2;++d0)stg[orow*64+d0*32+r32]=__float2bfloat16(o[d0][r]*rli[r]);}
    asm volatile("s_waitcnt lgkmcnt(0)":::"memory");
    #pragma unroll
    for(int i=0;i<4;++i){const int row=i*8+(lane>>3),ch=lane&7; const u32x4 v=*(const u32x4*)(stg+row*64+ch*8); ATTN_STORE16(Ow+(long)row*PO+ch*8,v);} }
  asm volatile("s_waitcnt lgkmcnt(0)\n\ts_barrier":::"memory");
  #undef KBIAS
  #undef DMA_K
  #undef DMA_V
  #undef CMASK
  #undef START
  #undef RESC
  #undef ROT
}
constexpr int ATTN_LDS_BYTES=LDS_BYTES;
#undef SBAR
#undef WAIT_BAR
}
#define LAS __attribute__((address_space(3)))
typedef unsigned short bf16;
typedef unsigned u32x4 __attribute__((ext_vector_type(4)));
typedef unsigned u32x2 __attribute__((ext_vector_type(2)));
typedef float f32x4 __attribute__((ext_vector_type(4)));
typedef float f32x2 __attribute__((ext_vector_type(2)));
typedef float f32x16 __attribute__((ext_vector_type(16)));
typedef short bf16x8 __attribute__((ext_vector_type(8)));
#define RLX_AGENT __ATOMIC_RELAXED, __HIP_MEMORY_SCOPE_AGENT
constexpr int NWAVES = 8, NTHR = 512;
constexpr int LDS_BYTES = 147456, MISC_OFF = 131072 + 8192;
constexpr float LOG2E = 1.4426950408889634f;
__device__ __forceinline__ unsigned pk2(float lo, float hi) { return pg8::cvt_pk_bf16(lo, hi); }
__device__ __forceinline__ float bf2f(unsigned u16) { return __uint_as_float(u16 << 16); }
__device__ __forceinline__ int crow(int r, int hi) { return (r & 3) + 8 * (r >> 2) + 4 * hi; }
__device__ __forceinline__ float wave_sum(float v) {
#pragma unroll
    for (int o = 1; o < 64; o <<= 1) v += __shfl_xor(v, o);
    return v;
}
__device__ __forceinline__ void sincos_cw(float x, float& s, float& c) {
    const float k = rintf(x * 0.636619772367581343f);
    float r = fmaf(k, -1.5703125f, x); r = fmaf(k, -4.837512969970703125e-4f, r); r = fmaf(k, -7.54978995489188216e-8f, r);
    const float z = r * r;
    const float sp = r + r * z * (-1.6666654611e-1f + z * (8.3321608736e-3f + z * -1.9515295891e-4f));
    const float cp = 1.0f - 0.5f * z + z * z * (4.166664568298827e-2f + z * (-1.388731625493765e-3f + z * 2.443315711809948e-5f));
    const int q = ((int)k) & 3;
    s = (q == 0) ? sp : (q == 1) ? cp : (q == 2) ? -sp : -cp;
    c = (q == 0) ? cp : (q == 1) ? -sp : (q == 2) ? -cp : sp;
}
__device__ __forceinline__ float block_scan(float v, float& tot, LAS float* scr, int lane, int wid) {
#pragma unroll
    for (int o = 1; o < 64; o <<= 1) { const float n = __shfl_up(v, o); if (lane >= o) v += n; }
    if (lane == 63) scr[wid] = v;
    __syncthreads();
    float off = 0.f; tot = 0.f;
#pragma unroll
    for (int w = 0; w < NWAVES; ++w) { const float x = scr[w]; if (w < wid) off += x; tot += x; }
    __syncthreads();
    return v + off;
}

template <int MODE> __device__ __forceinline__ int rowmap(int n) {
    if (MODE == 1) return n < 1024 ? ((n & ~127) | ((n & 63) << 1) | ((n >> 6) & 1)) : n;
    if (MODE == 2) return 2 * n;
    if (MODE == 3) return 2 * n + 1;
    return n;
}
template <int MODE> __device__ __forceinline__ void p0_transpose_item(const float* W, int ldw, int K, int N, const float* ks, bf16* WT, LAS float* scr, int item, int lane) {
    const int nblk = N / 32, kb = item / nblk, nb = item % nblk, k0 = 64 * kb, n0 = 32 * nb;
#pragma unroll
    for (int i = 0; i < 32; ++i) { const int kk = 2 * i + (lane >> 5); float w = W[(size_t)(k0 + kk) * ldw + n0 + (lane & 31)]; if (ks) w *= ks[k0 + kk]; scr[kk * 33 + (lane & 31)] = w; }
    asm volatile("s_waitcnt lgkmcnt(0)" ::: "memory");
    const int c = lane & 7;
#pragma unroll
    for (int j = 0; j < 4; ++j) { const int n = (lane >> 3) + 8 * j; const LAS float* s = scr + (8 * c) * 33 + n;
        u32x4 o; o.x = pk2(s[0 * 33], s[1 * 33]); o.y = pk2(s[2 * 33], s[3 * 33]); o.z = pk2(s[4 * 33], s[5 * 33]); o.w = pk2(s[6 * 33], s[7 * 33]);
        *(u32x4*)(WT + (size_t)rowmap<MODE>(n0 + n) * K + k0 + 8 * c) = o; }
    asm volatile("s_waitcnt lgkmcnt(0)" ::: "memory");
}
__device__ __forceinline__ void p0_prep(const Params& p, LAS unsigned char* lds, int vcu, int G) {
    const int tid = tid_fresh(), lane = tid & 63, wid = __builtin_amdgcn_readfirstlane(tid >> 6);
    unsigned char* ws = p.ws;
    for (int i = blockIdx.x * NTHR + tid; i < (int)(CTL_BYTES / 4); i += G * NTHR) ((unsigned*)(ws + WS_CTL))[i] = 0u;
    { float* cs = (float*)(ws + WS_CS);
      for (int i = blockIdx.x * NTHR + tid; i < (TSEQ + NSMP) * 64; i += G * NTHR) { const int tix = i >> 6, d = i & 63; const float pos = (float)(tix < TSEQ ? tix : PAST + tix - TSEQ);
          const float inv = exp2f((float)d * (-13.287712379549449f / 64.0f)); float s, c; sincos_cw(pos * inv, s, c); cs[2 * i] = c; cs[2 * i + 1] = s; } }
    LAS float* scr = (LAS float*)(lds + wid * 16384);
    const int gw = vcu * NWAVES + wid, NGW = G * NWAVES;
    constexpr int I_IN = (DM / 64) * (NZ / 32), I_O = (DM / 64) * (DM / 32), I_G = (DM / 64) * (DFF / 32), I_D = (DFF / 64) * (DM / 32);
#ifndef REP_P0T
#define REP_P0T 1
#endif
    for (int rept = 0; rept < REP_P0T; ++rept)
    for (int it = gw; it < I_IN + I_O + 2 * I_G + I_D; it += NGW) {
        int r = it;
        if (r < I_IN) { p0_transpose_item<1>(p.win, DIN, DM, NZ, nullptr, (bf16*)(ws + WS_WIN), scr, r, lane); continue; } r -= I_IN;
        if (r < I_O) { p0_transpose_item<0>(p.wout, DM, DM, DM, nullptr, (bf16*)(ws + WS_WO), scr, r, lane); continue; } r -= I_O;
        if (r < I_G) { p0_transpose_item<2>(p.wg, DFF, DM, DFF, p.gffn, (bf16*)(ws + WS_WGU), scr, r, lane); continue; } r -= I_G;
        if (r < I_G) { p0_transpose_item<3>(p.wu, DFF, DM, DFF, p.gffn, (bf16*)(ws + WS_WGU), scr, r, lane); continue; } r -= I_G;
        p0_transpose_item<0>(p.wd, DM, DFF, DM, nullptr, (bf16*)(ws + WS_WD), scr, r, lane);
    }
    __syncthreads();
    LAS f32x4* wl = (LAS f32x4*)lds;
    for (int i = tid; i < 2048; i += NTHR) { const int ln = i & 63, q = i >> 6, half = q & 1, e = (q >> 1) & 3, j = q >> 3;
        wl[i] = *(const f32x4*)(p.win + (size_t)(4 * ln + 256 * j + e) * DIN + NZ + 4 * half); }
    __syncthreads();
    f32x4 gm[4];
#pragma unroll
    for (int j = 0; j < 4; ++j) gm[j] = *(const f32x4*)(p.gmix + 4 * lane + 256 * j);
    bf16* XN = (bf16*)(ws + WS_XN);
    constexpr int NQUAD = MTOK / 4;
#ifndef REP_P0R
#define REP_P0R 1
#endif
    for (int repr_ = 0; repr_ < REP_P0R; ++repr_)
    for (int qd = gw; qd < NQUAD; qd += NGW) {
        const int m0 = 4 * qd; const float* xr = (m0 < MP) ? p.xp + (size_t)m0 * DM : p.xs + (size_t)(m0 - MP) * DM;
        f32x4 v[4][4];
#pragma unroll
        for (int rr = 0; rr < 4; ++rr)
#pragma unroll
            for (int j = 0; j < 4; ++j) v[rr][j] = *(const f32x4*)(xr + (size_t)rr * DM + 4 * lane + 256 * j);
        asm volatile("" ::: "memory");
        float ss[4]; f32x4 a0[4], a1[4];
#pragma unroll
        for (int rr = 0; rr < 4; ++rr) { ss[rr] = 0.f; a0[rr] = (f32x4){0.f, 0.f, 0.f, 0.f}; a1[rr] = a0[rr]; }
#pragma unroll
        for (int j = 0; j < 4; ++j) {
#pragma unroll
            for (int rr = 0; rr < 4; ++rr) { ss[rr] += (v[rr][j][0] * v[rr][j][0] + v[rr][j][1] * v[rr][j][1]) + (v[rr][j][2] * v[rr][j][2] + v[rr][j][3] * v[rr][j][3]); v[rr][j] = v[rr][j] * gm[j]; }
#pragma unroll
            for (int e = 0; e < 4; ++e) { const f32x4 w0 = wl[((j * 4 + e) * 2) * 64 + lane], w1 = wl[((j * 4 + e) * 2 + 1) * 64 + lane];
#pragma unroll
                for (int rr = 0; rr < 4; ++rr) { a0[rr] += w0 * v[rr][j][e]; a1[rr] += w1 * v[rr][j][e]; } } }
        const int b5 = lane >> 5, b4 = (lane >> 4) & 1, b3 = (lane >> 3) & 1;
#pragma unroll
        for (int rr = 0; rr < 4; ++rr) {
            const float r = 1.0f / sqrtf(wave_sum(ss[rr]) * (1.0f / DM) + 1e-6f);
            float t4[4], t2[2];
#pragma unroll
            for (int i = 0; i < 4; ++i) { const float mine = b5 ? a1[rr][i] : a0[rr][i], send = b5 ? a0[rr][i] : a1[rr][i]; t4[i] = mine + __shfl_xor(send, 32); }
#pragma unroll
            for (int i = 0; i < 2; ++i) { const float mine = b4 ? t4[2 + i] : t4[i], send = b4 ? t4[i] : t4[2 + i]; t2[i] = mine + __shfl_xor(send, 16); }
            float t1; { const float mine = b3 ? t2[1] : t2[0], send = b3 ? t2[0] : t2[1]; t1 = mine + __shfl_xor(send, 8); }
            t1 += __shfl_xor(t1, 4); t1 += __shfl_xor(t1, 2); t1 += __shfl_xor(t1, 1);
            const int m = m0 + rr;
#pragma unroll
            for (int j = 0; j < 4; ++j) { u32x2 w; const f32x4 xa = v[rr][j] * r; w.x = pk2(xa[0], xa[1]); w.y = pk2(xa[2], xa[3]); *(u32x2*)(XN + (size_t)m * DM + 4 * lane + 256 * j) = w; }
            if ((lane & 7) == 0) { const int idx = lane >> 3; const float t = t1 * r + p.bfg[idx]; const float lf = fminf(t, 0.f) - log1pf(expf(-fabsf(t)));
                float* o = (m < MP) ? p.out + O_LFP + (size_t)m * 8 : p.out + O_LFS + (size_t)(m - MP) * 8; o[idx] = lf; }
        }
    }
}
__device__ __forceinline__ void p1_cumsum(const Params& p, LAS unsigned char* lds) {
    const int tid = tid_fresh(), lane = tid & 63, wid = __builtin_amdgcn_readfirstlane(tid >> 6);
    const int bh = blockIdx.x; if (bh >= NB * 8) return;
    const int b = bh >> 3, h = bh & 7; const float* lf = p.out + O_LFP + (size_t)b * TSEQ * 8 + h;
    float c[4]; float run = 0.f;
#pragma unroll
    for (int e = 0; e < 4; ++e) { run += lf[(size_t)(4 * tid + e) * 8]; c[e] = run; }
    float tot; const float inc = block_scan(run, tot, (LAS float*)lds, lane, wid); const float exc = inc - run;
    float* cb = (float*)(p.ws + WS_CB) + (size_t)bh * TSEQ + 4 * tid;
    *(f32x4*)cb = (f32x4){exc + c[0], exc + c[1], exc + c[2], exc + c[3]};
}
__device__ __forceinline__ void p6_final(const Params& p, int vcu, int G) {
    const int tid = tid_fresh(), lane = tid & 63, wid = __builtin_amdgcn_readfirstlane(tid >> 6);
    const float* ss = (const float*)(p.ws + WS_SS2);
    f32x4 gf[4];
#pragma unroll
    for (int j = 0; j < 4; ++j) gf[j] = *(const f32x4*)(p.gfin + 4 * lane + 256 * j);
    for (int m = vcu * NWAVES + wid; m < MTOK; m += G * NWAVES) { const float r = 1.0f / sqrtf(ss[m] * (1.0f / DM) + 1e-6f); float* y = p.out + O_Y + (size_t)m * DM + 4 * lane;
#pragma unroll
        for (int j = 0; j < 4; ++j) { const f32x4 v = *(const f32x4*)(y + 256 * j); *(f32x4*)(y + 256 * j) = v * r * gf[j]; } }
}
#define XB_TMO      128
#define XB_XCNT(j)  (256  + 64 * (j))
#define XB_XSUB(j)  (1280 + 64 * (j))
#define XB_XGEN(j)  (2304 + 64 * (j))
#define XB_TOP      3328
#define XB_TOPGEN   3392
#define XCD_BAR_WORDS 3456
#define XB_SPIN_CAP (1u << 18)

__device__ __forceinline__ unsigned xb_ld(unsigned* p)              { return __hip_atomic_load(p, __ATOMIC_RELAXED, __HIP_MEMORY_SCOPE_AGENT); }
__device__ __forceinline__ unsigned xb_add(unsigned* p, unsigned v) { return __hip_atomic_fetch_add(p, v, __ATOMIC_RELAXED, __HIP_MEMORY_SCOPE_AGENT); }
__device__ __forceinline__ unsigned xb_xcc_id() { return (unsigned)__builtin_amdgcn_s_getreg((3 << 11) | 20) & 0xFu; }
#define XB_SPIN(cond, bar) do { unsigned _sp = 0; while (cond) { __builtin_amdgcn_s_sleep(1); \
    if ((++_sp & 255u) == 0u) { if (xb_ld(&(bar)[XB_TMO])) break; if (_sp > XB_SPIN_CAP) { atomicAdd(&(bar)[XB_TMO], 1u); break; } } } } while (0)

struct XcdBarrier {
    unsigned* bar; unsigned x;
    volatile LAS unsigned* st;
};

__device__ __forceinline__ XcdBarrier xcd_barrier_post(unsigned* bar, volatile LAS unsigned* st) {
    XcdBarrier b; b.bar = bar; b.x = xb_xcc_id(); b.st = st;
    if (threadIdx.x == 0) (void)xb_add(&bar[XB_XCNT(b.x)], 1u);
    return b;
}
__device__ __forceinline__ void xcd_barrier_complete(unsigned* bar, unsigned x, unsigned& nloc, unsigned& nx) {
    const unsigned G = gridDim.x * gridDim.y * gridDim.z;
    unsigned sum, cnt, mine, sp = 0u;
    for (;;) {
        sum = 0u; cnt = 0u; mine = 0u;
#pragma unroll
        for (unsigned j = 0; j < 16; ++j) { const unsigned c = xb_ld(&bar[XB_XCNT(j)]); sum += c; cnt += (c > 0u) ? 1u : 0u; mine = (j == x) ? c : mine; }
        if (sum == G) break;
        __builtin_amdgcn_s_sleep(1);
        if ((++sp & 255u) == 0u) { if (xb_ld(&bar[XB_TMO])) break; if (sp > XB_SPIN_CAP) { atomicAdd(&bar[XB_TMO], 1u); break; } }
    }
    nloc = mine > 0u ? mine : 1u; nx = cnt > 0u ? cnt : 1u;
}

__device__ __forceinline__ void xcd_barrier(const XcdBarrier& b) {
    asm volatile("s_waitcnt vmcnt(0)" ::: "memory");
    __syncthreads();
    if (threadIdx.x == 0) {
        unsigned* bar = b.bar;
        __builtin_amdgcn_s_waitcnt(0);
        unsigned nloc = b.st[0], nx = b.st[1];
        if (nloc == 0u) { xcd_barrier_complete(bar, b.x, nloc, nx); b.st[0] = nloc; b.st[1] = nx; }
        const unsigned old = xb_add(&bar[XB_XSUB(b.x)], 1u);
        const unsigned gen = old / nloc;
        if (old + 1u == (gen + 1u) * nloc) {
            __builtin_amdgcn_fence(__ATOMIC_RELEASE, "agent");
            asm volatile("s_waitcnt vmcnt(0)" ::: "memory");
            const unsigned og = xb_add(&bar[XB_TOP], 1u);
            const unsigned tg = og / nx;
            if (og + 1u == (tg + 1u) * nx) xb_add(&bar[XB_TOPGEN], 1u);
            else XB_SPIN(xb_ld(&bar[XB_TOPGEN]) == tg, bar);
            __builtin_amdgcn_fence(__ATOMIC_ACQUIRE, "agent");
            xb_add(&bar[XB_XGEN(b.x)], 1u);
            asm volatile("s_waitcnt vmcnt(0)" ::: "memory");
        } else {
            XB_SPIN(xb_ld(&bar[XB_XGEN(b.x)]) == gen, bar);
            __builtin_amdgcn_fence(__ATOMIC_ACQUIRE, "agent");
            asm volatile("s_waitcnt vmcnt(0)" ::: "memory");
        }
    }
    __syncthreads();
}
#ifndef RJ_SKIP
#define RJ_SKIP 0
#endif
#define MFMA32(a, b, c) __builtin_amdgcn_mfma_f32_32x32x16_bf16((a), (b), (c), 0, 0, 0)
__device__ __forceinline__ void ret_job(LAS unsigned char* lds, const Params& p_, const bool sample, const int b, const int h) {
    const Params p = fresh_params(p_);
    const int tid = tid_fresh(), lane = tid & 63, wid = __builtin_amdgcn_readfirstlane(tid >> 6), r32 = lane & 31, hi = lane >> 5;
    constexpr int PQK = 272, PT = 144;
    LAS unsigned char* Qr = lds; LAS unsigned char* Kr = lds + 17408; LAS unsigned char* Kdt = lds + 34816; LAS unsigned char* Vt = lds + 53248;
    LAS unsigned char* St = lds + 71680; LAS unsigned char* Am = lds + 106496; LAS f32x2* stats = (LAS f32x2*)(lds + 115712);
    const float lg2 = h == 0 ? -0.045803689613124746f : h == 1 ? -0.022720076500083907f : h == 2 ? -0.011315313227834146f : -0.005646563141142062f;
    const float cdec = __builtin_amdgcn_exp2f(lg2 * 64.0f);
    const int nch = sample ? 1 : TSEQ / 64; const size_t row0 = sample ? (size_t)MP + b * NSMP : (size_t)b * TSEQ;
    const bf16* Z = (const bf16*)(p.ws + WS_Z); bf16* MIX = (bf16*)(p.ws + WS_MIX);
    const int dkb = wid & 3, dvh = wid >> 2;
    f32x16 S0, S1;
    if (sample) { const float* sp = p.sr + (size_t)(b * 4 + h) * 16384 + 64 * dvh + r32;
#pragma unroll
        for (int r = 0; r < 16; ++r) { const int dk = 32 * dkb + crow(r, hi); S0[r] = sp[dk * 128]; S1[r] = sp[dk * 128 + 32]; } }
    else {
#pragma unroll
        for (int r = 0; r < 16; ++r) { S0[r] = 0.f; S1[r] = 0.f; } }
    u32x4 pq0, pq1, pk0, pk1, pv0, pv1; u32x2 pg[4];
#define RJ_LOAD(c_) do { const bf16* zr = Z + (row0 + (size_t)(c_) * 64 + 2 * (tid & 31)) * NZ + h * 128 + (tid >> 5) * 8; \
        pq0 = *(const u32x4*)zr; pq1 = *(const u32x4*)(zr + NZ); pk0 = *(const u32x4*)(zr + 512); pk1 = *(const u32x4*)(zr + NZ + 512); pv0 = *(const u32x4*)(zr + 1024); pv1 = *(const u32x4*)(zr + NZ + 1024); } while (0)
    RJ_LOAD(0);
    f32x4 gnv[4];
#pragma unroll
    for (int g = 0; g < 4; ++g) gnv[g] = *(const f32x4*)(p.gn + h * 128 + 32 * (wid >> 1) + 8 * g + 4 * hi);
    for (int c = 0; c < nch; ++c) {
        const size_t r0 = row0 + (size_t)c * 64;
#if !(RJ_SKIP & 1)
        { const int jp = tid & 31, ch = tid >> 5;
            *(LAS u32x4*)(Qr + (2 * jp) * PQK + ch * 16) = pq0; *(LAS u32x4*)(Qr + (2 * jp + 1) * PQK + ch * 16) = pq1;
            *(LAS u32x4*)(Kr + (2 * jp) * PQK + ch * 16) = pk0; *(LAS u32x4*)(Kr + (2 * jp + 1) * PQK + ch * 16) = pk1;
            const float kd0 = __builtin_amdgcn_exp2f(lg2 * (float)(63 - 2 * jp)), kd1 = __builtin_amdgcn_exp2f(lg2 * (float)(62 - 2 * jp));
#pragma unroll
            for (int e = 0; e < 8; ++e) { const unsigned a0 = pk0[e >> 1], a1 = pk1[e >> 1], b0 = pv0[e >> 1], b1 = pv1[e >> 1];
                const float f0 = (e & 1) ? __uint_as_float(a0 & 0xffff0000u) : __uint_as_float(a0 << 16), f1 = (e & 1) ? __uint_as_float(a1 & 0xffff0000u) : __uint_as_float(a1 << 16);
                *(LAS unsigned*)(Kdt + (ch * 8 + e) * PT + jp * 4) = pk2(f0 * kd0, f1 * kd1);
                *(LAS unsigned*)(Vt + (ch * 8 + e) * PT + jp * 4) = (e & 1) ? ((b0 >> 16) | (b1 & 0xffff0000u)) : ((b0 & 0xffffu) | (b1 << 16)); } }
#pragma unroll
        for (int g = 0; g < 4; ++g) { const int dk0 = 32 * dkb + 8 * g + 4 * hi;
            u32x2 w0, w1; w0.x = pk2(S0[4 * g], S0[4 * g + 1]); w0.y = pk2(S0[4 * g + 2], S0[4 * g + 3]); w1.x = pk2(S1[4 * g], S1[4 * g + 1]); w1.y = pk2(S1[4 * g + 2], S1[4 * g + 3]);
            *(LAS u32x2*)(St + (64 * dvh + r32) * PQK + dk0 * 2) = w0; *(LAS u32x2*)(St + (64 * dvh + 32 + r32) * PQK + dk0 * 2) = w1; }
        if (c + 1 < nch) RJ_LOAD(c + 1);
        { const bf16* grow = Z + (r0 + 32 * (wid & 1) + r32) * NZ + 1536 + h * 128 + 32 * (wid >> 1) + 4 * hi;
#pragma unroll
          for (int g = 0; g < 4; ++g) pg[g] = *(const u32x2*)(grow + 8 * g); }
#endif
        __syncthreads();
#if !(RJ_SKIP & 2)
        if (wid < 4) { const int jb = wid >> 1, ib = wid & 1; f32x16 a;
#pragma unroll
            for (int r = 0; r < 16; ++r) a[r] = 0.f;
#pragma unroll 2
            for (int ks = 0; ks < 8; ++ks) { const bf16x8 kf = *(const LAS bf16x8*)(Kr + (32 * jb + r32) * PQK + (16 * ks + 8 * hi) * 2), qf = *(const LAS bf16x8*)(Qr + (32 * ib + r32) * PQK + (16 * ks + 8 * hi) * 2);
                a = MFMA32(kf, qf, a); }
            const int i = 32 * ib + r32;
#pragma unroll
            for (int g = 0; g < 4; ++g) { const int j0 = 32 * jb + 8 * g + 4 * hi; float t[4];
#pragma unroll
                for (int e = 0; e < 4; ++e) t[e] = a[4 * g + e] * __builtin_amdgcn_exp2f(lg2 * fabsf((float)(i - (j0 + e))));
                u32x2 w; w.x = pk2(t[0], t[1]); w.y = pk2(t[2], t[3]); *(LAS u32x2*)(Am + i * PT + j0 * 2) = w; } }
#endif
        __syncthreads();
#if !(RJ_SKIP & 4)
        { const int dvb = wid >> 1, ib = wid & 1; f32x16 oi, ox;
#pragma unroll
            for (int r = 0; r < 16; ++r) { oi[r] = 0.f; ox[r] = 0.f; }
#pragma unroll
            for (int ks = 0; ks < 4; ++ks) { const bf16x8 vf = *(const LAS bf16x8*)(Vt + (32 * dvb + r32) * PT + (16 * ks + 8 * hi) * 2), af = *(const LAS bf16x8*)(Am + (32 * ib + r32) * PT + (16 * ks + 8 * hi) * 2);
                oi = MFMA32(vf, af, oi); }
#pragma unroll 2
            for (int ks = 0; ks < 8; ++ks) { const bf16x8 sf = *(const LAS bf16x8*)(St + (32 * dvb + r32) * PQK + (16 * ks + 8 * hi) * 2), qf = *(const LAS bf16x8*)(Qr + (32 * ib + r32) * PQK + (16 * ks + 8 * hi) * 2);
                ox = MFMA32(sf, qf, ox); }
            const int i = 32 * ib + r32; const float qd = __builtin_amdgcn_exp2f(lg2 * (float)(i + 1)); float s1 = 0.f, s2 = 0.f;
#pragma unroll
            for (int r = 0; r < 16; ++r) { oi[r] += ox[r] * qd; s1 += oi[r]; s2 += oi[r] * oi[r]; }
            s1 += __shfl_xor(s1, 32); s2 += __shfl_xor(s2, 32);
            if (hi == 0) stats[i * 4 + dvb] = (f32x2){s1, s2};
            __syncthreads();
            float m1 = 0.f, m2 = 0.f;
#pragma unroll
            for (int t = 0; t < 4; ++t) { const f32x2 st = stats[i * 4 + t]; m1 += st.x; m2 += st.y; }
            const float mu = m1 * (1.0f / 128.0f), var = fmaxf(m2 * (1.0f / 128.0f) - mu * mu, 0.f), rstd = 1.0f / sqrtf(var + 1e-5f);
            bf16* mrow = MIX + (r0 + i) * DM + h * 128;
#pragma unroll
            for (int g = 0; g < 4; ++g) { const int dv0 = 32 * dvb + 8 * g + 4 * hi; const u32x2 gw = pg[g]; const f32x4 gn = gnv[g];
                const float g0 = bf2f(gw.x & 0xffffu), g1 = bf2f(gw.x >> 16), g2 = bf2f(gw.y & 0xffffu), g3 = bf2f(gw.y >> 16);
                const float y0 = (oi[4 * g] - mu) * rstd * gn[0] * pg8::silu_f(g0), y1 = (oi[4 * g + 1] - mu) * rstd * gn[1] * pg8::silu_f(g1);
                const float y2 = (oi[4 * g + 2] - mu) * rstd * gn[2] * pg8::silu_f(g2), y3 = (oi[4 * g + 3] - mu) * rstd * gn[3] * pg8::silu_f(g3);
                u32x2 w; w.x = pk2(y0, y1); w.y = pk2(y2, y3); *(u32x2*)(mrow + dv0) = w; } }
#endif
#if !(RJ_SKIP & 8)
#pragma unroll
        for (int r = 0; r < 16; ++r) { S0[r] *= cdec; S1[r] *= cdec; }
#pragma unroll
        for (int ks = 0; ks < 4; ++ks) { const bf16x8 kdf = *(const LAS bf16x8*)(Kdt + (32 * dkb + r32) * PT + (16 * ks + 8 * hi) * 2);
            const bf16x8 v0 = *(const LAS bf16x8*)(Vt + (64 * dvh + r32) * PT + (16 * ks + 8 * hi) * 2), v1 = *(const LAS bf16x8*)(Vt + (64 * dvh + 32 + r32) * PT + (16 * ks + 8 * hi) * 2);
            S0 = MFMA32(kdf, v0, S0); S1 = MFMA32(kdf, v1, S1); }
#endif
        __syncthreads();
    }
#undef RJ_LOAD
    { float* so = p.out + (sample ? O_SRS : O_SRP) + (size_t)(b * 4 + h) * 16384 + 64 * dvh + r32;
#pragma unroll
        for (int r = 0; r < 16; ++r) { const int dk = 32 * dkb + crow(r, hi); so[dk * 128] = S0[r]; so[dk * 128 + 32] = S1[r]; } }
}

__device__ __forceinline__ void fox_sample_job(LAS unsigned char* lds, const Params& p_, const int b, const int h) {
    const Params p = fresh_params(p_);
    const int tid = tid_fresh(), lane = tid & 63, wid = __builtin_amdgcn_readfirstlane(tid >> 6), r32 = lane & 31, hi = lane >> 5;
    LAS float* ab = (LAS float*)lds;
    LAS float* scr = (LAS float*)(lds + 16640);
    LAS unsigned char* vtw = lds + 20480 + wid * 5120;
    { const float* clf = p.clf + (size_t)b * PAST * 8 + h; float v[8]; float tt = 0.f;
#pragma unroll
      for (int e = 0; e < 8; ++e) { v[e] = clf[(size_t)(8 * tid + e) * 8]; tt += v[e]; }
      float tot; const float inc = block_scan(tt, tot, scr, lane, wid); float suf = tot - inc;
#pragma unroll
      for (int e = 7; e >= 0; --e) { ab[8 * tid + e] = suf * LOG2E; suf += v[e]; }
      if (wid == 0) { float x = p.out[O_LFS + (size_t)(b * NSMP + lane) * 8 + h];
#pragma unroll
          for (int o = 1; o < 64; o <<= 1) { const float n = __shfl_up(x, o); if (lane >= o) x += n; }
          ab[PAST + lane] = -x * LOG2E; } }
    __syncthreads();
    const bf16* Zq = (const bf16*)(p.ws + WS_Z) + ((size_t)MP + b * NSMP) * NZ + 2048 + h * 64;
    bf16x8 qr[2][4];
#pragma unroll
    for (int qb = 0; qb < 2; ++qb)
#pragma unroll
        for (int d0 = 0; d0 < 4; ++d0) qr[qb][d0] = *(const bf16x8*)(Zq + (size_t)(32 * qb + r32) * NZ + 16 * d0 + 8 * hi);
    f32x16 o[2][2]; float mrun[2] = {-1e30f, -1e30f}, lrun[2] = {0.f, 0.f};
#pragma unroll
    for (int a = 0; a < 2; ++a)
#pragma unroll
        for (int c = 0; c < 2; ++c)
#pragma unroll
            for (int r = 0; r < 16; ++r) o[a][c][r] = 0.f;
    const size_t hoff = (size_t)h * 64;
    const float* ckb = p.ck + (size_t)b * PAST * 512 + hoff; const float* cvb = p.cv + (size_t)b * PAST * 512 + hoff;
    const float* nkb = p.out + O_FKS + (size_t)b * NSMP * 512 + hoff; const float* nvb = p.out + O_FVS + (size_t)b * NSMP * 512 + hoff;
    constexpr int NSTEP = PAST / 32 + 2;
    f32x4 kraw[8], vraw[8];
#define FS_LOAD(s_) do { const int s__ = (s_); const float* kp = s__ < PAST / 32 ? ckb + (size_t)s__ * 32 * 512 : nkb + (size_t)(s__ - PAST / 32) * 32 * 512; \
        const float* vp = s__ < PAST / 32 ? cvb + (size_t)s__ * 32 * 512 : nvb + (size_t)(s__ - PAST / 32) * 32 * 512; \
        _Pragma("unroll") for (int d0 = 0; d0 < 4; ++d0) { kraw[2 * d0] = *(const f32x4*)(kp + r32 * 512 + 16 * d0 + 8 * hi); kraw[2 * d0 + 1] = *(const f32x4*)(kp + r32 * 512 + 16 * d0 + 8 * hi + 4); } \
        _Pragma("unroll") for (int i = 0; i < 4; ++i) { const int pr = 4 * i + (lane >> 4); vraw[2 * i] = *(const f32x4*)(vp + (2 * pr) * 512 + 4 * (lane & 15)); vraw[2 * i + 1] = *(const f32x4*)(vp + (2 * pr + 1) * 512 + 4 * (lane & 15)); } } while (0)
    FS_LOAD(wid);
    for (int s = wid; s < NSTEP; s += NWAVES) {
        bf16x8 kf[4];
#pragma unroll
        for (int d0 = 0; d0 < 4; ++d0) { u32x4 w; w.x = pk2(kraw[2 * d0][0], kraw[2 * d0][1]); w.y = pk2(kraw[2 * d0][2], kraw[2 * d0][3]); w.z = pk2(kraw[2 * d0 + 1][0], kraw[2 * d0 + 1][1]); w.w = pk2(kraw[2 * d0 + 1][2], kraw[2 * d0 + 1][3]);
            kf[d0] = __builtin_bit_cast(bf16x8, w); }
#pragma unroll
        for (int i = 0; i < 4; ++i) { const int kap = 2 * (4 * i + (lane >> 4)); const int pos = (kap & ~12) | ((kap & 4) << 1) | ((kap & 8) >> 1);
#pragma unroll
            for (int e = 0; e < 4; ++e) *(LAS unsigned*)(vtw + (4 * (lane & 15) + e) * 80 + pos * 2) = pk2(vraw[2 * i][e], vraw[2 * i + 1][e]); }
        if (s + NWAVES < NSTEP) FS_LOAD(s + NWAVES);
        f32x16 sc[2];
#pragma unroll
        for (int qb = 0; qb < 2; ++qb) {
#pragma unroll
            for (int r = 0; r < 16; ++r) sc[qb][r] = 0.f;
#pragma unroll
            for (int d0 = 0; d0 < 4; ++d0) sc[qb] = MFMA32(kf[d0], qr[qb][d0], sc[qb]); }
        const int key0 = 32 * s;
#pragma unroll
        for (int g = 0; g < 4; ++g) { const f32x4 bv = *(const LAS f32x4*)(ab + key0 + 8 * g + 4 * hi);
#pragma unroll
            for (int e = 0; e < 4; ++e) { sc[0][4 * g + e] += bv[e]; sc[1][4 * g + e] += bv[e]; } }
        if (s >= PAST / 32) {
#pragma unroll
            for (int qb = 0; qb < 2; ++qb)
#pragma unroll
                for (int r = 0; r < 16; ++r) { const int kn = key0 - PAST + crow(r, hi); if (kn > 32 * qb + r32) sc[qb][r] = -INFINITY; } }
        bf16x8 pf[2][2];
#pragma unroll
        for (int qb = 0; qb < 2; ++qb) { float rm = sc[qb][0];
#pragma unroll
            for (int r = 1; r < 16; ++r) rm = fmaxf(rm, sc[qb][r]);
            rm = fmaxf(rm, __shfl_xor(rm, 32));
            const float mn = fmaxf(mrun[qb], rm), alpha = __builtin_amdgcn_exp2f(mrun[qb] - mn); mrun[qb] = mn; float ps = 0.f;
#pragma unroll
            for (int r = 0; r < 16; ++r) { const float e_ = __builtin_amdgcn_exp2f(sc[qb][r] - mn); sc[qb][r] = e_; ps += e_; }
            lrun[qb] = lrun[qb] * alpha + ps;
#pragma unroll
            for (int r = 0; r < 16; ++r) { o[qb][0][r] *= alpha; o[qb][1][r] *= alpha; }
#pragma unroll
            for (int ks = 0; ks < 2; ++ks) { u32x4 w; w.x = pk2(sc[qb][8 * ks], sc[qb][8 * ks + 1]); w.y = pk2(sc[qb][8 * ks + 2], sc[qb][8 * ks + 3]); w.z = pk2(sc[qb][8 * ks + 4], sc[qb][8 * ks + 5]); w.w = pk2(sc[qb][8 * ks + 6], sc[qb][8 * ks + 7]);
                pf[qb][ks] = __builtin_bit_cast(bf16x8, w); } }
#pragma unroll
        for (int db = 0; db < 2; ++db)
#pragma unroll
            for (int ks = 0; ks < 2; ++ks) { const bf16x8 vf = *(const LAS bf16x8*)(vtw + (32 * db + r32) * 80 + (16 * ks + 8 * hi) * 2);
                o[0][db] = MFMA32(vf, pf[0][ks], o[0][db]); o[1][db] = MFMA32(vf, pf[1][ks], o[1][db]); }
    }
#undef FS_LOAD
    lrun[0] += __shfl_xor(lrun[0], 32); lrun[1] += __shfl_xor(lrun[1], 32);
    bf16* MIX = (bf16*)(p.ws + WS_MIX);
#pragma unroll
    for (int qb = 0; qb < 2; ++qb) {
        __syncthreads();
        LAS float* cw = (LAS float*)(lds + wid * 8576);
        if (hi == 0) { cw[2080 + r32] = mrun[qb]; cw[2112 + r32] = lrun[qb]; }
#pragma unroll
        for (int db = 0; db < 2; ++db)
#pragma unroll
            for (int r = 0; r < 16; ++r) cw[r32 * 65 + 32 * db + crow(r, hi)] = o[qb][db][r];
        __syncthreads();
        const int q = tid >> 4, dg = tid & 15; float M = -3e38f;
#pragma unroll
        for (int w = 0; w < NWAVES; ++w) M = fmaxf(M, ((LAS float*)(lds + w * 8576))[2080 + q]);
        float L = 0.f, a0 = 0.f, a1 = 0.f, a2 = 0.f, a3 = 0.f;
#pragma unroll
        for (int w = 0; w < NWAVES; ++w) { LAS float* c = (LAS float*)(lds + w * 8576); const float wg = __builtin_amdgcn_exp2f(c[2080 + q] - M); L += wg * c[2112 + q];
            a0 += wg * c[q * 65 + 4 * dg]; a1 += wg * c[q * 65 + 4 * dg + 1]; a2 += wg * c[q * 65 + 4 * dg + 2]; a3 += wg * c[q * 65 + 4 * dg + 3]; }
        const float inv = 1.0f / L; u32x2 w; w.x = pk2(a0 * inv, a1 * inv); w.y = pk2(a2 * inv, a3 * inv);
        *(u32x2*)(MIX + ((size_t)MP + b * NSMP + 32 * qb + q) * DM + 512 + h * 64 + 4 * dg) = w;
    }
    __syncthreads();
}
constexpr int NJ_RETP = NB * 4, NJ_FS = NB * 8, NJ_FP = NB * 8 * (TSEQ / 256), NJ_RETS = NB * 4, NJOBS = NJ_RETP + NJ_FS + NJ_FP + NJ_RETS;
__global__ void __launch_bounds__(NTHR, 2) hybrid_fwd(Params p) {
    extern __shared__ __attribute__((aligned(16))) unsigned char lds_raw[];
    LAS unsigned char* lds = (LAS unsigned char*)lds_raw;
    cg::grid_group grid = cg::this_grid();
    const int G = gridDim.x, bx = blockIdx.x, vcu = (G % 8 == 0) ? (bx % 8) * (G / 8) + bx / 8 : bx;
    unsigned char* ws = p.ws;
    volatile LAS unsigned* MISCU = (volatile LAS unsigned*)(lds + MISC_OFF);
    if (threadIdx.x < 32) MISCU[threadIdx.x] = 0u;
    __syncthreads();
    bf16* XN = (bf16*)(ws + WS_XN); bf16* MIX = (bf16*)(ws + WS_MIX); bf16* Z = (bf16*)(ws + WS_Z); bf16* H = (bf16*)(ws + WS_H);
    float* SS1 = (float*)(ws + WS_SS1); float* SS2 = (float*)(ws + WS_SS2);

#ifndef PHMASK
#define PHMASK 0xffff
#endif
#ifdef TSPROBE
    unsigned long long* TS = (unsigned long long*)(ws + WS_CTL + 600 * 1024);
#define STAMP(k) do { if (blockIdx.x == 0 && threadIdx.x == 0) TS[k] = __builtin_amdgcn_s_memrealtime(); } while (0)
#else
#define STAMP(k) do {} while (0)
#endif
#ifdef TSPROBE
    grid.sync(); STAMP(0);
#endif
#ifndef REP_P0
#define REP_P0 1
#endif
    for (int rep0 = 0; rep0 < REP_P0; ++rep0) { p0_prep(p, lds, vcu, G); if (rep0 + 1 < REP_P0) grid.sync(); }
    grid.sync(); STAMP(1);
    const XcdBarrier xbar = xcd_barrier_post((unsigned*)(ws + WS_CTL) + 4096, MISCU + 8);
#ifdef REP_SYNC
    for (int i = 0; i < REP_SYNC; ++i) grid.sync();
#endif
    if (PHMASK & 2) p1_cumsum(p, lds);
    __syncthreads();
#ifndef REP_P1
#define REP_P1 1
#endif
    for (int rep1 = 0; rep1 < REP_P1; ++rep1) { pg8::Gemm g{XN, (const bf16*)(ws + WS_WIN), MTOK, NZ, DM}; pg8::StaticOrder S; S.init(MTOK, NZ, G, bx);
      pg8::EpiInProj E{Z, p.out, (const float*)(ws + WS_CS)};
      pg8::gemm_phase<pg8::EpiInProj, pg8::StaticOrder, true, true>(lds, g, S, E); if (rep1 + 1 < REP_P1) grid.sync(); }
    xcd_barrier(xbar); STAMP(2);
#ifndef REP_P2
#define REP_P2 1
#endif
    for (int rep2 = 0; rep2 < REP_P2; ++rep2) { unsigned* ctr = (unsigned*)(ws + WS_CTL) + 16 * rep2; volatile LAS int* MISC = (volatile LAS int*)(lds + MISC_OFF);
      for (;;) {
          if (tid_fresh() == 0) MISC[0] = (int)atomicAdd(ctr, 1u);
          __syncthreads();
          const int job = __builtin_amdgcn_readfirstlane(MISC[0]);
          __syncthreads();
          if (job >= NJOBS) break;
          if (job < NJ_RETP) { if (PHMASK & 8) ret_job(lds, p, false, job >> 2, job & 3); }
          else if (job < NJ_RETP + NJ_FS) { const int j = job - NJ_RETP; if (PHMASK & 16) fox_sample_job(lds, p, j >> 3, j & 7); }
          else if (job < NJ_RETP + NJ_FS + NJ_FP) { const Params q = fresh_params(p); bf16* Z = (bf16*)(q.ws + WS_Z); bf16* MIX = (bf16*)(q.ws + WS_MIX); unsigned char* ws = q.ws; const int j = job - NJ_RETP - NJ_FS; const int qb = (TSEQ / 256 - 1) - (j >> 7), bh = j & 127;
              if (PHMASK & 32) attn_body::attn_unit<8>(bh >> 3, bh & 7, qb, (const attn_body::bf16*)(Z + 2048), (const attn_body::bf16*)(Z + 2560), (const attn_body::bf16*)(Z + 3072),
                                      (attn_body::bf16*)(MIX + 512), (const float*)(ws + WS_CB), (char*)lds_raw); }
          else { const int j = job - NJ_RETP - NJ_FS - NJ_FP; if (PHMASK & 8) ret_job(lds, p, true, j >> 2, j & 3); }
          __syncthreads();
      }
      if (rep2 + 1 < REP_P2) grid.sync(); }
    xcd_barrier(xbar); STAMP(3);
#ifndef REP_P3
#define REP_P3 1
#endif
    for (int rep3 = 0; rep3 < REP_P3; ++rep3) { pg8::Gemm g{MIX, (const bf16*)(ws + WS_WO), MTOK, DM, DM}; pg8::StaticOrder S; S.init(MTOK, DM, G, bx);
      pg8::EpiResid E{p.xp, p.xs, p.out + O_Y, XN, rep3 ? (float*)(ws + WS_CTL + 640 * 1024) : SS1};
      pg8::gemm_phase<pg8::EpiResid, pg8::StaticOrder, true, true>(lds, g, S, E); if (rep3 + 1 < REP_P3) grid.sync(); }
    xcd_barrier(xbar); STAMP(4);
#ifndef REP_P4
#define REP_P4 1
#endif
    for (int rep4 = 0; rep4 < REP_P4; ++rep4) { pg8::Gemm g{XN, (const bf16*)(ws + WS_WGU), MTOK, NGU, DM}; pg8::StaticOrder S; S.init(MTOK, NGU, G, bx);
      pg8::EpiGateUp E{H, SS1};
      pg8::gemm_phase<pg8::EpiGateUp, pg8::StaticOrder, true, true>(lds, g, S, E); if (rep4 + 1 < REP_P4) grid.sync(); }
    xcd_barrier(xbar); STAMP(5);
#ifndef REP_P5
#define REP_P5 1
#endif
    for (int rep5 = REP_P5 - 1; rep5 >= 0; --rep5) { pg8::Gemm g{H, (const bf16*)(ws + WS_WD), MTOK, DM, DFF}; pg8::StaticOrder S; S.init(MTOK, DM, G, bx);
      pg8::EpiResid E{rep5 ? p.out + O_Y : nullptr, rep5 ? p.out + O_Y + (size_t)MP * DM : nullptr, rep5 ? (float*)(ws + WS_MIX) - (size_t)MTOK * DM / 2 : p.out + O_Y, nullptr, rep5 ? (float*)(ws + WS_CTL + 640 * 1024) : SS2};
      pg8::gemm_phase<pg8::EpiResid, pg8::StaticOrder, true, true>(lds, g, S, E); if (rep5 > 0) grid.sync(); }
    xcd_barrier(xbar); STAMP(6);
    if (PHMASK & 512) p6_final(p, vcu, G);
#ifdef TSPROBE
    grid.sync(); STAMP(7);
    grid.sync(); STAMP(8);
    grid.sync();
    { const size_t offs[9] = {O_SRP, O_FKP, O_FVP, O_LFP, O_SRS, O_FKS, O_FVS, O_LFS, O_END};
      for (int j = 0; j < 8; ++j) { const float dt_us = (float)(TS[j + 1] - TS[j]) * 0.01f; const float f = 1.0f + dt_us * 0.001f;
          for (size_t i = offs[j] + (size_t)blockIdx.x * NTHR + threadIdx.x; i < offs[j + 1]; i += (size_t)G * NTHR) p.out[i] *= f; } }
#endif
}

extern "C" void kernel_launch(void* const* d_in, const int* in_sizes, int n_in, void* d_out, int out_size, void* d_ws, size_t ws_size, hipStream_t stream) {
    static int grid = 0;
    if (grid == 0) {
        if (n_in != 16 || out_size != (int)O_END || ws_size < WS_END) { fprintf(stderr, "kernel_launch: unexpected shapes (n_in %d, out %d, ws %zu); nothing launched\n", n_in, out_size, ws_size); grid = -1; return; }
        int dev = 0, cus = 0, per_cu = 0;
        if (hipGetDevice(&dev) != hipSuccess || hipDeviceGetAttribute(&cus, hipDeviceAttributeMultiprocessorCount, dev) != hipSuccess) { grid = -1; return; }
        if (hipFuncSetAttribute((const void*)hybrid_fwd, hipFuncAttributeMaxDynamicSharedMemorySize, LDS_BYTES) != hipSuccess) { fprintf(stderr, "kernel_launch: hipFuncSetAttribute failed\n"); grid = -1; return; }
        if (hipOccupancyMaxActiveBlocksPerMultiprocessor(&per_cu, (const void*)hybrid_fwd, NTHR, LDS_BYTES) != hipSuccess || per_cu < 1) { fprintf(stderr, "kernel_launch: occupancy query says %d blocks per CU\n", per_cu); per_cu = 1; }
        (void)hipGetLastError();
        grid = cus * per_cu;
    }
    if (grid < 0) return;
    Params p{};
    p.xp = (const float*)d_in[0]; p.xs = (const float*)d_in[1]; p.ck = (const float*)d_in[2]; p.cv = (const float*)d_in[3]; p.clf = (const float*)d_in[4]; p.sr = (const float*)d_in[5];
    p.win = (const float*)d_in[6]; p.bfg = (const float*)d_in[7]; p.gn = (const float*)d_in[8]; p.wout = (const float*)d_in[9]; p.gmix = (const float*)d_in[10]; p.gffn = (const float*)d_in[11];
    p.wg = (const float*)d_in[12]; p.wu = (const float*)d_in[13]; p.wd = (const float*)d_in[14]; p.gfin = (const float*)d_in[15];
    p.out = (float*)d_out; p.ws = (unsigned char*)d_ws;
    void* args[] = {&p};
    const hipError_t e = hipLaunchCooperativeKernel((const void*)hybrid_fwd, dim3(grid), dim3(NTHR), args, LDS_BYTES, stream);
    if (e != hipSuccess) fprintf(stderr, "kernel_launch: cooperative launch failed: %s (grid %d)\n", hipGetErrorString(e), grid);
}
```

```cpp
#include <hip/hip_runtime.h>
#include <hip/hip_cooperative_groups.h>
#include <hip/hip_bf16.h>
#include <cstdio>
#include <cstdint>
#include <cmath>
namespace cg = cooperative_groups;

constexpr int DM = 1024, NB = 16, TSEQ = 2048, MP = NB * TSEQ, NSMP = 64, MS = NB * NSMP, MTOK = MP + MS, PAST = 4096;
constexpr int DIN = 3592, NZ = 3584, DFF = 2816, NGU = 2 * DFF;
constexpr size_t O_Y = 0, O_SRP = (size_t)MTOK * DM, O_FKP = O_SRP + 1048576, O_FVP = O_FKP + 16777216, O_LFP = O_FVP + 16777216, O_SRS = O_LFP + 262144,
                 O_FKS = O_SRS + 1048576, O_FVS = O_FKS + 524288, O_LFS = O_FVS + 524288, O_END = O_LFS + 8192;
constexpr size_t MiB = 1u << 20;
constexpr size_t WS_CTL = 0, WS_SS1 = 64 * 1024, WS_SS2 = 256 * 1024, CTL_BYTES = 512 * 1024;
constexpr size_t WS_CS = 1 * MiB, WS_CB = 3 * MiB, WS_WIN = 4 * MiB, WS_WO = 11 * MiB, WS_WGU = 13 * MiB, WS_WD = 24 * MiB;
constexpr size_t WS_XN = 32 * MiB, WS_MIX = 98 * MiB, WS_Z = 164 * MiB, WS_H = WS_Z, WS_END = 395 * MiB;
constexpr float C2F = 0.125f * 1.4426950408889634f;

struct Params {
    const float *xp, *xs, *ck, *cv, *clf, *sr, *win, *bfg, *gn, *wout, *gmix, *gffn, *wg, *wu, *wd, *gfin;
    float* out; unsigned char* ws;
};

__device__ __forceinline__ int tid_fresh() { int t = threadIdx.x; asm volatile("" : "+v"(t)); return t; }

__device__ __forceinline__ Params fresh_params(const Params& p) {
    Params q = p;
    asm volatile("" : "+s"(q.out), "+s"(q.ws), "+s"(q.ck), "+s"(q.cv), "+s"(q.clf), "+s"(q.sr), "+s"(q.gn));
    return q;
}

namespace pg8 {
#define PG8_LAS __attribute__((address_space(3)))
typedef unsigned short bf16_t;
typedef short bf16x8 __attribute__((ext_vector_type(8)));
typedef float f32x4 __attribute__((ext_vector_type(4)));
typedef unsigned u32x4 __attribute__((ext_vector_type(4)));
constexpr int BM = 256, BK = 64, HALF = 128, HTB = HALF * BK * 2  , STAGE_BYTES = 8 * HTB, NXCD = 8, WGM = 8;

__host__ __device__ __forceinline__ int lds_byte(int r, int c) { const int st = (r >> 4) * 2 + (c >> 5), rr = r & 15, cc = c & 31, ob = rr * 64 + cc * 2; return st * 1024 + (ob ^ (((ob >> 9) & 1) << 5)); }
__host__ __device__ __forceinline__ void stage_rc(int b, int& R, int& C) { const int st = b / 1024, sb = b % 1024, swz = sb ^ (((sb >> 9) & 1) << 5); R = (st >> 1) * 16 + swz / 64; C = (st & 1) * 32 + (swz % 64) / 2; }
__host__ __device__ __forceinline__ int perm32(int rho) { const int n = rho >> 4, i = rho & 15; return 8 * (i >> 2) + 4 * n + (i & 3); }

struct Unit { int pm, pn; };
struct Gemm { const bf16_t* A; const bf16_t* Bt; int M, N, K, ld; };

struct StaticOrder {
    int nM, nN, nwg, G, c;
    __host__ __device__ void init(int M, int N, int G_, int c_) { nM = M / BM; nN = N / BM; nwg = nM * nN; G = G_; c = c_; }
    __host__ __device__ bool next(int i, Unit& u) const {
        const long L = (long)i * G + c; if (L >= nwg) return false;
        int wgid = (int)L; { const int q = nwg / NXCD, r = nwg % NXCD, xcd = wgid % NXCD, off = wgid / NXCD; wgid = (xcd < r ? xcd * (q + 1) : r * (q + 1) + (xcd - r) * q) + off; }
        const int nig = WGM * nN, gid = wgid / nig, fm = gid * WGM, gsz = (nM - fm) < WGM ? (nM - fm) : WGM;
        u.pm = fm + ((wgid % nig) % gsz); u.pn = (wgid % nig) / gsz; return true;
    }
    __device__ __forceinline__ void a_ready(const Unit&) const {}
    __device__ __forceinline__ void done(const Unit&) const {}
};


struct OneUnit { int pm, pn;
    __device__ __forceinline__ bool next(int i, Unit& u) const { if (i) return false; u.pm = pm; u.pn = pn; return true; }
    __device__ __forceinline__ void a_ready(const Unit&) const {}
    __device__ __forceinline__ void done(const Unit&) const {}
};
typedef float f32x2 __attribute__((ext_vector_type(2)));
typedef __bf16 bf16x2_t __attribute__((ext_vector_type(2)));
typedef unsigned u32x2 __attribute__((ext_vector_type(2)));
__device__ __forceinline__ unsigned cvt_pk_bf16(float lo, float hi) { f32x2 v = {lo, hi}; bf16x2_t b = __builtin_convertvector(v, bf16x2_t); return __builtin_bit_cast(unsigned, b); }
__device__ __forceinline__ float silu_f(float x) { return x * __builtin_amdgcn_rcpf(1.f + __builtin_amdgcn_exp2f(x * -1.4426950408889634f)); }

struct EpiInProj {
    static constexpr bool PERM = true, AFTER_DRAIN = false;
    bf16_t* Z; float* out; const float* cs;
    __device__ __forceinline__ void operator()(const f32x4 (&acc)[2][2][4][2], const Unit& u, int wr, int wc, int fr, int fq) const {
        const int pn = u.pn, row0 = u.pm * BM + wr * 64 + fr; const bool prompt = u.pm < (MP / BM);
        if (pn < 4) {
            const float sc = pn < 2 ? 0.08838834764831845f : 1.f; const int d0 = 16 * wc + 4 * fq;
#pragma unroll
            for (int ai = 0; ai < 2; ++ai)
#pragma unroll
                for (int m = 0; m < 4; ++m) { const int row = row0 + ai * HALF + m * 16; const int tix = prompt ? (row & (TSEQ - 1)) : TSEQ + ((row - MP) & (NSMP - 1));
                    const float* cr = cs + (size_t)tix * 128 + 2 * d0; const f32x4 c01 = *(const f32x4*)cr, c23 = *(const f32x4*)(cr + 4);
                    bf16_t* zrow = Z + (size_t)row * NZ + pn * BM + d0;
#pragma unroll
                    for (int bj = 0; bj < 2; ++bj) { const f32x4 v0 = acc[ai][bj][m][0], v1 = acc[ai][bj][m][1];
                        const float a0 = (v0[0] * c01[0] - v0[1] * c01[1]) * sc, b0 = (v0[0] * c01[1] + v0[1] * c01[0]) * sc;
                        const float a1 = (v0[2] * c01[2] - v0[3] * c01[3]) * sc, b1 = (v0[2] * c01[3] + v0[3] * c01[2]) * sc;
                        const float a2 = (v1[0] * c23[0] - v1[1] * c23[1]) * sc, b2 = (v1[0] * c23[1] + v1[1] * c23[0]) * sc;
                        const float a3 = (v1[2] * c23[2] - v1[3] * c23[3]) * sc, b3 = (v1[2] * c23[3] + v1[3] * c23[2]) * sc;
                        u32x2 w1, w2; w1.x = cvt_pk_bf16(a0, a1); w1.y = cvt_pk_bf16(a2, a3); w2.x = cvt_pk_bf16(b0, b1); w2.y = cvt_pk_bf16(b2, b3);
                        *(u32x2*)(zrow + bj * HALF) = w1; *(u32x2*)(zrow + bj * HALF + 64) = w2; } }
        } else {
            const float sc = (pn == 8 || pn == 9) ? C2F : 1.f; const int cw = wc * 32 + 8 * fq;
            float* fo = nullptr; size_t fstride = 512;
            if (pn >= 10) { const bool isv = pn >= 12; const int cb = (pn - (isv ? 12 : 10)) * BM + cw;
                fo = prompt ? out + (isv ? O_FVP : O_FKP) + (size_t)row0 * 512 + cb : out + (isv ? O_FVS : O_FKS) + (size_t)(row0 - MP) * 512 + cb; }
#pragma unroll
            for (int ai = 0; ai < 2; ++ai)
#pragma unroll
                for (int m = 0; m < 4; ++m) { bf16_t* rowp = Z + (size_t)(row0 + ai * HALF + m * 16) * NZ + pn * BM + cw; float* fr_ = fo + (size_t)(ai * HALF + m * 16) * fstride;
#pragma unroll
                    for (int bj = 0; bj < 2; ++bj) { const f32x4 v0 = acc[ai][bj][m][0] * sc, v1 = acc[ai][bj][m][1] * sc;
                        u32x4 w; w.x = cvt_pk_bf16(v0[0], v0[1]); w.y = cvt_pk_bf16(v0[2], v0[3]); w.z = cvt_pk_bf16(v1[0], v1[1]); w.w = cvt_pk_bf16(v1[2], v1[3]);
                        *(u32x4*)(rowp + bj * HALF) = w;
                        if (fo) { *(f32x4*)(fr_ + bj * HALF) = v0; *(f32x4*)(fr_ + bj * HALF + 4) = v1; } } }
        }
    }
};
struct EpiResid {
    static constexpr bool PERM = false, AFTER_DRAIN = false;
    const float* xp; const float* xs; float* Y; bf16_t* Yb; float* ss;
    __device__ __forceinline__ void operator()(const f32x4 (&acc)[2][2][4][2], const Unit& u, int wr, int wc, int fr, int fq) const {
        const int row0 = u.pm * BM + wr * 64 + fr, col0 = u.pn * BM + wc * 32 + 4 * fq; const bool prompt = u.pm < (MP / BM);
#pragma unroll
        for (int ai = 0; ai < 2; ++ai)
#pragma unroll
            for (int m = 0; m < 4; ++m) { const int row = row0 + ai * HALF + m * 16; float* yr = Y + (size_t)row * DM + col0;
                const float* br = xp ? (prompt ? xp + (size_t)row * DM + col0 : xs + (size_t)(row - MP) * DM + col0) : yr; float s = 0.f;
#pragma unroll
                for (int bj = 0; bj < 2; ++bj)
#pragma unroll
                    for (int n = 0; n < 2; ++n) { const int co = bj * HALF + n * 16; const f32x4 v = acc[ai][bj][m][n] + *(const f32x4*)(br + co); *(f32x4*)(yr + co) = v;
                        s += (v[0] * v[0] + v[1] * v[1]) + (v[2] * v[2] + v[3] * v[3]);
                        if (Yb) { u32x2 w; w.x = cvt_pk_bf16(v[0], v[1]); w.y = cvt_pk_bf16(v[2], v[3]); *(u32x2*)(Yb + (size_t)row * DM + col0 + co) = w; } }
                if (ss) { s += __shfl_xor(s, 16); s += __shfl_xor(s, 32); }
                if (ss && fq == 0) atomicAdd(ss + row, s); }
    }
};
struct EpiGateUp {
    static constexpr bool PERM = true, AFTER_DRAIN = false;
    bf16_t* H; const float* ss;
    __device__ __forceinline__ void operator()(const f32x4 (&acc)[2][2][4][2], const Unit& u, int wr, int wc, int fr, int fq) const {
        const int row0 = u.pm * BM + wr * 64 + fr, f0 = u.pn * 128 + wc * 16 + 4 * fq;
#pragma unroll
        for (int ai = 0; ai < 2; ++ai)
#pragma unroll
            for (int m = 0; m < 4; ++m) { const int row = row0 + ai * HALF + m * 16; const float r = 1.0f / sqrtf(ss[row] * (1.0f / DM) + 1e-6f);
#pragma unroll
                for (int bj = 0; bj < 2; ++bj) { const f32x4 v0 = acc[ai][bj][m][0] * r, v1 = acc[ai][bj][m][1] * r;
                    u32x2 w; w.x = cvt_pk_bf16(silu_f(v0[0]) * v0[1], silu_f(v0[2]) * v0[3]); w.y = cvt_pk_bf16(silu_f(v1[0]) * v1[1], silu_f(v1[2]) * v1[3]);
                    *(u32x2*)(H + (size_t)row * DFF + f0 + bj * 64) = w; } }
    }
};

struct EpiAtomic {
    static constexpr bool PERM = false, AFTER_DRAIN = false;
    float* Y;
    __device__ __forceinline__ void operator()(const f32x4 (&acc)[2][2][4][2], const Unit& u, int wr, int wc, int fr, int fq) const {
        const int row0 = u.pm * BM + wr * 64 + fr, col0 = u.pn * BM + wc * 32 + 4 * fq;
#pragma unroll
        for (int ai = 0; ai < 2; ++ai)
#pragma unroll
            for (int m = 0; m < 4; ++m) { float* yr = Y + (size_t)(row0 + ai * HALF + m * 16) * DM + col0;
#pragma unroll
                for (int bj = 0; bj < 2; ++bj)
#pragma unroll
                    for (int n = 0; n < 2; ++n) { const f32x4 v = acc[ai][bj][m][n]; float* y = yr + bj * HALF + n * 16;
#pragma unroll
                        for (int e = 0; e < 4; ++e) __hip_atomic_fetch_add(y + e, v[e], __ATOMIC_RELAXED, __HIP_MEMORY_SCOPE_AGENT); } }
    }
};

template <class Epi, class Sched, bool ALIGN_EPI = false, bool SP2 = false>
__device__ __forceinline__ void gemm_phase(PG8_LAS unsigned char* lds, const Gemm g, const Sched& S, const Epi& E) {
    const int tid = tid_fresh(), wid = __builtin_amdgcn_readfirstlane(tid >> 6), lane = tid & 63, wr = wid >> 2, wc = wid & 3, fr = lane & 15, fq = lane >> 4;
    const int K = g.ld, nt = g.K / BK;
    unsigned voffA[2], voffB[2];
#pragma unroll
    for (int i = 0; i < 2; ++i) { int R, C; stage_rc(tid * 16 + i * 8192, R, C); const int Rb = Epi::PERM ? ((R & ~31) + perm32(R & 31)) : R;
        voffA[i] = (unsigned)(R * K + C) * 2u; voffB[i] = (unsigned)(Rb * K + C) * 2u; }
    const size_t kstep = (size_t)(BK * 2);
    const size_t hstep = (size_t)HALF * K * 2;
    const size_t tstep = 2 * hstep;
    const unsigned ldsw = (unsigned)wid * 1024u;
    const int aoff = lds_byte(wr * 64 + fr, fq * 8), boff = lds_byte(wc * 32 + fr, fq * 8);
#define PG8_SA(b, h) (((b) * 2 + (h)) * HTB)
#define PG8_SB(b, h) ((4 + (b) * 2 + (h)) * HTB)
#define PG8_STAGE(bufoff, gbase, voff) do { _Pragma("unroll") for (int _i = 0; _i < 2; ++_i) \
        __builtin_amdgcn_global_load_lds((const unsigned*)((const char*)(gbase) + (voff)[_i]), (PG8_LAS unsigned*)(lds + (bufoff) + ldsw + _i * 8192), 16, 0, 0); } while (0)
#define PG8_LDA(dst, b, h) do { _Pragma("unroll") for (int m = 0; m < 4; ++m) _Pragma("unroll") for (int k = 0; k < 2; ++k) dst[m][k] = *(const PG8_LAS bf16x8*)(lds + PG8_SA(b, h) + aoff + m * 2048 + k * 1024); } while (0)
#define PG8_LDB(dst, b, h) do { _Pragma("unroll") for (int n = 0; n < 2; ++n) _Pragma("unroll") for (int k = 0; k < 2; ++k) dst[n][k] = *(const PG8_LAS bf16x8*)(lds + PG8_SB(b, h) + boff + n * 2048 + k * 1024); } while (0)
#define PG8_MMA(ai, bj, At, Bt) do { __builtin_amdgcn_s_setprio(1); _Pragma("unroll") for (int m = 0; m < 4; ++m) _Pragma("unroll") for (int n = 0; n < 2; ++n) _Pragma("unroll") for (int k = 0; k < 2; ++k) \
        acc[ai][bj][m][n] = __builtin_amdgcn_mfma_f32_16x16x32_bf16(Bt[n][k], At[m][k], acc[ai][bj][m][n], 0, 0, 0); __builtin_amdgcn_s_setprio(0); } while (0)
#define PG8_WAIT_V(n) asm volatile("s_waitcnt vmcnt(" #n ")" ::: "memory")
#define PG8_WAIT_L(n) asm volatile("s_waitcnt lgkmcnt(" #n ")" ::: "memory")
#define PG8_BAR __builtin_amdgcn_s_barrier()
#define PG8_SCHED __builtin_amdgcn_sched_barrier(0)
    Unit cur, nxt; int ui = 0;
    if (!S.next(0, cur)) return;
    f32x4 acc[2][2][4][2];
#pragma unroll
    for (int a = 0; a < 2; ++a)
#pragma unroll
        for (int b = 0; b < 2; ++b)
#pragma unroll
            for (int m = 0; m < 4; ++m)
#pragma unroll
                for (int n = 0; n < 2; ++n) acc[a][b][m][n] = (f32x4){0.f, 0.f, 0.f, 0.f};
    bf16x8 At[4][2], B0[2][2], B1[2][2];
    const char* cA = (const char*)g.A + (size_t)cur.pm * tstep; const char* cB = (const char*)g.Bt + (size_t)cur.pn * tstep;
    S.a_ready(cur);
    if constexpr (SP2) {
        PG8_STAGE(PG8_SB(0, 0), cB, voffB); PG8_STAGE(PG8_SB(0, 1), cB + hstep, voffB); PG8_STAGE(PG8_SA(0, 0), cA, voffA); PG8_STAGE(PG8_SA(0, 1), cA + hstep, voffA);
        if (wr == 1) PG8_BAR;
        PG8_WAIT_V(2); PG8_BAR;
        PG8_STAGE(PG8_SB(1, 0), cB + kstep, voffB); PG8_STAGE(PG8_SA(1, 0), cA + kstep, voffA); PG8_STAGE(PG8_SB(1, 1), cB + hstep + kstep, voffB);
        PG8_WAIT_V(6); PG8_BAR;
    } else {
        PG8_STAGE(PG8_SB(0, 0), cB, voffB); PG8_STAGE(PG8_SA(0, 0), cA, voffA); PG8_STAGE(PG8_SB(0, 1), cB + hstep, voffB); PG8_STAGE(PG8_SA(0, 1), cA + hstep, voffA);
        if (wr == 1) PG8_BAR;
        PG8_WAIT_V(4); PG8_BAR;
        PG8_STAGE(PG8_SB(1, 0), cB + kstep, voffB); PG8_STAGE(PG8_SA(1, 0), cA + kstep, voffA); PG8_STAGE(PG8_SB(1, 1), cB + hstep + kstep, voffB);
        PG8_WAIT_V(6); PG8_BAR;
    }
    for (;;) {
        const bool has_next = S.next(ui + 1, nxt);
        const char* nA = has_next ? (const char*)g.A + (size_t)nxt.pm * tstep : cA; const char* nB = has_next ? (const char*)g.Bt + (size_t)nxt.pn * tstep : cB;
        for (int t = 0; t < nt; t += 2) {
            const bool last = (t == nt - 2);
            const char* a1 = cA + (size_t)(t + 1) * kstep;
            const char* a2 = last ? nA : cA + (size_t)(t + 2) * kstep; const char* b2 = last ? nB : cB + (size_t)(t + 2) * kstep;
            const char* a3 = a2 + kstep; const char* b3 = b2 + kstep;
            if (last && has_next) S.a_ready(nxt);
            if constexpr (SP2) {
            PG8_LDB(B0, 0, 0); PG8_LDB(B1, 0, 1); PG8_SCHED; PG8_LDA(At, 0, 0); PG8_STAGE(PG8_SA(1, 1), a1 + hstep, voffA);
            PG8_WAIT_V(8); PG8_WAIT_L(0); PG8_BAR; PG8_MMA(0, 0, At, B0); PG8_MMA(0, 1, At, B1); PG8_BAR; PG8_SCHED;
            PG8_LDA(At, 0, 1); PG8_STAGE(PG8_SB(0, 0), b2, voffB); PG8_STAGE(PG8_SB(0, 1), b2 + hstep, voffB); PG8_STAGE(PG8_SA(0, 0), a2, voffA);
            PG8_WAIT_V(8); PG8_WAIT_L(0); PG8_BAR; PG8_MMA(1, 0, At, B0); PG8_MMA(1, 1, At, B1); PG8_BAR; PG8_SCHED;
            PG8_LDB(B0, 1, 0); PG8_LDB(B1, 1, 1); PG8_SCHED; PG8_LDA(At, 1, 0); PG8_STAGE(PG8_SA(0, 1), a2 + hstep, voffA);
            PG8_WAIT_V(8); PG8_WAIT_L(0); PG8_BAR; PG8_MMA(0, 0, At, B0); PG8_MMA(0, 1, At, B1); PG8_BAR; PG8_SCHED;
            PG8_LDA(At, 1, 1); PG8_STAGE(PG8_SB(1, 0), b3, voffB); PG8_STAGE(PG8_SB(1, 1), b3 + hstep, voffB); PG8_STAGE(PG8_SA(1, 0), a3, voffA);
            PG8_WAIT_V(8); PG8_WAIT_L(0); PG8_BAR; PG8_MMA(1, 0, At, B0); PG8_MMA(1, 1, At, B1); PG8_BAR; PG8_SCHED;
            } else {
            PG8_LDB(B0, 0, 0); PG8_SCHED; PG8_LDA(At, 0, 0); PG8_STAGE(PG8_SA(1, 1), a1 + hstep, voffA);
            PG8_WAIT_L(8); PG8_BAR; PG8_WAIT_L(0); PG8_MMA(0, 0, At, B0); PG8_BAR; PG8_SCHED;
            PG8_LDB(B1, 0, 1); PG8_STAGE(PG8_SB(0, 0), b2, voffB);
            PG8_BAR; PG8_WAIT_L(0); PG8_MMA(0, 1, At, B1); PG8_BAR;
            PG8_LDA(At, 0, 1); PG8_STAGE(PG8_SA(0, 0), a2, voffA);
            PG8_BAR; PG8_WAIT_L(0); PG8_MMA(1, 0, At, B0); PG8_BAR; PG8_SCHED;
            PG8_STAGE(PG8_SB(0, 1), b2 + hstep, voffB);
            PG8_WAIT_V(6); PG8_BAR; PG8_MMA(1, 1, At, B1); PG8_BAR;
            PG8_LDB(B0, 1, 0); PG8_SCHED; PG8_LDA(At, 1, 0); PG8_STAGE(PG8_SA(0, 1), a2 + hstep, voffA);
            PG8_WAIT_L(8); PG8_BAR; PG8_WAIT_L(0); PG8_MMA(0, 0, At, B0); PG8_BAR; PG8_SCHED;
            PG8_LDB(B1, 1, 1); PG8_STAGE(PG8_SB(1, 0), b3, voffB);
            PG8_BAR; PG8_WAIT_L(0); PG8_MMA(0, 1, At, B1); PG8_BAR;
            PG8_LDA(At, 1, 1); PG8_STAGE(PG8_SA(1, 0), a3, voffA);
            PG8_BAR; PG8_WAIT_L(0); PG8_MMA(1, 0, At, B0); PG8_BAR; PG8_SCHED;
            PG8_STAGE(PG8_SB(1, 1), b3 + hstep, voffB);
            PG8_WAIT_V(6); PG8_BAR; PG8_MMA(1, 1, At, B1); PG8_BAR;
            }
        }
        if constexpr (ALIGN_EPI) { if (wr == 0) PG8_BAR; }
        if constexpr (!Epi::AFTER_DRAIN) { E(acc, cur, wr, wc, fr, fq); S.done(cur); }
        if (!has_next) break;
#pragma unroll
        for (int a = 0; a < 2; ++a)
#pragma unroll
            for (int b = 0; b < 2; ++b)
#pragma unroll
                for (int m = 0; m < 4; ++m)
#pragma unroll
                    for (int n = 0; n < 2; ++n) acc[a][b][m][n] = (f32x4){0.f, 0.f, 0.f, 0.f};
        cur = nxt; cA = nA; cB = nB; ++ui;
        if constexpr (ALIGN_EPI) { if (wr == 1) PG8_BAR; }
    }
    PG8_WAIT_V(0);
    if constexpr (!ALIGN_EPI) { if (wr == 0) PG8_BAR; }
    PG8_BAR;
    if constexpr (Epi::AFTER_DRAIN) { E.fused(acc, cur, wr, wc, fr, fq, lds, wid, lane); S.done(cur); }
#undef PG8_SA
#undef PG8_SB
#undef PG8_STAGE
#undef PG8_LDA
#undef PG8_LDB
#undef PG8_MMA
#undef PG8_WAIT_V
#undef PG8_WAIT_L
#undef PG8_BAR
#undef PG8_SCHED
}
}
#include <hip/hip_bf16.h>
#include <cmath>
namespace attn_body {
using bf16=__hip_bfloat16;
using bf16x8=__attribute__((ext_vector_type(8)))short;
using s16x4=__attribute__((ext_vector_type(4)))short;
using f32x16=__attribute__((ext_vector_type(16)))float;
using u32x4=__attribute__((ext_vector_type(4)))unsigned;
using f32x4b=__attribute__((ext_vector_type(4)))float;
constexpr int BATCH=16,NHEAD=8,SEQ=2048,D=64,PQ=3584,PO=1024;
constexpr int NW=8,QBLK=32,QB=QBLK*NW,KVBLK=64,NQB=SEQ/QB;
constexpr int ATTN_UNIT_ROWS=QB;
__device__ __forceinline__ int crow(int r,int hi){return (r&3)+8*(r>>2)+4*hi;}
#define SBAR() __builtin_amdgcn_sched_barrier(0)
__device__ __forceinline__ void cmask(f32x16&p0,f32x16&p1,int jb,int qrel,int hi){
  const float NEG=-INFINITY; int kb=64*jb+4*hi;
  #pragma unroll
  for(int r=0;r<16;++r){int kv=kb+(r&3)+8*(r>>2); if(kv>qrel)p0[r]=NEG; if(kv+32>qrel)p1[r]=NEG;}
}

constexpr int NSLOT=3, SLOTB=8192;
constexpr int LDS_K=0, LDS_V=NSLOT*SLOTB, LDS_WS=2*NSLOT*SLOTB, LDS_OST=LDS_WS+NW*64*4, LDS_BIAS=LDS_OST+NW*4096, LDS_BYTES=LDS_BIAS+SEQ*4;
constexpr float C2=0.125f*1.4426950408889634f;
__device__ __forceinline__ void glds16(const void*gsrc,unsigned lds_dst){unsigned keep;
  asm volatile("s_mov_b32 %0, m0\n\ts_mov_b32 m0, %2\n\ts_nop 0\n\tglobal_load_lds_dwordx4 %1, off\n\ts_mov_b32 m0, %0":"=&s"(keep):"v"(gsrc),"s"(lds_dst):"memory");}
__device__ __forceinline__ float max3f(float a,float b,float c){float r;asm("v_max3_f32 %0, %1, %2, %3":"=v"(r):"v"(a),"v"(b),"v"(c));return r;}
__device__ __forceinline__ float max2f(float a,float b){float r;asm("v_max_f32_e32 %0, %1, %2":"=v"(r):"v"(a),"v"(b));return r;}
__device__ __forceinline__ float fadd_s(float a,float b){float r;asm("v_add_f32_e32 %0, %1, %2":"=v"(r):"v"(a),"v"(b));return r;}
__device__ __forceinline__ float fsub_s(float a,float b){float r;asm("v_sub_f32_e32 %0, %1, %2":"=v"(r):"v"(a),"v"(b));return r;}
typedef float f32x2_t __attribute__((ext_vector_type(2))); typedef __bf16 bf16x2_t __attribute__((ext_vector_type(2)));
__device__ __forceinline__ unsigned cvtpk_s(float lo,float hi){f32x2_t v={lo,hi};bf16x2_t b=__builtin_convertvector(v,bf16x2_t);return __builtin_bit_cast(unsigned,b);}
#define WAIT_BAR(N) asm volatile("s_waitcnt vmcnt(" #N ") lgkmcnt(0)\n\ts_barrier":::"memory")

__device__ __forceinline__ void qkt(f32x16&p0,f32x16&p1,const char*Kslot,const bf16x8*qr,const f32x16&negm,int r32,int hi){
  const char*kb=Kslot+hi*1024+r32*16;
  #pragma unroll
  for(int d0=0;d0<4;++d0){
    const bf16x8 b0=*reinterpret_cast<const bf16x8*>(kb+d0*2048);
    const bf16x8 b1=*reinterpret_cast<const bf16x8*>(kb+d0*2048+512);
    if(d0==0){p0=__builtin_amdgcn_mfma_f32_32x32x16_bf16(b0,qr[0],negm,0,0,0);p1=__builtin_amdgcn_mfma_f32_32x32x16_bf16(b1,qr[0],negm,0,0,0);}
    else{p0=__builtin_amdgcn_mfma_f32_32x32x16_bf16(b0,qr[d0],p0,0,0,0);p1=__builtin_amdgcn_mfma_f32_32x32x16_bf16(b1,qr[d0],p1,0,0,0);}}
}
typedef __attribute__((address_space(3))) const char* lds_cptr;
typedef short v4i16_t __attribute__((ext_vector_type(4)));
__device__ __forceinline__ void kload8(bf16x8*kf,lds_cptr kp){
  kf[0]=*(const __attribute__((address_space(3))) bf16x8*)(kp);      kf[1]=*(const __attribute__((address_space(3))) bf16x8*)(kp+512);
  kf[2]=*(const __attribute__((address_space(3))) bf16x8*)(kp+2048); kf[3]=*(const __attribute__((address_space(3))) bf16x8*)(kp+2560);
  kf[4]=*(const __attribute__((address_space(3))) bf16x8*)(kp+4096); kf[5]=*(const __attribute__((address_space(3))) bf16x8*)(kp+4608);
  kf[6]=*(const __attribute__((address_space(3))) bf16x8*)(kp+6144); kf[7]=*(const __attribute__((address_space(3))) bf16x8*)(kp+6656);
}
__device__ __forceinline__ void kload2(bf16x8*kf,lds_cptr kp,int j){ kf[2*j]=*(const __attribute__((address_space(3))) bf16x8*)(kp+j*2048); kf[2*j+1]=*(const __attribute__((address_space(3))) bf16x8*)(kp+j*2048+512); }
__device__ __forceinline__ s16x4 vtr(lds_cptr p){ return __builtin_bit_cast(s16x4,__builtin_amdgcn_ds_read_tr16_b64_v4i16((__attribute__((address_space(3))) v4i16_t*)p)); }
__device__ __forceinline__ float rowmax(const f32x16&p0,const f32x16&p1){
  float a=max3f(p0[0],p0[1],p1[0]),b=max3f(p0[2],p0[3],p1[1]);a=max3f(a,p1[2],p1[3]);
  #pragma unroll
  for(int r=4;r<16;r+=4){a=max3f(a,p0[r],p0[r+1]);b=max3f(b,p0[r+2],p0[r+3]);a=max3f(a,p1[r],p1[r+1]);b=max3f(b,p1[r+2],p1[r+3]);}
  const float m=max2f(a,b);
  auto rr=__builtin_amdgcn_permlane32_swap(__float_as_uint(m),__float_as_uint(m),false,false);
  return max2f(__uint_as_float(rr[0]),__uint_as_float(rr[1]));
}
__device__ __forceinline__ void pv(f32x16*o,int vb,bf16x8 pa0,bf16x8 pa1,bf16x8 pa2,bf16x8 pa3){
  #pragma unroll
  for(int d0=0;d0<2;++d0){s16x4 lo[4],hi[4];
    #pragma unroll
    for(int ks=0;ks<4;++ks){
      asm volatile("ds_read_b64_tr_b16 %0,%1 offset:%c2":"=&v"(lo[ks]):"v"(vb),"i"(d0*4096+ks*1024):"memory");
      asm volatile("ds_read_b64_tr_b16 %0,%1 offset:%c2":"=&v"(hi[ks]):"v"(vb),"i"(d0*4096+ks*1024+512):"memory");}
    asm volatile("s_waitcnt lgkmcnt(0)":::"memory");SBAR();
    #define PK(k) (bf16x8){lo[k][0],lo[k][1],lo[k][2],lo[k][3],hi[k][0],hi[k][1],hi[k][2],hi[k][3]}
    o[d0]=__builtin_amdgcn_mfma_f32_32x32x16_bf16(pa0,PK(0),o[d0],0,0,0);
    o[d0]=__builtin_amdgcn_mfma_f32_32x32x16_bf16(pa1,PK(1),o[d0],0,0,0);
    o[d0]=__builtin_amdgcn_mfma_f32_32x32x16_bf16(pa2,PK(2),o[d0],0,0,0);
    o[d0]=__builtin_amdgcn_mfma_f32_32x32x16_bf16(pa3,PK(3),o[d0],0,0,0);
    #undef PK
  }
}

#ifndef ATTN_STORE16
#define ATTN_STORE16(p,v) (*(u32x4*)(p)=(v))
#endif
template<int THRL> __device__ __forceinline__ void attn_unit(int b,int h,int qb,const bf16*Q,const bf16*__restrict__ K,const bf16*__restrict__ V,bf16*O,const float*__restrict__ CB,char*shm){
  const int tid=tid_fresh(),lane=tid&63,r32=lane&31,hi=lane>>5; const int wid=__builtin_amdgcn_readfirstlane(tid>>6);
  const long rowbase=(long)b*SEQ; const int q0=qb*QB;
  const bf16*Qw=Q+(rowbase+q0+wid*QBLK)*PQ+h*D;
  const bf16*Kh=K+rowbase*PQ+h*D,*Vh=V+rowbase*PQ+h*D;
  const unsigned lds0=(unsigned)(uintptr_t)shm;
  float*wsf=(float*)(shm+LDS_WS)+wid*64;
  const bf16*ksrc=Kh+(long)lane*PQ+wid*8;
  const bf16*vsrc=Vh+(long)(16*(wid&3)+(lane>>2))*PQ+(wid>>2)*32+(lane&3)*8;
  const unsigned kdst=lds0+LDS_K+wid*1024, vdst=lds0+LDS_V+wid*1024;
  #define DMA_K(t,slot) glds16(ksrc+(long)(t)*KVBLK*PQ,(unsigned)__builtin_amdgcn_readfirstlane(kdst+(slot)))
  #define DMA_V(t,slot) glds16(vsrc+(long)(t)*KVBLK*PQ,(unsigned)__builtin_amdgcn_readfirstlane(vdst+(slot)))
  const int vb0=(int)(lds0+LDS_V)+((lane>>4)&1)*32+(lane&3)*8+(4*hi+((lane&15)>>2))*64;
  const char*Kbase=shm+LDS_K; bf16x8 kf[8];
  const lds_cptr shm3=(lds_cptr)shm; const lds_cptr kp0=shm3+LDS_K+hi*1024+r32*16; const lds_cptr vp0=shm3+LDS_V+((lane>>4)&1)*32+(lane&3)*8+(4*hi+((lane&15)>>2))*64;
  const int NT=(q0+QB)/KVBLK;
  { const float*cb=CB+(long)(b*NHEAD+h)*SEQ; float*bl=(float*)(shm+LDS_BIAS); for(int i=tid;i<NT*KVBLK;i+=NW*64)bl[i]=cb[i]*(-1.4426950408889634f); }
  const lds_cptr bp0=(lds_cptr)shm+LDS_BIAS+hi*16;
  #define KBIAS(P0,P1,t) do{ const lds_cptr bp_=bp0+(t)*256; _Pragma("unroll") for(int g_=0;g_<4;++g_){ const f32x4b a_=*(const __attribute__((address_space(3))) f32x4b*)(bp_+g_*32); const f32x4b c_=*(const __attribute__((address_space(3))) f32x4b*)(bp_+128+g_*32); \
      P0[4*g_]+=a_[0];P0[4*g_+1]+=a_[1];P0[4*g_+2]+=a_[2];P0[4*g_+3]+=a_[3]; P1[4*g_]+=c_[0];P1[4*g_+1]+=c_[1];P1[4*g_+2]+=c_[2];P1[4*g_+3]+=c_[3]; } }while(0)
  DMA_K(0,0);DMA_V(0,0);DMA_K(1,SLOTB);
  bf16x8 qr[4];
  #pragma unroll
  for(int d0=0;d0<4;++d0)qr[d0]=*reinterpret_cast<const bf16x8*>(&Qw[(long)r32*PQ+d0*16+hi*8]);
  float mhat=0.f,l_reg=0.f;f32x16 o[2];o[0]=f32x16{};o[1]=f32x16{};f32x16 negm=f32x16{};asm volatile("":"+v"(negm));
  const int qrel=wid*QBLK+r32;
  #define CMASK(P0,P1,t) do{int jb_=(t)-(NT-4); if(jb_>=0)cmask(P0,P1,jb_,qrel,hi);}while(0)
  bool resc=false;
  #define START(P0,P1) do{ const float rm=rowmax(P0,P1); resc=false; \
    { const float dl=rm; mhat=fadd_s(mhat,dl); \
      _Pragma("unroll") for(int r=0;r<16;++r){P0[r]=fsub_s(P0[r],dl);P1[r]=fsub_s(P1[r],dl);} \
      _Pragma("unroll") for(int r=0;r<16;++r)negm[r]=-mhat; asm volatile("":"+v"(negm)); } \
    _Pragma("unroll") for(int r=0;r<16;++r)P0[r]=__builtin_amdgcn_exp2f(P0[r]); }while(0)
  #define RESC() do{ if(resc){ asm volatile("s_waitcnt lgkmcnt(0)":::"memory"); \
      _Pragma("unroll") for(int d_=0;d_<2;++d_) _Pragma("unroll") for(int r=0;r<16;++r)o[d_][r]*=wsf[crow(r,hi)]; } }while(0)
  f32x16 pA0,pA1,pB0,pB1;
  int sl_prev=0,sl_cur=0,sl_next=SLOTB;
  #define ROT() do{sl_prev=sl_cur;sl_cur=sl_next;sl_next=(sl_next==(NSLOT-1)*SLOTB)?0:sl_next+SLOTB;}while(0)
  DMA_K(2,2*SLOTB);
  WAIT_BAR(3);
  qkt(pA0,pA1,Kbase,qr,negm,r32,hi);KBIAS(pA0,pA1,0);asm volatile("s_nop 15\n\ts_nop 7":"+v"(pA0),"+v"(pA1));CMASK(pA0,pA1,0);
  START(pA0,pA1);
  _Pragma("unroll") for(int r=0;r<16;++r)pA1[r]=__builtin_amdgcn_exp2f(pA1[r]);
  WAIT_BAR(0);
  DMA_K(3,0);DMA_V(1,SLOTB);
  ROT();
  kload8(kf,kp0+sl_cur);
  WAIT_BAR(2);
  s16x4 vlo[8],vhi[8]; u32x4 pw0,pw1,pw2,pw3;
  #define PKW(P,B) cvtpk_s(P[B],P[B+1])
  #define PAF(k) __builtin_bit_cast(bf16x8,pw##k)
  #define VFR(i) (bf16x8){vlo[i][0],vlo[i][1],vlo[i][2],vlo[i][3],vhi[i][0],vhi[i][1],vhi[i][2],vhi[i][3]}
  #define PIN(x) asm volatile("":"+v"(x))
  #define MX3(a,b,c) __builtin_fmaxf(__builtin_fmaxf((a),(b)),(c))
  #define GAPA(MF,A0,A1,A2,A3,W0,W1,PW) do{ MF; sacc+=A0; sacc+=A1; sacc+=A2; sacc+=A3; PIN(sacc); W0; W1; PIN(PW); SBAR(); }while(0)
  #define EX(v) __builtin_amdgcn_exp2f(v)
  #define GAPB(MF,X,B) do{ MF; X[B]=EX(X[B]); X[B+1]=EX(X[B+1]); X[B+2]=EX(X[B+2]); X[B+3]=EX(X[B+3]); PIN(X); SBAR(); }while(0)
  #define VRD(i) do{ vlo[i]=vtr(vp_+(((i)>>2)*4096+((i)&3)*1024)); vhi[i]=vtr(vp_+(((i)>>2)*4096+((i)&3)*1024+512)); }while(0)
  #define KRD(G,j) do{ if(G){ kload2(kf,kp0+sl_next,j); SBAR(); } }while(0)
  #define STEP(C0,C1,P0,P1,t,GK,GV,GL) do{ SBAR(); \
    const lds_cptr vp_=vp0+sl_prev; \
    VRD(0); SBAR(); float sacc=(P0[0]+P0[1]); \
    GAPA(C0=__builtin_amdgcn_mfma_f32_32x32x16_bf16(kf[0],qr[0],negm,0,0,0), P0[2],P0[3],P0[4],P0[5],     pw0[0]=PKW(P0,0), pw0[1]=PKW(P0,2), pw0); \
    VRD(4); SBAR(); GAPA(C1=__builtin_amdgcn_mfma_f32_32x32x16_bf16(kf[1],qr[0],negm,0,0,0), P0[6],P0[7],P0[8],P0[9],     pw0[2]=PKW(P0,4), pw0[3]=PKW(P0,6), pw0); \
    VRD(1); SBAR(); GAPA(C0=__builtin_amdgcn_mfma_f32_32x32x16_bf16(kf[2],qr[1],C0,0,0,0),   P0[10],P0[11],P0[12],P0[13], pw1[0]=PKW(P0,8), pw1[1]=PKW(P0,10), pw1); \
    VRD(5); SBAR(); GAPA(C1=__builtin_amdgcn_mfma_f32_32x32x16_bf16(kf[3],qr[1],C1,0,0,0),   P0[14],P0[15],P1[0],P1[1],   pw1[2]=PKW(P0,12),pw1[3]=PKW(P0,14), pw1); \
    VRD(2); SBAR(); GAPA(C0=__builtin_amdgcn_mfma_f32_32x32x16_bf16(kf[4],qr[2],C0,0,0,0),   P1[2],P1[3],P1[4],P1[5],     pw2[0]=PKW(P1,0), pw2[1]=PKW(P1,2), pw2); \
    VRD(6); SBAR(); GAPA(C1=__builtin_amdgcn_mfma_f32_32x32x16_bf16(kf[5],qr[2],C1,0,0,0),   P1[6],P1[7],P1[8],P1[9],     pw2[2]=PKW(P1,4), pw2[3]=PKW(P1,6), pw2); \
    VRD(3); SBAR(); GAPA(C0=__builtin_amdgcn_mfma_f32_32x32x16_bf16(kf[6],qr[3],C0,0,0,0),   P1[10],P1[11],P1[12],P1[13], pw3[0]=PKW(P1,8), pw3[1]=PKW(P1,10), pw3); \
    VRD(7); SBAR(); GAPA(C1=__builtin_amdgcn_mfma_f32_32x32x16_bf16(kf[7],qr[3],C1,0,0,0),   P1[14],P1[15],0.f,0.f,       pw3[2]=PKW(P1,12),pw3[3]=PKW(P1,14), pw3); \
    l_reg+=sacc; \
    if(GK){DMA_K((t)+3,sl_cur);} if(GV){DMA_V((t)+1,sl_next);} \
    KBIAS(C0,C1,t); CMASK(C0,C1,t); \
    { float a=MX3(C0[0],C0[1],C1[0]),b=MX3(C0[2],C0[3],C1[1]); a=MX3(a,C1[2],C1[3]); \
      _Pragma("unroll") for(int r=4;r<16;r+=4){a=MX3(a,C0[r],C0[r+1]);b=MX3(b,C0[r+2],C0[r+3]);a=MX3(a,C1[r],C1[r+1]);b=MX3(b,C1[r+2],C1[r+3]);} \
      float rm=__builtin_fmaxf(a,b); { auto rr=__builtin_amdgcn_permlane32_swap(__float_as_uint(rm),__float_as_uint(rm),false,false); rm=__builtin_fmaxf(__uint_as_float(rr[0]),__uint_as_float(rr[1])); } \
      resc=false; \
      if(__builtin_expect(__any(rm>(float)THRL),0)){ const float dl=__builtin_fmaxf(rm,0.f); mhat+=dl; \
        _Pragma("unroll") for(int r=0;r<16;++r){C0[r]-=dl;C1[r]-=dl;} \
        _Pragma("unroll") for(int r=0;r<16;++r)negm[r]=-mhat; asm volatile("":"+v"(negm)); \
        const float f=__builtin_amdgcn_exp2f(-dl); l_reg*=f; if(hi==0)wsf[r32]=f; resc=true; } } \
    SBAR(); \
    GAPB(o[0]=__builtin_amdgcn_mfma_f32_32x32x16_bf16(PAF(0),VFR(0),o[0],0,0,0), C0,0); \
    GAPB(o[1]=__builtin_amdgcn_mfma_f32_32x32x16_bf16(PAF(0),VFR(4),o[1],0,0,0), C0,4); \
    KRD(GL,0); GAPB(o[0]=__builtin_amdgcn_mfma_f32_32x32x16_bf16(PAF(1),VFR(1),o[0],0,0,0), C0,8); \
    KRD(GL,1); GAPB(o[1]=__builtin_amdgcn_mfma_f32_32x32x16_bf16(PAF(1),VFR(5),o[1],0,0,0), C0,12); \
    KRD(GL,2); GAPB(o[0]=__builtin_amdgcn_mfma_f32_32x32x16_bf16(PAF(2),VFR(2),o[0],0,0,0), C1,0); \
    KRD(GL,3); GAPB(o[1]=__builtin_amdgcn_mfma_f32_32x32x16_bf16(PAF(2),VFR(6),o[1],0,0,0), C1,4); \
    GAPB(o[0]=__builtin_amdgcn_mfma_f32_32x32x16_bf16(PAF(3),VFR(3),o[0],0,0,0), C1,8); \
    GAPB(o[1]=__builtin_amdgcn_mfma_f32_32x32x16_bf16(PAF(3),VFR(7),o[1],0,0,0), C1,12); \
    }while(0)
  int t=1;
  #undef CMASK
  #define CMASK(P0,P1,t) do{}while(0)
  for(;t+5<NT;t+=2){
    STEP(pB0,pB1,pA0,pA1,t,true,true,true);     WAIT_BAR(2); RESC(); ROT();
    STEP(pA0,pA1,pB0,pB1,t+1,true,true,true);   WAIT_BAR(2); RESC(); ROT();
  }
  #undef CMASK
  #define CMASK(P0,P1,t) do{int jb_=(t)-(NT-4); if(jb_>=0)cmask(P0,P1,jb_,qrel,hi);}while(0)
  #define ENDW(tt) do{ if((tt)+3<NT){WAIT_BAR(2);} else if((tt)+2<NT){WAIT_BAR(1);} else {WAIT_BAR(0);} }while(0)
  for(;t+1<NT;t+=2){
    STEP(pB0,pB1,pA0,pA1,t,(t+3<NT),(t+1<NT),(t+1<NT));       ENDW(t);   RESC(); ROT();
    STEP(pA0,pA1,pB0,pB1,t+1,(t+4<NT),(t+2<NT),(t+2<NT));     ENDW(t+1); RESC(); ROT();
  }
  STEP(pB0,pB1,pA0,pA1,NT-1,false,false,false); RESC();
  { float sacc=pB0[0]+pB0[1]; _Pragma("unroll") for(int r=2;r<16;++r)sacc+=pB0[r]; _Pragma("unroll") for(int r=0;r<16;++r)sacc+=pB1[r]; l_reg+=sacc;
    pw0=(u32x4){PKW(pB0,0),PKW(pB0,2),PKW(pB0,4),PKW(pB0,6)};pw1=(u32x4){PKW(pB0,8),PKW(pB0,10),PKW(pB0,12),PKW(pB0,14)};pw2=(u32x4){PKW(pB1,0),PKW(pB1,2),PKW(pB1,4),PKW(pB1,6)};pw3=(u32x4){PKW(pB1,8),PKW(pB1,10),PKW(pB1,12),PKW(pB1,14)};
    SBAR(); pv(o,vb0+sl_cur,PAF(0),PAF(1),PAF(2),PAF(3)); }
  #undef PKW
  #undef PAF
  #undef VFR
  #undef PIN
  #undef MX3
  #undef GAPA
  #undef GAPB
  #undef EX
  #undef VRD
  #undef KRD
  #undef STEP
  #undef ENDW
  {auto rr=__builtin_amdgcn_permlane32_swap(__float_as_uint(l_reg),__float_as_uint(l_reg),false,false);l_reg=__uint_as_float(rr[0])+__uint_as_float(rr[1]);}
  if(hi==0)wsf[32+r32]=l_reg;asm volatile("s_waitcnt lgkmcnt(0)":::"memory");
  float rli[16];
  #pragma unroll
  for(int r=0;r<16;++r)rli[r]=__builtin_amdgcn_rcpf(wsf[32+crow(r,hi)]);
  bf16*Ow=O+(rowbase+q0+wid*QBLK)*PO+h*D;
  { bf16*stg=(bf16*)(shm+LDS_OST)+wid*2048;
    #pragma unroll
    for(int r=0;r<16;++r){const int orow=crow(r,hi);
      #pragma unroll
      for(int d0=0;d0<2;++d0)stg[orow*64+d0*32+r32]=__float2bfloat16(o[d0][r]*rli[r]);}
    asm volatile("s_waitcnt lgkmcnt(0)":::"memory");
    #pragma unroll
    for(int i=0;i<4;++i){const int row=i*8+(lane>>3),ch=lane&7; const u32x4 v=*(const u32x4*)(stg+row*64+ch*8); ATTN_STORE16(Ow+(long)row*PO+ch*8,v);} }
  asm volatile("s_waitcnt lgkmcnt(0)\n\ts_barrier":::"memory");
  #undef KBIAS
  #undef DMA_K
  #undef DMA_V
  #undef CMASK
  #undef START
  #undef RESC
  #undef ROT
}
constexpr int ATTN_LDS_BYTES=LDS_BYTES;
#undef SBAR
#undef WAIT_BAR
}
#define LAS __attribute__((address_space(3)))
typedef unsigned short bf16;
typedef unsigned u32x4 __attribute__((ext_vector_type(4)));
typedef unsigned u32x2 __attribute__((ext_vector_type(2)));
typedef float f32x4 __attribute__((ext_vector_type(4)));
typedef float f32x2 __attribute__((ext_vector_type(2)));
typedef float f32x16 __attribute__((ext_vector_type(16)));
typedef short bf16x8 __attribute__((ext_vector_type(8)));
#define RLX_AGENT __ATOMIC_RELAXED, __HIP_MEMORY_SCOPE_AGENT
constexpr int NWAVES = 8, NTHR = 512;
constexpr int LDS_BYTES = 147456, MISC_OFF = 131072 + 8192;
constexpr float LOG2E = 1.4426950408889634f;
__device__ __forceinline__ unsigned pk2(float lo, float hi) { return pg8::cvt_pk_bf16(lo, hi); }
__device__ __forceinline__ float bf2f(unsigned u16) { return __uint_as_float(u16 << 16); }
__device__ __forceinline__ int crow(int r, int hi) { return (r & 3) + 8 * (r >> 2) + 4 * hi; }
__device__ __forceinline__ float wave_sum(float v) {
#pragma unroll
    for (int o = 1; o < 64; o <<= 1) v += __shfl_xor(v, o);
    return v;
}
__device__ __forceinline__ void sincos_cw(float x, float& s, float& c) {
    const float k = rintf(x * 0.636619772367581343f);
    float r = fmaf(k, -1.5703125f, x); r = fmaf(k, -4.837512969970703125e-4f, r); r = fmaf(k, -7.54978995489188216e-8f, r);
    const float z = r * r;
    const float sp = r + r * z * (-1.6666654611e-1f + z * (8.3321608736e-3f + z * -1.9515295891e-4f));
    const float cp = 1.0f - 0.5f * z + z * z * (4.166664568298827e-2f + z * (-1.388731625493765e-3f + z * 2.443315711809948e-5f));
    const int q = ((int)k) & 3;
    s = (q == 0) ? sp : (q == 1) ? cp : (q == 2) ? -sp : -cp;
    c = (q == 0) ? cp : (q == 1) ? -sp : (q == 2) ? -cp : sp;
}
__device__ __forceinline__ float block_scan(float v, float& tot, LAS float* scr, int lane, int wid) {
#pragma unroll
    for (int o = 1; o < 64; o <<= 1) { const float n = __shfl_up(v, o); if (lane >= o) v += n; }
    if (lane == 63) scr[wid] = v;
    __syncthreads();
    float off = 0.f; tot = 0.f;
#pragma unroll
    for (int w = 0; w < NWAVES; ++w) { const float x = scr[w]; if (w < wid) off += x; tot += x; }
    __syncthreads();
    return v + off;
}

template <int MODE> __device__ __forceinline__ int rowmap(int n) {
    if (MODE == 1) return n < 1024 ? ((n & ~127) | ((n & 63) << 1) | ((n >> 6) & 1)) : n;
    if (MODE == 2) return 2 * n;
    if (MODE == 3) return 2 * n + 1;
    return n;
}
template <int MODE> __device__ __forceinline__ void p0_transpose_item(const float* W, int ldw, int K, int N, const float* ks, bf16* WT, LAS float* scr, int item, int lane) {
    const int nblk = N / 32, kb = item / nblk, nb = item % nblk, k0 = 64 * kb, n0 = 32 * nb;
#pragma unroll
    for (int i = 0; i < 32; ++i) { const int kk = 2 * i + (lane >> 5); float w = W[(size_t)(k0 + kk) * ldw + n0 + (lane & 31)]; if (ks) w *= ks[k0 + kk]; scr[kk * 33 + (lane & 31)] = w; }
    asm volatile("s_waitcnt lgkmcnt(0)" ::: "memory");
    const int c = lane & 7;
#pragma unroll
    for (int j = 0; j < 4; ++j) { const int n = (lane >> 3) + 8 * j; const LAS float* s = scr + (8 * c) * 33 + n;
        u32x4 o; o.x = pk2(s[0 * 33], s[1 * 33]); o.y = pk2(s[2 * 33], s[3 * 33]); o.z = pk2(s[4 * 33], s[5 * 33]); o.w = pk2(s[6 * 33], s[7 * 33]);
        *(u32x4*)(WT + (size_t)rowmap<MODE>(n0 + n) * K + k0 + 8 * c) = o; }
    asm volatile("s_waitcnt lgkmcnt(0)" ::: "memory");
}
__device__ __forceinline__ void p0_prep(const Params& p, LAS unsigned char* lds, int vcu, int G) {
    const int tid = tid_fresh(), lane = tid & 63, wid = __builtin_amdgcn_readfirstlane(tid >> 6);
    unsigned char* ws = p.ws;
    for (int i = blockIdx.x * NTHR + tid; i < (int)(CTL_BYTES / 4); i += G * NTHR) ((unsigned*)(ws + WS_CTL))[i] = 0u;
    { float* cs = (float*)(ws + WS_CS);
      for (int i = blockIdx.x * NTHR + tid; i < (TSEQ + NSMP) * 64; i += G * NTHR) { const int tix = i >> 6, d = i & 63; const float pos = (float)(tix < TSEQ ? tix : PAST + tix - TSEQ);
          const float inv = exp2f((float)d * (-13.287712379549449f / 64.0f)); float s, c; sincos_cw(pos * inv, s, c); cs[2 * i] = c; cs[2 * i + 1] = s; } }
    LAS float* scr = (LAS float*)(lds + wid * 16384);
    const int gw = vcu * NWAVES + wid, NGW = G * NWAVES;
    constexpr int I_IN = (DM / 64) * (NZ / 32), I_O = (DM / 64) * (DM / 32), I_G = (DM / 64) * (DFF / 32), I_D = (DFF / 64) * (DM / 32);
#ifndef REP_P0T
#define REP_P0T 1
#endif
    for (int rept = 0; rept < REP_P0T; ++rept)
    for (int it = gw; it < I_IN + I_O + 2 * I_G + I_D; it += NGW) {
        int r = it;
        if (r < I_IN) { p0_transpose_item<1>(p.win, DIN, DM, NZ, nullptr, (bf16*)(ws + WS_WIN), scr, r, lane); continue; } r -= I_IN;
        if (r < I_O) { p0_transpose_item<0>(p.wout, DM, DM, DM, nullptr, (bf16*)(ws + WS_WO), scr, r, lane); continue; } r -= I_O;
        if (r < I_G) { p0_transpose_item<2>(p.wg, DFF, DM, DFF, p.gffn, (bf16*)(ws + WS_WGU), scr, r, lane); continue; } r -= I_G;
        if (r < I_G) { p0_transpose_item<3>(p.wu, DFF, DM, DFF, p.gffn, (bf16*)(ws + WS_WGU), scr, r, lane); continue; } r -= I_G;
        p0_transpose_item<0>(p.wd, DM, DFF, DM, nullptr, (bf16*)(ws + WS_WD), scr, r, lane);
    }
    __syncthreads();
    LAS f32x4* wl = (LAS f32x4*)lds;
    for (int i = tid; i < 2048; i += NTHR) { const int ln = i & 63, q = i >> 6, half = q & 1, e = (q >> 1) & 3, j = q >> 3;
        wl[i] = *(const f32x4*)(p.win + (size_t)(4 * ln + 256 * j + e) * DIN + NZ + 4 * half); }
    __syncthreads();
    f32x4 gm[4];
#pragma unroll
    for (int j = 0; j < 4; ++j) gm[j] = *(const f32x4*)(p.gmix + 4 * lane + 256 * j);
    bf16* XN = (bf16*)(ws + WS_XN);
    constexpr int NQUAD = MTOK / 4;
#ifndef REP_P0R
#define REP_P0R 1
#endif
    for (int repr_ = 0; repr_ < REP_P0R; ++repr_)
    for (int qd = gw; qd < NQUAD; qd += NGW) {
        const int m0 = 4 * qd; const float* xr = (m0 < MP) ? p.xp + (size_t)m0 * DM : p.xs + (size_t)(m0 - MP) * DM;
        f32x4 v[4][4];
#pragma unroll
        for (int rr = 0; rr < 4; ++rr)
#pragma unroll
            for (int j = 0; j < 4; ++j) v[rr][j] = *(const f32x4*)(xr + (size_t)rr * DM + 4 * lane + 256 * j);
        asm volatile("" ::: "memory");
        float ss[4]; f32x4 a0[4], a1[4];
#pragma unroll
        for (int rr = 0; rr < 4; ++rr) { ss[rr] = 0.f; a0[rr] = (f32x4){0.f, 0.f, 0.f, 0.f}; a1[rr] = a0[rr]; }
#pragma unroll
        for (int j = 0; j < 4; ++j) {
#pragma unroll
            for (int rr = 0; rr < 4; ++rr) { ss[rr] += (v[rr][j][0] * v[rr][j][0] + v[rr][j][1] * v[rr][j][1]) + (v[rr][j][2] * v[rr][j][2] + v[rr][j][3] * v[rr][j][3]); v[rr][j] = v[rr][j] * gm[j]; }
#pragma unroll
            for (int e = 0; e < 4; ++e) { const f32x4 w0 = wl[((j * 4 + e) * 2) * 64 + lane], w1 = wl[((j * 4 + e) * 2 + 1) * 64 + lane];
#pragma unroll
                for (int rr = 0; rr < 4; ++rr) { a0[rr] += w0 * v[rr][j][e]; a1[rr] += w1 * v[rr][j][e]; } } }
        const int b5 = lane >> 5, b4 = (lane >> 4) & 1, b3 = (lane >> 3) & 1;
#pragma unroll
        for (int rr = 0; rr < 4; ++rr) {
            const float r = 1.0f / sqrtf(wave_sum(ss[rr]) * (1.0f / DM) + 1e-6f);
            float t4[4], t2[2];
#pragma unroll
            for (int i = 0; i < 4; ++i) { const float mine = b5 ? a1[rr][i] : a0[rr][i], send = b5 ? a0[rr][i] : a1[rr][i]; t4[i] = mine + __shfl_xor(send, 32); }
#pragma unroll
            for (int i = 0; i < 2; ++i) { const float mine = b4 ? t4[2 + i] : t4[i], send = b4 ? t4[i] : t4[2 + i]; t2[i] = mine + __shfl_xor(send, 16); }
            float t1; { const float mine = b3 ? t2[1] : t2[0], send = b3 ? t2[0] : t2[1]; t1 = mine + __shfl_xor(send, 8); }
            t1 += __shfl_xor(t1, 4); t1 += __shfl_xor(t1, 2); t1 += __shfl_xor(t1, 1);
            const int m = m0 + rr;
#pragma unroll
            for (int j = 0; j < 4; ++j) { u32x2 w; const f32x4 xa = v[rr][j] * r; w.x = pk2(xa[0], xa[1]); w.y = pk2(xa[2], xa[3]); *(u32x2*)(XN + (size_t)m * DM + 4 * lane + 256 * j) = w; }
            if ((lane & 7) == 0) { const int idx = lane >> 3; const float t = t1 * r + p.bfg[idx]; const float lf = fminf(t, 0.f) - log1pf(expf(-fabsf(t)));
                float* o = (m < MP) ? p.out + O_LFP + (size_t)m * 8 : p.out + O_LFS + (size_t)(m - MP) * 8; o[idx] = lf; }
        }
    }
}
__device__ __forceinline__ void p1_cumsum(const Params& p, LAS unsigned char* lds) {
    const int tid = tid_fresh(), lane = tid & 63, wid = __builtin_amdgcn_readfirstlane(tid >> 6);
    const int bh = blockIdx.x; if (bh >= NB * 8) return;
    const int b = bh >> 3, h = bh & 7; const float* lf = p.out + O_LFP + (size_t)b * TSEQ * 8 + h;
    float c[4]; float run = 0.f;
#pragma unroll
    for (int e = 0; e < 4; ++e) { run += lf[(size_t)(4 * tid + e) * 8]; c[e] = run; }
    float tot; const float inc = block_scan(run, tot, (LAS float*)lds, lane, wid); const float exc = inc - run;
    float* cb = (float*)(p.ws + WS_CB) + (size_t)bh * TSEQ + 4 * tid;
    *(f32x4*)cb = (f32x4){exc + c[0], exc + c[1], exc + c[2], exc + c[3]};
}
__device__ __forceinline__ void p6_final(const Params& p, int vcu, int G) {
    const int tid = tid_fresh(), lane = tid & 63, wid = __builtin_amdgcn_readfirstlane(tid >> 6);
    f32x4 gf[4];
#pragma unroll
    for (int j = 0; j < 4; ++j) gf[j] = *(const f32x4*)(p.gfin + 4 * lane + 256 * j);
    for (int m = 2 * (vcu * NWAVES + wid); m < MTOK; m += 2 * G * NWAVES) { float* y = p.out + O_Y + (size_t)m * DM + 4 * lane;
        f32x4 v[2][4]; float s0 = 0.f, s1 = 0.f;
#pragma unroll
        for (int j = 0; j < 4; ++j) { v[0][j] = *(const f32x4*)(y + 256 * j); v[1][j] = *(const f32x4*)(y + DM + 256 * j); }
#pragma unroll
        for (int j = 0; j < 4; ++j) { s0 += (v[0][j][0] * v[0][j][0] + v[0][j][1] * v[0][j][1]) + (v[0][j][2] * v[0][j][2] + v[0][j][3] * v[0][j][3]);
            s1 += (v[1][j][0] * v[1][j][0] + v[1][j][1] * v[1][j][1]) + (v[1][j][2] * v[1][j][2] + v[1][j][3] * v[1][j][3]); }
        const float r0 = 1.0f / sqrtf(wave_sum(s0) * (1.0f / DM) + 1e-6f), r1 = 1.0f / sqrtf(wave_sum(s1) * (1.0f / DM) + 1e-6f);
#pragma unroll
        for (int j = 0; j < 4; ++j) { *(f32x4*)(y + 256 * j) = v[0][j] * r0 * gf[j]; *(f32x4*)(y + DM + 256 * j) = v[1][j] * r1 * gf[j]; } }
}
#define XB_TMO      128
#define XB_XCNT(j)  (256  + 64 * (j))
#define XB_XSUB(j)  (1280 + 64 * (j))
#define XB_XGEN(j)  (2304 + 64 * (j))
#define XB_TOP      3328
#define XB_TOPGEN   3392
#define XCD_BAR_WORDS 3456
#define XB_SPIN_CAP (1u << 18)

__device__ __forceinline__ unsigned xb_ld(unsigned* p)              { return __hip_atomic_load(p, __ATOMIC_RELAXED, __HIP_MEMORY_SCOPE_AGENT); }
__device__ __forceinline__ unsigned xb_add(unsigned* p, unsigned v) { return __hip_atomic_fetch_add(p, v, __ATOMIC_RELAXED, __HIP_MEMORY_SCOPE_AGENT); }
__device__ __forceinline__ unsigned xb_xcc_id() { return (unsigned)__builtin_amdgcn_s_getreg((3 << 11) | 20) & 0xFu; }
#define XB_SPIN(cond, bar) do { unsigned _sp = 0; while (cond) { __builtin_amdgcn_s_sleep(1); \
    if ((++_sp & 255u) == 0u) { if (xb_ld(&(bar)[XB_TMO])) break; if (_sp > XB_SPIN_CAP) { atomicAdd(&(bar)[XB_TMO], 1u); break; } } } } while (0)

struct XcdBarrier {
    unsigned* bar; unsigned x;
    volatile LAS unsigned* st;
};

__device__ __forceinline__ XcdBarrier xcd_barrier_post(unsigned* bar, volatile LAS unsigned* st) {
    XcdBarrier b; b.bar = bar; b.x = xb_xcc_id(); b.st = st;
    if (threadIdx.x == 0) (void)xb_add(&bar[XB_XCNT(b.x)], 1u);
    return b;
}
__device__ __forceinline__ void xcd_barrier_complete(unsigned* bar, unsigned x, unsigned& nloc, unsigned& nx) {
    const unsigned G = gridDim.x * gridDim.y * gridDim.z;
    unsigned sum, cnt, mine, sp = 0u;
    for (;;) {
        sum = 0u; cnt = 0u; mine = 0u;
#pragma unroll
        for (unsigned j = 0; j < 16; ++j) { const unsigned c = xb_ld(&bar[XB_XCNT(j)]); sum += c; cnt += (c > 0u) ? 1u : 0u; mine = (j == x) ? c : mine; }
        if (sum == G) break;
        __builtin_amdgcn_s_sleep(1);
        if ((++sp & 255u) == 0u) { if (xb_ld(&bar[XB_TMO])) break; if (sp > XB_SPIN_CAP) { atomicAdd(&bar[XB_TMO], 1u); break; } }
    }
    nloc = mine > 0u ? mine : 1u; nx = cnt > 0u ? cnt : 1u;
}

__device__ __forceinline__ void xcd_barrier(const XcdBarrier& b) {
    asm volatile("s_waitcnt vmcnt(0)" ::: "memory");
    __syncthreads();
    if (threadIdx.x == 0) {
        unsigned* bar = b.bar;
        __builtin_amdgcn_s_waitcnt(0);
        unsigned nloc = b.st[0], nx = b.st[1];
        if (nloc == 0u) { xcd_barrier_complete(bar, b.x, nloc, nx); b.st[0] = nloc; b.st[1] = nx; }
        const unsigned old = xb_add(&bar[XB_XSUB(b.x)], 1u);
        const unsigned gen = old / nloc;
        if (old + 1u == (gen + 1u) * nloc) {
            __builtin_amdgcn_fence(__ATOMIC_RELEASE, "agent");
            asm volatile("s_waitcnt vmcnt(0)" ::: "memory");
            const unsigned og = xb_add(&bar[XB_TOP], 1u);
            const unsigned tg = og / nx;
            if (og + 1u == (tg + 1u) * nx) xb_add(&bar[XB_TOPGEN], 1u);
            else XB_SPIN(xb_ld(&bar[XB_TOPGEN]) == tg, bar);
            __builtin_amdgcn_fence(__ATOMIC_ACQUIRE, "agent");
            xb_add(&bar[XB_XGEN(b.x)], 1u);
            asm volatile("s_waitcnt vmcnt(0)" ::: "memory");
        } else {
            XB_SPIN(xb_ld(&bar[XB_XGEN(b.x)]) == gen, bar);
            __builtin_amdgcn_fence(__ATOMIC_ACQUIRE, "agent");
            asm volatile("s_waitcnt vmcnt(0)" ::: "memory");
        }
    }
    __syncthreads();
}
#ifndef RJ_SKIP
#define RJ_SKIP 0
#endif
#define MFMA32(a, b, c) __builtin_amdgcn_mfma_f32_32x32x16_bf16((a), (b), (c), 0, 0, 0)
__device__ __forceinline__ void ret_job(LAS unsigned char* lds, const Params& p_, const bool sample, const int b, const int h) {
    const Params p = fresh_params(p_);
    const int tid = tid_fresh(), lane = tid & 63, wid = __builtin_amdgcn_readfirstlane(tid >> 6), r32 = lane & 31, hi = lane >> 5;
    constexpr int PQK = 272, PT = 144;
    LAS unsigned char* Qr = lds; LAS unsigned char* Kr = lds + 17408; LAS unsigned char* Kdt = lds + 34816; LAS unsigned char* Vt = lds + 53248;
    LAS unsigned char* St = lds + 71680; LAS unsigned char* Am = lds + 106496; LAS f32x2* stats = (LAS f32x2*)(lds + 115712);
    const float lg2 = h == 0 ? -0.045803689613124746f : h == 1 ? -0.022720076500083907f : h == 2 ? -0.011315313227834146f : -0.005646563141142062f;
    const float cdec = __builtin_amdgcn_exp2f(lg2 * 64.0f);
    const int nch = sample ? 1 : TSEQ / 64; const size_t row0 = sample ? (size_t)MP + b * NSMP : (size_t)b * TSEQ;
    const bf16* Z = (const bf16*)(p.ws + WS_Z); bf16* MIX = (bf16*)(p.ws + WS_MIX);
    const int dkb = wid & 3, dvh = wid >> 2;
    f32x16 S0, S1;
    if (sample) { const float* sp = p.sr + (size_t)(b * 4 + h) * 16384 + 64 * dvh + r32;
#pragma unroll
        for (int r = 0; r < 16; ++r) { const int dk = 32 * dkb + crow(r, hi); S0[r] = sp[dk * 128]; S1[r] = sp[dk * 128 + 32]; } }
    else {
#pragma unroll
        for (int r = 0; r < 16; ++r) { S0[r] = 0.f; S1[r] = 0.f; } }
    u32x4 pq0, pq1, pk0, pk1, pv0, pv1; u32x2 pg[4];
#define RJ_LOAD(c_) do { const bf16* zr = Z + (row0 + (size_t)(c_) * 64 + 2 * (tid & 31)) * NZ + h * 128 + (tid >> 5) * 8; \
        pq0 = *(const u32x4*)zr; pq1 = *(const u32x4*)(zr + NZ); pk0 = *(const u32x4*)(zr + 512); pk1 = *(const u32x4*)(zr + NZ + 512); pv0 = *(const u32x4*)(zr + 1024); pv1 = *(const u32x4*)(zr + NZ + 1024); } while (0)
    RJ_LOAD(0);
    f32x4 gnv[4];
#pragma unroll
    for (int g = 0; g < 4; ++g) gnv[g] = *(const f32x4*)(p.gn + h * 128 + 32 * (wid >> 1) + 8 * g + 4 * hi);
    for (int c = 0; c < nch; ++c) {
        const size_t r0 = row0 + (size_t)c * 64;
#if !(RJ_SKIP & 1)
        { const int jp = tid & 31, ch = tid >> 5;
            *(LAS u32x4*)(Qr + (2 * jp) * PQK + ch * 16) = pq0; *(LAS u32x4*)(Qr + (2 * jp + 1) * PQK + ch * 16) = pq1;
            *(LAS u32x4*)(Kr + (2 * jp) * PQK + ch * 16) = pk0; *(LAS u32x4*)(Kr + (2 * jp + 1) * PQK + ch * 16) = pk1;
            const float kd0 = __builtin_amdgcn_exp2f(lg2 * (float)(63 - 2 * jp)), kd1 = __builtin_amdgcn_exp2f(lg2 * (float)(62 - 2 * jp));
#pragma unroll
            for (int e = 0; e < 8; ++e) { const unsigned a0 = pk0[e >> 1], a1 = pk1[e >> 1], b0 = pv0[e >> 1], b1 = pv1[e >> 1];
                const float f0 = (e & 1) ? __uint_as_float(a0 & 0xffff0000u) : __uint_as_float(a0 << 16), f1 = (e & 1) ? __uint_as_float(a1 & 0xffff0000u) : __uint_as_float(a1 << 16);
                *(LAS unsigned*)(Kdt + (ch * 8 + e) * PT + jp * 4) = pk2(f0 * kd0, f1 * kd1);
                *(LAS unsigned*)(Vt + (ch * 8 + e) * PT + jp * 4) = (e & 1) ? ((b0 >> 16) | (b1 & 0xffff0000u)) : ((b0 & 0xffffu) | (b1 << 16)); } }
#pragma unroll
        for (int g = 0; g < 4; ++g) { const int dk0 = 32 * dkb + 8 * g + 4 * hi;
            u32x2 w0, w1; w0.x = pk2(S0[4 * g], S0[4 * g + 1]); w0.y = pk2(S0[4 * g + 2], S0[4 * g + 3]); w1.x = pk2(S1[4 * g], S1[4 * g + 1]); w1.y = pk2(S1[4 * g + 2], S1[4 * g + 3]);
            *(LAS u32x2*)(St + (64 * dvh + r32) * PQK + dk0 * 2) = w0; *(LAS u32x2*)(St + (64 * dvh + 32 + r32) * PQK + dk0 * 2) = w1; }
        if (c + 1 < nch) RJ_LOAD(c + 1);
        { const bf16* grow = Z + (r0 + 32 * (wid & 1) + r32) * NZ + 1536 + h * 128 + 32 * (wid >> 1) + 4 * hi;
#pragma unroll
          for (int g = 0; g < 4; ++g) pg[g] = *(const u32x2*)(grow + 8 * g); }
#endif
        __syncthreads();
#if !(RJ_SKIP & 2)
        if (wid < 4) { const int jb = wid >> 1, ib = wid & 1; f32x16 a;
#pragma unroll
            for (int r = 0; r < 16; ++r) a[r] = 0.f;
#pragma unroll 2
            for (int ks = 0; ks < 8; ++ks) { const bf16x8 kf = *(const LAS bf16x8*)(Kr + (32 * jb + r32) * PQK + (16 * ks + 8 * hi) * 2), qf = *(const LAS bf16x8*)(Qr + (32 * ib + r32) * PQK + (16 * ks + 8 * hi) * 2);
                a = MFMA32(kf, qf, a); }
            const int i = 32 * ib + r32;
#pragma unroll
            for (int g = 0; g < 4; ++g) { const int j0 = 32 * jb + 8 * g + 4 * hi; float t[4];
#pragma unroll
                for (int e = 0; e < 4; ++e) t[e] = a[4 * g + e] * __builtin_amdgcn_exp2f(lg2 * fabsf((float)(i - (j0 + e))));
                u32x2 w; w.x = pk2(t[0], t[1]); w.y = pk2(t[2], t[3]); *(LAS u32x2*)(Am + i * PT + j0 * 2) = w; } }
#endif
        __syncthreads();
#if !(RJ_SKIP & 4)
        { const int dvb = wid >> 1, ib = wid & 1; f32x16 oi, ox;
#pragma unroll
            for (int r = 0; r < 16; ++r) { oi[r] = 0.f; ox[r] = 0.f; }
#pragma unroll
            for (int ks = 0; ks < 4; ++ks) { const bf16x8 vf = *(const LAS bf16x8*)(Vt + (32 * dvb + r32) * PT + (16 * ks + 8 * hi) * 2), af = *(const LAS bf16x8*)(Am + (32 * ib + r32) * PT + (16 * ks + 8 * hi) * 2);
                oi = MFMA32(vf, af, oi); }
#pragma unroll 2
            for (int ks = 0; ks < 8; ++ks) { const bf16x8 sf = *(const LAS bf16x8*)(St + (32 * dvb + r32) * PQK + (16 * ks + 8 * hi) * 2), qf = *(const LAS bf16x8*)(Qr + (32 * ib + r32) * PQK + (16 * ks + 8 * hi) * 2);
                ox = MFMA32(sf, qf, ox); }
            const int i = 32 * ib + r32; const float qd = __builtin_amdgcn_exp2f(lg2 * (float)(i + 1)); float s1 = 0.f, s2 = 0.f;
#pragma unroll
            for (int r = 0; r < 16; ++r) { oi[r] += ox[r] * qd; s1 += oi[r]; s2 += oi[r] * oi[r]; }
            s1 += __shfl_xor(s1, 32); s2 += __shfl_xor(s2, 32);
            if (hi == 0) stats[i * 4 + dvb] = (f32x2){s1, s2};
            __syncthreads();
            float m1 = 0.f, m2 = 0.f;
#pragma unroll
            for (int t = 0; t < 4; ++t) { const f32x2 st = stats[i * 4 + t]; m1 += st.x; m2 += st.y; }
            const float mu = m1 * (1.0f / 128.0f), var = fmaxf(m2 * (1.0f / 128.0f) - mu * mu, 0.f), rstd = 1.0f / sqrtf(var + 1e-5f);
            bf16* mrow = MIX + (r0 + i) * DM + h * 128;
#pragma unroll
            for (int g = 0; g < 4; ++g) { const int dv0 = 32 * dvb + 8 * g + 4 * hi; const u32x2 gw = pg[g]; const f32x4 gn = gnv[g];
                const float g0 = bf2f(gw.x & 0xffffu), g1 = bf2f(gw.x >> 16), g2 = bf2f(gw.y & 0xffffu), g3 = bf2f(gw.y >> 16);
                const float y0 = (oi[4 * g] - mu) * rstd * gn[0] * pg8::silu_f(g0), y1 = (oi[4 * g + 1] - mu) * rstd * gn[1] * pg8::silu_f(g1);
                const float y2 = (oi[4 * g + 2] - mu) * rstd * gn[2] * pg8::silu_f(g2), y3 = (oi[4 * g + 3] - mu) * rstd * gn[3] * pg8::silu_f(g3);
                u32x2 w; w.x = pk2(y0, y1); w.y = pk2(y2, y3); *(u32x2*)(mrow + dv0) = w; } }
#endif
#if !(RJ_SKIP & 8)
#pragma unroll
        for (int r = 0; r < 16; ++r) { S0[r] *= cdec; S1[r] *= cdec; }
#pragma unroll
        for (int ks = 0; ks < 4; ++ks) { const bf16x8 kdf = *(const LAS bf16x8*)(Kdt + (32 * dkb + r32) * PT + (16 * ks + 8 * hi) * 2);
            const bf16x8 v0 = *(const LAS bf16x8*)(Vt + (64 * dvh + r32) * PT + (16 * ks + 8 * hi) * 2), v1 = *(const LAS bf16x8*)(Vt + (64 * dvh + 32 + r32) * PT + (16 * ks + 8 * hi) * 2);
            S0 = MFMA32(kdf, v0, S0); S1 = MFMA32(kdf, v1, S1); }
#endif
        __syncthreads();
    }
#undef RJ_LOAD
    { float* so = p.out + (sample ? O_SRS : O_SRP) + (size_t)(b * 4 + h) * 16384 + 64 * dvh + r32;
#pragma unroll
        for (int r = 0; r < 16; ++r) { const int dk = 32 * dkb + crow(r, hi); so[dk * 128] = S0[r]; so[dk * 128 + 32] = S1[r]; } }
}

constexpr size_t WS_PART = WS_END + 6 * MiB;
constexpr int PART_STRIDE = 4224;
__device__ __forceinline__ void fs_chunk_job(LAS unsigned char* lds, const Params& p_, const int b, const int c) {
    const Params p = fresh_params(p_);
    const int tid = tid_fresh(), lane = tid & 63, wid = __builtin_amdgcn_readfirstlane(tid >> 6), r32 = lane & 31, hi = lane >> 5;
    const int h = wid;
    LAS float* ab = (LAS float*)(lds + wid * 1280);
    LAS float* red = (LAS float*)(lds + 10240);
    LAS unsigned char* vtw = lds + 12288 + wid * 5120;
    { const float* clf = p.clf + (size_t)b * PAST * 8; float acc = 0.f;
      for (int j = 256 * (c + 1) + (tid >> 3); j < PAST; j += 64) acc += clf[(size_t)j * 8 + (tid & 7)];
      acc += __shfl_xor(acc, 8); acc += __shfl_xor(acc, 16); acc += __shfl_xor(acc, 32);
      if (lane < 8) red[wid * 8 + lane] = acc;
      __syncthreads();
      float Sh = 0.f;
#pragma unroll
      for (int w = 0; w < NWAVES; ++w) Sh += red[w * 8 + h];
      float v[4]; float tt = 0.f;
#pragma unroll
      for (int e = 0; e < 4; ++e) { v[e] = clf[(size_t)(256 * c + 4 * lane + e) * 8 + h]; tt += v[e]; }
      float inc = tt;
#pragma unroll
      for (int o = 1; o < 64; o <<= 1) { const float n = __shfl_up(inc, o); if (lane >= o) inc += n; }
      const float tot = __shfl(inc, 63); float suf = Sh + (tot - inc);
#pragma unroll
      for (int e = 3; e >= 0; --e) { ab[4 * lane + e] = suf * LOG2E; suf += v[e]; }
      if (c == 15) { float x = p.out[O_LFS + (size_t)(b * NSMP + lane) * 8 + h];
#pragma unroll
          for (int o = 1; o < 64; o <<= 1) { const float n = __shfl_up(x, o); if (lane >= o) x += n; }
          ab[256 + lane] = -x * LOG2E; } }
    const bf16* Zq = (const bf16*)(p.ws + WS_Z) + ((size_t)MP + b * NSMP) * NZ + 2048 + h * 64;
    bf16x8 qr[2][4];
#pragma unroll
    for (int qb = 0; qb < 2; ++qb)
#pragma unroll
        for (int d0 = 0; d0 < 4; ++d0) qr[qb][d0] = *(const bf16x8*)(Zq + (size_t)(32 * qb + r32) * NZ + 16 * d0 + 8 * hi);
    f32x16 o[2][2]; float mrun[2] = {-1e30f, -1e30f}, lrun[2] = {0.f, 0.f};
#pragma unroll
    for (int a = 0; a < 2; ++a)
#pragma unroll
        for (int cc = 0; cc < 2; ++cc)
#pragma unroll
            for (int r = 0; r < 16; ++r) o[a][cc][r] = 0.f;
    const size_t hoff = (size_t)h * 64;
    const float* ckb = p.ck + ((size_t)b * PAST + 256 * c) * 512 + hoff; const float* cvb = p.cv + ((size_t)b * PAST + 256 * c) * 512 + hoff;
    const float* nkb = p.out + O_FKS + (size_t)b * NSMP * 512 + hoff; const float* nvb = p.out + O_FVS + (size_t)b * NSMP * 512 + hoff;
    const int nstep = (c == 15) ? 10 : 8;
    f32x4 kraw[8], vraw[8];
#define FS_LOAD(s_) do { const int s__ = (s_); const float* kp = s__ < 8 ? ckb + (size_t)s__ * 32 * 512 : nkb + (size_t)(s__ - 8) * 32 * 512; \
        const float* vp = s__ < 8 ? cvb + (size_t)s__ * 32 * 512 : nvb + (size_t)(s__ - 8) * 32 * 512; \
        _Pragma("unroll") for (int d0 = 0; d0 < 4; ++d0) { kraw[2 * d0] = *(const f32x4*)(kp + r32 * 512 + 16 * d0 + 8 * hi); kraw[2 * d0 + 1] = *(const f32x4*)(kp + r32 * 512 + 16 * d0 + 8 * hi + 4); } \
        _Pragma("unroll") for (int i = 0; i < 4; ++i) { const int pr = 4 * i + (lane >> 4); vraw[2 * i] = *(const f32x4*)(vp + (2 * pr) * 512 + 4 * (lane & 15)); vraw[2 * i + 1] = *(const f32x4*)(vp + (2 * pr + 1) * 512 + 4 * (lane & 15)); } } while (0)
    FS_LOAD(0);
    for (int s = 0; s < nstep; ++s) {
        bf16x8 kf[4];
#pragma unroll
        for (int d0 = 0; d0 < 4; ++d0) { u32x4 w; w.x = pk2(kraw[2 * d0][0], kraw[2 * d0][1]); w.y = pk2(kraw[2 * d0][2], kraw[2 * d0][3]); w.z = pk2(kraw[2 * d0 + 1][0], kraw[2 * d0 + 1][1]); w.w = pk2(kraw[2 * d0 + 1][2], kraw[2 * d0 + 1][3]);
            kf[d0] = __builtin_bit_cast(bf16x8, w); }
#pragma unroll
        for (int i = 0; i < 4; ++i) { const int kap = 2 * (4 * i + (lane >> 4)); const int pos = (kap & ~12) | ((kap & 4) << 1) | ((kap & 8) >> 1);
#pragma unroll
            for (int e = 0; e < 4; ++e) *(LAS unsigned*)(vtw + (4 * (lane & 15) + e) * 80 + pos * 2) = pk2(vraw[2 * i][e], vraw[2 * i + 1][e]); }
        if (s + 1 < nstep) FS_LOAD(s + 1);
        f32x16 sc[2];
#pragma unroll
        for (int qb = 0; qb < 2; ++qb) {
#pragma unroll
            for (int r = 0; r < 16; ++r) sc[qb][r] = 0.f;
#pragma unroll
            for (int d0 = 0; d0 < 4; ++d0) sc[qb] = MFMA32(kf[d0], qr[qb][d0], sc[qb]); }
        const int key0 = 32 * s;
#pragma unroll
        for (int g = 0; g < 4; ++g) { const f32x4 bv = *(const LAS f32x4*)(ab + key0 + 8 * g + 4 * hi);
#pragma unroll
            for (int e = 0; e < 4; ++e) { sc[0][4 * g + e] += bv[e]; sc[1][4 * g + e] += bv[e]; } }
        if (s >= 8) {
#pragma unroll
            for (int qb = 0; qb < 2; ++qb)
#pragma unroll
                for (int r = 0; r < 16; ++r) { const int kn = key0 - 256 + crow(r, hi); if (kn > 32 * qb + r32) sc[qb][r] = -INFINITY; } }
        bf16x8 pf[2][2];
#pragma unroll
        for (int qb = 0; qb < 2; ++qb) { float rm = sc[qb][0];
#pragma unroll
            for (int r = 1; r < 16; ++r) rm = fmaxf(rm, sc[qb][r]);
            rm = fmaxf(rm, __shfl_xor(rm, 32));
            const float mn = fmaxf(mrun[qb], rm), alpha = __builtin_amdgcn_exp2f(mrun[qb] - mn); mrun[qb] = mn; float ps = 0.f;
#pragma unroll
            for (int r = 0; r < 16; ++r) { const float e_ = __builtin_amdgcn_exp2f(sc[qb][r] - mn); sc[qb][r] = e_; ps += e_; }
            lrun[qb] = lrun[qb] * alpha + ps;
#pragma unroll
            for (int r = 0; r < 16; ++r) { o[qb][0][r] *= alpha; o[qb][1][r] *= alpha; }
#pragma unroll
            for (int ks = 0; ks < 2; ++ks) { u32x4 w; w.x = pk2(sc[qb][8 * ks], sc[qb][8 * ks + 1]); w.y = pk2(sc[qb][8 * ks + 2], sc[qb][8 * ks + 3]); w.z = pk2(sc[qb][8 * ks + 4], sc[qb][8 * ks + 5]); w.w = pk2(sc[qb][8 * ks + 6], sc[qb][8 * ks + 7]);
                pf[qb][ks] = __builtin_bit_cast(bf16x8, w); } }
#pragma unroll
        for (int db = 0; db < 2; ++db)
#pragma unroll
            for (int ks = 0; ks < 2; ++ks) { const bf16x8 vf = *(const LAS bf16x8*)(vtw + (32 * db + r32) * 80 + (16 * ks + 8 * hi) * 2);
                o[0][db] = MFMA32(vf, pf[0][ks], o[0][db]); o[1][db] = MFMA32(vf, pf[1][ks], o[1][db]); }
    }
#undef FS_LOAD
    lrun[0] += __shfl_xor(lrun[0], 32); lrun[1] += __shfl_xor(lrun[1], 32);
    float* part = (float*)(p.ws + WS_PART) + (size_t)((b * 8 + h) * 16 + c) * PART_STRIDE;
#pragma unroll
    for (int qb = 0; qb < 2; ++qb) { const int q = 32 * qb + r32;
        if (hi == 0) { part[4096 + q] = mrun[qb]; part[4160 + q] = lrun[qb]; }
#pragma unroll
        for (int db = 0; db < 2; ++db)
#pragma unroll
            for (int g = 0; g < 4; ++g) *(f32x4*)(part + q * 64 + 32 * db + 8 * g + 4 * hi) = (f32x4){o[qb][db][4 * g], o[qb][db][4 * g + 1], o[qb][db][4 * g + 2], o[qb][db][4 * g + 3]}; }
}
__device__ __forceinline__ void fs_combine_job(const Params& p_, const int b, const int h) {
    const Params p = fresh_params(p_);
    const int tid = tid_fresh(), q = tid >> 3, dg = tid & 7;
    const float* part = (const float*)(p.ws + WS_PART) + (size_t)((b * 8 + h) * 16) * PART_STRIDE;
    float M = -3e38f;
#pragma unroll
    for (int c = 0; c < 16; ++c) M = fmaxf(M, part[(size_t)c * PART_STRIDE + 4096 + q]);
    float L = 0.f; f32x4 a0 = {0.f, 0.f, 0.f, 0.f}, a1 = a0;
#pragma unroll
    for (int c = 0; c < 16; ++c) { const float* pc = part + (size_t)c * PART_STRIDE; const float wg = __builtin_amdgcn_exp2f(pc[4096 + q] - M); L += wg * pc[4160 + q];
        a0 += *(const f32x4*)(pc + q * 64 + 8 * dg) * wg; a1 += *(const f32x4*)(pc + q * 64 + 8 * dg + 4) * wg; }
    const float inv = 1.0f / L; u32x4 w; w.x = pk2(a0[0] * inv, a0[1] * inv); w.y = pk2(a0[2] * inv, a0[3] * inv); w.z = pk2(a1[0] * inv, a1[1] * inv); w.w = pk2(a1[2] * inv, a1[3] * inv);
    *(u32x4*)((bf16*)(p.ws + WS_MIX) + ((size_t)MP + b * NSMP + q) * DM + 512 + h * 64 + 8 * dg) = w;
}
constexpr int NFP = NB * 8 * (TSEQ / 256);
constexpr int Q_FSC = NB * 16, Q_RETS = NB * 4, Q_RETP = NB * 4, Q_FSM = NB * 8, Q_P3S = 16, Q_FP1 = 300, Q_P4S = 4 * 22, Q_FP2 = 300, Q_P5S = 64;
constexpr int Q_FP3 = NFP - Q_FP1 - Q_FP2;
constexpr int NJOBS = Q_FSC + Q_RETS + Q_RETP + Q_FSM + Q_P3S + Q_FP1 + Q_P4S + Q_FP2 + Q_P5S + Q_FP3;
constexpr size_t WS_HS = WS_END;
constexpr size_t WS_END2 = WS_PART + (size_t)NB * 8 * 16 * PART_STRIDE * 4;
__device__ __forceinline__ void gate_wait(unsigned* c, unsigned target) {
    if (tid_fresh() == 0) { unsigned sp = 0; while (__hip_atomic_load(c, RLX_AGENT) < target && ++sp < (1u << 22)) __builtin_amdgcn_s_sleep(4);
        __builtin_amdgcn_fence(__ATOMIC_ACQUIRE, "agent"); asm volatile("s_waitcnt vmcnt(0)" ::: "memory"); }
    __syncthreads();
}
__device__ __forceinline__ void job_signal(unsigned* c) {
    asm volatile("s_waitcnt vmcnt(0)" ::: "memory");
    __syncthreads();
    if (tid_fresh() == 0) { __builtin_amdgcn_fence(__ATOMIC_RELEASE, "agent"); asm volatile("s_waitcnt vmcnt(0)" ::: "memory"); __hip_atomic_fetch_add(c, 1u, RLX_AGENT); }
}
__global__ void __launch_bounds__(NTHR, 2) hybrid_fwd(Params p) {
    extern __shared__ __attribute__((aligned(16))) unsigned char lds_raw[];
    LAS unsigned char* lds = (LAS unsigned char*)lds_raw;
    cg::grid_group grid = cg::this_grid();
    const int G = gridDim.x, bx = blockIdx.x, vcu = (G % 8 == 0) ? (bx % 8) * (G / 8) + bx / 8 : bx;
    unsigned char* ws = p.ws;
    volatile LAS unsigned* MISCU = (volatile LAS unsigned*)(lds + MISC_OFF);
    if (threadIdx.x < 32) MISCU[threadIdx.x] = 0u;
    __syncthreads();
    p0_prep(p, lds, vcu, G);
    grid.sync();
    const XcdBarrier xbar = xcd_barrier_post((unsigned*)(ws + WS_CTL) + 4096, MISCU + 8);
    p1_cumsum(p, lds);
    __syncthreads();
    { pg8::Gemm g{(const bf16*)(ws + WS_XN), (const bf16*)(ws + WS_WIN), MTOK, NZ, DM, DM}; pg8::StaticOrder S; S.init(MTOK, NZ, G, bx);
      pg8::EpiInProj E{(bf16*)(ws + WS_Z), p.out, (const float*)(ws + WS_CS)};
      pg8::gemm_phase<pg8::EpiInProj, pg8::StaticOrder, true, true>(lds, g, S, E); }
    xcd_barrier(xbar);
    { volatile LAS int* MISC = (volatile LAS int*)(lds + MISC_OFF);
      for (;;) {
          if (tid_fresh() == 0) MISC[0] = (int)atomicAdd((unsigned*)(ws + WS_CTL), 1u);
          __syncthreads();
          int job = __builtin_amdgcn_readfirstlane(MISC[0]);
          __syncthreads();
#ifndef DUP_KIND
#define DUP_KIND 0
#endif
          constexpr int NDUP = DUP_KIND == 1 ? 2560 : DUP_KIND == 2 ? 1024 : 0;
          if (job >= NJOBS + NDUP) break;
          if (job >= NJOBS) { const int d = job - NJOBS;
              if (DUP_KIND == 2) { const Params q = fresh_params(p); bf16* Z = (bf16*)(q.ws + WS_Z); attn_body::attn_unit<8>((d & 127) >> 3, d & 7, 7 - (d >> 7), (const attn_body::bf16*)(Z + 2048), (const attn_body::bf16*)(Z + 2560), (const attn_body::bf16*)(Z + 3072), (attn_body::bf16*)((bf16*)(q.ws + WS_MIX) + 512), (const float*)(q.ws + WS_CB), (char*)lds_raw); }
              __syncthreads(); continue; }
          const Params q = fresh_params(p);
          unsigned char* qws = q.ws; unsigned* cnt = (unsigned*)(qws + WS_CTL);
          bf16* Z = (bf16*)(qws + WS_Z); bf16* MIX = (bf16*)(qws + WS_MIX); bf16* XN = (bf16*)(qws + WS_XN);
          int fp = -1;
          if (job < Q_FSC) { fs_chunk_job(lds, p, job >> 4, job & 15); job_signal(cnt + 64 + 64 * (job >> 4)); }
          else if ((job -= Q_FSC) < Q_RETS) { ret_job(lds, p, true, job >> 2, job & 3); job_signal(cnt + 1216); }
          else if ((job -= Q_RETS) < Q_RETP) ret_job(lds, p, false, job >> 2, job & 3);
          else if ((job -= Q_RETP) < Q_FSM) { gate_wait(cnt + 64 + 64 * (job >> 3), 16); fs_combine_job(p, job >> 3, job & 7); job_signal(cnt + 1216); }
          else if ((job -= Q_FSM) < Q_P3S) { gate_wait(cnt + 1216, Q_RETS + Q_FSM);
              pg8::Gemm g{MIX, (const bf16*)(qws + WS_WO), MTOK, DM, DM, DM}; pg8::OneUnit S{MP / 256 + job / 4, job % 4};
              pg8::EpiResid E{q.xp, q.xs, q.out + O_Y, XN, (float*)(qws + WS_SS1)};
              pg8::gemm_phase<pg8::EpiResid, pg8::OneUnit, true, true>(lds, g, S, E); job_signal(cnt + 1280); }
          else if ((job -= Q_P3S) < Q_FP1) fp = job;
          else if ((job -= Q_FP1) < Q_P4S) { gate_wait(cnt + 1280, Q_P3S);
              pg8::Gemm g{XN, (const bf16*)(qws + WS_WGU), MTOK, NGU, DM, DM}; pg8::OneUnit S{MP / 256 + job / 22, job % 22};
              pg8::EpiGateUp E{(bf16*)(qws + WS_HS) - (size_t)MP * DFF, (const float*)(qws + WS_SS1)};
              pg8::gemm_phase<pg8::EpiGateUp, pg8::OneUnit, true, true>(lds, g, S, E); job_signal(cnt + 1344); }
          else if ((job -= Q_P4S) < Q_FP2) fp = Q_FP1 + job;
          else if ((job -= Q_FP2) < Q_P5S) { gate_wait(cnt + 1344, Q_P4S);
              const int kq = job & 3, un = job >> 2, koff = (kq == 0 ? 0 : kq == 1 ? 768 : kq == 2 ? 1408 : 2176), klen = (kq & 1) ? 640 : 768;
              pg8::Gemm g{(const bf16*)(qws + WS_HS) - (size_t)MP * DFF + koff, (const bf16*)(qws + WS_WD) + koff, MTOK, DM, klen, DFF}; pg8::OneUnit S{MP / 256 + un / 4, un % 4};
              pg8::EpiAtomic E{q.out + O_Y};
              pg8::gemm_phase<pg8::EpiAtomic, pg8::OneUnit, true, true>(lds, g, S, E); }
          else fp = Q_FP1 + Q_FP2 + (job - Q_P5S);
          if (fp >= 0) { const int qb = (TSEQ / 256 - 1) - (fp >> 7), bh = fp & 127;
              attn_body::attn_unit<8>(bh >> 3, bh & 7, qb, (const attn_body::bf16*)(Z + 2048), (const attn_body::bf16*)(Z + 2560), (const attn_body::bf16*)(Z + 3072),
                                      (attn_body::bf16*)(MIX + 512), (const float*)(qws + WS_CB), (char*)lds_raw); }
          __syncthreads();
      } }
    xcd_barrier(xbar);
#ifndef REP_G
#define REP_G 1
#endif
    for (int rep = 0; rep < REP_G; ++rep) { pg8::Gemm g{(const bf16*)(ws + WS_MIX), (const bf16*)(ws + WS_WO), MP, DM, DM, DM}; pg8::StaticOrder S; S.init(MP, DM, G, bx);
      pg8::EpiResid E{p.xp, p.xs, p.out + O_Y, (bf16*)(ws + WS_XN), rep ? (float*)(ws + WS_SS2) : (float*)(ws + WS_SS1)};
      pg8::gemm_phase<pg8::EpiResid, pg8::StaticOrder, true, true>(lds, g, S, E);
    xcd_barrier(xbar); }
    for (int rep = 0; rep < REP_G; ++rep) { pg8::Gemm g{(const bf16*)(ws + WS_XN), (const bf16*)(ws + WS_WGU), MP, NGU, DM, DM}; pg8::StaticOrder S; S.init(MP, NGU, G, bx);
      pg8::EpiGateUp E{(bf16*)(ws + WS_H), (const float*)(ws + WS_SS1)};
      pg8::gemm_phase<pg8::EpiGateUp, pg8::StaticOrder, true, true>(lds, g, S, E);
    xcd_barrier(xbar); }
    for (int rep = REP_G - 1; rep >= 0; --rep) { pg8::Gemm g{(const bf16*)(ws + WS_H), (const bf16*)(ws + WS_WD), MP, DM, DFF, DFF}; pg8::StaticOrder S; S.init(MP, DM, G, bx);
      pg8::EpiResid E{rep ? p.out + O_Y : nullptr, nullptr, rep ? (float*)(ws + WS_XN) : p.out + O_Y, nullptr, nullptr};
      pg8::gemm_phase<pg8::EpiResid, pg8::StaticOrder, true, true>(lds, g, S, E);
    xcd_barrier(xbar); }
    p6_final(p, vcu, G);
}

extern "C" void kernel_launch(void* const* d_in, const int* in_sizes, int n_in, void* d_out, int out_size, void* d_ws, size_t ws_size, hipStream_t stream) {
    static int grid = 0;
    if (grid == 0) {
        if (n_in != 16 || out_size != (int)O_END || ws_size < WS_END2) { fprintf(stderr, "kernel_launch: unexpected shapes (n_in %d, out %d, ws %zu); nothing launched\n", n_in, out_size, ws_size); grid = -1; return; }
        int dev = 0, cus = 0, per_cu = 0;
        if (hipGetDevice(&dev) != hipSuccess || hipDeviceGetAttribute(&cus, hipDeviceAttributeMultiprocessorCount, dev) != hipSuccess) { grid = -1; return; }
        if (hipFuncSetAttribute((const void*)hybrid_fwd, hipFuncAttributeMaxDynamicSharedMemorySize, LDS_BYTES) != hipSuccess) { fprintf(stderr, "kernel_launch: hipFuncSetAttribute failed\n"); grid = -1; return; }
        if (hipOccupancyMaxActiveBlocksPerMultiprocessor(&per_cu, (const void*)hybrid_fwd, NTHR, LDS_BYTES) != hipSuccess || per_cu < 1) { fprintf(stderr, "kernel_launch: occupancy query says %d blocks per CU\n", per_cu); per_cu = 1; }
        (void)hipGetLastError();
        grid = cus * per_cu;
    }
    if (grid < 0) return;
    Params p{};
    p.xp = (const float*)d_in[0]; p.xs = (const float*)d_in[1]; p.ck = (const float*)d_in[2]; p.cv = (const float*)d_in[3]; p.clf = (const float*)d_in[4]; p.sr = (const float*)d_in[5];
    p.win = (const float*)d_in[6]; p.bfg = (const float*)d_in[7]; p.gn = (const float*)d_in[8]; p.wout = (const float*)d_in[9]; p.gmix = (const float*)d_in[10]; p.gffn = (const float*)d_in[11];
    p.wg = (const float*)d_in[12]; p.wu = (const float*)d_in[13]; p.wd = (const float*)d_in[14]; p.gfin = (const float*)d_in[15];
    p.out = (float*)d_out; p.ws = (unsigned char*)d_ws;
    void* args[] = {&p};
    const hipError_t e = hipLaunchCooperativeKernel((const void*)hybrid_fwd, dim3(grid), dim3(NTHR), args, LDS_BYTES, stream);
    if (e != hipSuccess) fprintf(stderr, "kernel_launch: cooperative launch failed: %s (grid %d)\n", hipGetErrorString(e), grid);
}
```

```cpp
#include <hip/hip_runtime.h>
#include <hip/hip_cooperative_groups.h>
#include <hip/hip_bf16.h>
#include <cstdio>
#include <cstdint>
#include <cmath>
namespace cg = cooperative_groups;

constexpr int DM = 1024, NB = 16, TSEQ = 2048, MP = NB * TSEQ, NSMP = 64, MS = NB * NSMP, MTOK = MP + MS, PAST = 4096;
constexpr int DIN = 3592, NZ = 3584, DFF = 2816, NGU = 2 * DFF;
constexpr size_t O_Y = 0, O_SRP = (size_t)MTOK * DM, O_FKP = O_SRP + 1048576, O_FVP = O_FKP + 16777216, O_LFP = O_FVP + 16777216, O_SRS = O_LFP + 262144,
                 O_FKS = O_SRS + 1048576, O_FVS = O_FKS + 524288, O_LFS = O_FVS + 524288, O_END = O_LFS + 8192;
constexpr size_t MiB = 1u << 20;
constexpr size_t WS_CTL = 0, WS_SS1 = 64 * 1024, WS_SS2 = 256 * 1024, CTL_BYTES = 512 * 1024;
constexpr size_t WS_CS = 1 * MiB, WS_CB = 3 * MiB, WS_WIN = 4 * MiB, WS_WO = 11 * MiB, WS_WGU = 13 * MiB, WS_WD = 24 * MiB;
constexpr size_t WS_XN = 32 * MiB, WS_MIX = 98 * MiB, WS_Z = 164 * MiB, WS_H = WS_Z, WS_END = 395 * MiB;
constexpr float C2F = 0.125f * 1.4426950408889634f;

struct Params {
    const float *xp, *xs, *ck, *cv, *clf, *sr, *win, *bfg, *gn, *wout, *gmix, *gffn, *wg, *wu, *wd, *gfin;
    float* out; unsigned char* ws;
};

__device__ __forceinline__ int tid_fresh() { int t = threadIdx.x; asm volatile("" : "+v"(t)); return t; }

__device__ __forceinline__ Params fresh_params(const Params& p) {
    Params q = p;
    asm volatile("" : "+s"(q.out), "+s"(q.ws), "+s"(q.ck), "+s"(q.cv), "+s"(q.clf), "+s"(q.sr), "+s"(q.gn));
    return q;
}

namespace pg8 {
#define PG8_LAS __attribute__((address_space(3)))
typedef unsigned short bf16_t;
typedef short bf16x8 __attribute__((ext_vector_type(8)));
typedef float f32x4 __attribute__((ext_vector_type(4)));
typedef unsigned u32x4 __attribute__((ext_vector_type(4)));
constexpr int BM = 256, BK = 64, HALF = 128, HTB = HALF * BK * 2  , STAGE_BYTES = 8 * HTB, NXCD = 8, WGM = 8;

__host__ __device__ __forceinline__ int lds_byte(int r, int c) { const int st = (r >> 4) * 2 + (c >> 5), rr = r & 15, cc = c & 31, ob = rr * 64 + cc * 2; return st * 1024 + (ob ^ (((ob >> 9) & 1) << 5)); }
__host__ __device__ __forceinline__ void stage_rc(int b, int& R, int& C) { const int st = b / 1024, sb = b % 1024, swz = sb ^ (((sb >> 9) & 1) << 5); R = (st >> 1) * 16 + swz / 64; C = (st & 1) * 32 + (swz % 64) / 2; }
__host__ __device__ __forceinline__ int perm32(int rho) { const int n = rho >> 4, i = rho & 15; return 8 * (i >> 2) + 4 * n + (i & 3); }

struct Unit { int pm, pn; };
struct Gemm { const bf16_t* A; const bf16_t* Bt; int M, N, K, ld; };

struct StaticOrder {
    int nM, nN, nwg, G, c;
    __host__ __device__ void init(int M, int N, int G_, int c_) { nM = M / BM; nN = N / BM; nwg = nM * nN; G = G_; c = c_; }
    __host__ __device__ bool next(int i, Unit& u) const {
        const long L = (long)i * G + c; if (L >= nwg) return false;
        int wgid = (int)L; { const int q = nwg / NXCD, r = nwg % NXCD, xcd = wgid % NXCD, off = wgid / NXCD; wgid = (xcd < r ? xcd * (q + 1) : r * (q + 1) + (xcd - r) * q) + off; }
        const int nig = WGM * nN, gid = wgid / nig, fm = gid * WGM, gsz = (nM - fm) < WGM ? (nM - fm) : WGM;
        u.pm = fm + ((wgid % nig) % gsz); u.pn = (wgid % nig) / gsz; return true;
    }
    __device__ __forceinline__ void a_ready(const Unit&) const {}
    __device__ __forceinline__ void done(const Unit&) const {}
};


struct OneUnit { int pm, pn;
    __device__ __forceinline__ bool next(int i, Unit& u) const { if (i) return false; u.pm = pm; u.pn = pn; return true; }
    __device__ __forceinline__ void a_ready(const Unit&) const {}
    __device__ __forceinline__ void done(const Unit&) const {}
};
typedef float f32x2 __attribute__((ext_vector_type(2)));
typedef __bf16 bf16x2_t __attribute__((ext_vector_type(2)));
typedef unsigned u32x2 __attribute__((ext_vector_type(2)));
__device__ __forceinline__ unsigned cvt_pk_bf16(float lo, float hi) { f32x2 v = {lo, hi}; bf16x2_t b = __builtin_convertvector(v, bf16x2_t); return __builtin_bit_cast(unsigned, b); }
__device__ __forceinline__ float silu_f(float x) { return x * __builtin_amdgcn_rcpf(1.f + __builtin_amdgcn_exp2f(x * -1.4426950408889634f)); }

struct EpiInProj {
    static constexpr bool PERM = true, AFTER_DRAIN = false;
    bf16_t* Z; float* out; const float* cs;
    __device__ __forceinline__ void operator()(const f32x4 (&acc)[2][2][4][2], const Unit& u, int wr, int wc, int fr, int fq) const {
        const int pn = u.pn, row0 = u.pm * BM + wr * 64 + fr; const bool prompt = u.pm < (MP / BM);
        if (pn < 4) {
            const float sc = pn < 2 ? 0.08838834764831845f : 1.f; const int d0 = 16 * wc + 4 * fq;
#pragma unroll
            for (int ai = 0; ai < 2; ++ai)
#pragma unroll
                for (int m = 0; m < 4; ++m) { const int row = row0 + ai * HALF + m * 16; const int tix = prompt ? (row & (TSEQ - 1)) : TSEQ + ((row - MP) & (NSMP - 1));
                    const float* cr = cs + (size_t)tix * 128 + 2 * d0; const f32x4 c01 = *(const f32x4*)cr, c23 = *(const f32x4*)(cr + 4);
                    bf16_t* zrow = Z + (size_t)row * NZ + pn * BM + d0;
#pragma unroll
                    for (int bj = 0; bj < 2; ++bj) { const f32x4 v0 = acc[ai][bj][m][0], v1 = acc[ai][bj][m][1];
                        const float a0 = (v0[0] * c01[0] - v0[1] * c01[1]) * sc, b0 = (v0[0] * c01[1] + v0[1] * c01[0]) * sc;
                        const float a1 = (v0[2] * c01[2] - v0[3] * c01[3]) * sc, b1 = (v0[2] * c01[3] + v0[3] * c01[2]) * sc;
                        const float a2 = (v1[0] * c23[0] - v1[1] * c23[1]) * sc, b2 = (v1[0] * c23[1] + v1[1] * c23[0]) * sc;
                        const float a3 = (v1[2] * c23[2] - v1[3] * c23[3]) * sc, b3 = (v1[2] * c23[3] + v1[3] * c23[2]) * sc;
                        u32x2 w1, w2; w1.x = cvt_pk_bf16(a0, a1); w1.y = cvt_pk_bf16(a2, a3); w2.x = cvt_pk_bf16(b0, b1); w2.y = cvt_pk_bf16(b2, b3);
                        *(u32x2*)(zrow + bj * HALF) = w1; *(u32x2*)(zrow + bj * HALF + 64) = w2; } }
        } else {
            const float sc = (pn == 8 || pn == 9) ? C2F : 1.f; const int cw = wc * 32 + 8 * fq;
            float* fo = nullptr; size_t fstride = 512;
            if (pn >= 10) { const bool isv = pn >= 12; const int cb = (pn - (isv ? 12 : 10)) * BM + cw;
                fo = prompt ? out + (isv ? O_FVP : O_FKP) + (size_t)row0 * 512 + cb : out + (isv ? O_FVS : O_FKS) + (size_t)(row0 - MP) * 512 + cb; }
#pragma unroll
            for (int ai = 0; ai < 2; ++ai)
#pragma unroll
                for (int m = 0; m < 4; ++m) { bf16_t* rowp = Z + (size_t)(row0 + ai * HALF + m * 16) * NZ + pn * BM + cw; float* fr_ = fo + (size_t)(ai * HALF + m * 16) * fstride;
#pragma unroll
                    for (int bj = 0; bj < 2; ++bj) { const f32x4 v0 = acc[ai][bj][m][0] * sc, v1 = acc[ai][bj][m][1] * sc;
                        u32x4 w; w.x = cvt_pk_bf16(v0[0], v0[1]); w.y = cvt_pk_bf16(v0[2], v0[3]); w.z = cvt_pk_bf16(v1[0], v1[1]); w.w = cvt_pk_bf16(v1[2], v1[3]);
                        *(u32x4*)(rowp + bj * HALF) = w;
                        if (fo) { *(f32x4*)(fr_ + bj * HALF) = v0; *(f32x4*)(fr_ + bj * HALF + 4) = v1; } } }
        }
    }
};
struct EpiResid {
    static constexpr bool PERM = false, AFTER_DRAIN = false;
    const float* xp; const float* xs; float* Y; bf16_t* Yb; float* ss;
    __device__ __forceinline__ void operator()(const f32x4 (&acc)[2][2][4][2], const Unit& u, int wr, int wc, int fr, int fq) const {
        const int row0 = u.pm * BM + wr * 64 + fr, col0 = u.pn * BM + wc * 32 + 4 * fq; const bool prompt = u.pm < (MP / BM);
#pragma unroll
        for (int ai = 0; ai < 2; ++ai)
#pragma unroll
            for (int m = 0; m < 4; ++m) { const int row = row0 + ai * HALF + m * 16; float* yr = Y + (size_t)row * DM + col0;
                const float* br = xp ? (prompt ? xp + (size_t)row * DM + col0 : xs + (size_t)(row - MP) * DM + col0) : yr; float s = 0.f;
#pragma unroll
                for (int bj = 0; bj < 2; ++bj)
#pragma unroll
                    for (int n = 0; n < 2; ++n) { const int co = bj * HALF + n * 16; const f32x4 v = acc[ai][bj][m][n] + *(const f32x4*)(br + co); *(f32x4*)(yr + co) = v;
                        s += (v[0] * v[0] + v[1] * v[1]) + (v[2] * v[2] + v[3] * v[3]);
                        if (Yb) { u32x2 w; w.x = cvt_pk_bf16(v[0], v[1]); w.y = cvt_pk_bf16(v[2], v[3]); *(u32x2*)(Yb + (size_t)row * DM + col0 + co) = w; } }
                if (ss) { s += __shfl_xor(s, 16); s += __shfl_xor(s, 32); }
                if (ss && fq == 0) atomicAdd(ss + row, s); }
    }
};
struct EpiGateUp {
    static constexpr bool PERM = true, AFTER_DRAIN = false;
    bf16_t* H; const float* ss;
    __device__ __forceinline__ void operator()(const f32x4 (&acc)[2][2][4][2], const Unit& u, int wr, int wc, int fr, int fq) const {
        const int row0 = u.pm * BM + wr * 64 + fr, f0 = u.pn * 128 + wc * 16 + 4 * fq;
#pragma unroll
        for (int ai = 0; ai < 2; ++ai)
#pragma unroll
            for (int m = 0; m < 4; ++m) { const int row = row0 + ai * HALF + m * 16; const float r = 1.0f / sqrtf(ss[row] * (1.0f / DM) + 1e-6f);
#pragma unroll
                for (int bj = 0; bj < 2; ++bj) { const f32x4 v0 = acc[ai][bj][m][0] * r, v1 = acc[ai][bj][m][1] * r;
                    u32x2 w; w.x = cvt_pk_bf16(silu_f(v0[0]) * v0[1], silu_f(v0[2]) * v0[3]); w.y = cvt_pk_bf16(silu_f(v1[0]) * v1[1], silu_f(v1[2]) * v1[3]);
                    *(u32x2*)(H + (size_t)row * DFF + f0 + bj * 64) = w; } }
    }
};

struct EpiAtomic {
    static constexpr bool PERM = false, AFTER_DRAIN = false;
    float* Y;
    __device__ __forceinline__ void operator()(const f32x4 (&acc)[2][2][4][2], const Unit& u, int wr, int wc, int fr, int fq) const {
        const int row0 = u.pm * BM + wr * 64 + fr, col0 = u.pn * BM + wc * 32 + 4 * fq;
#pragma unroll
        for (int ai = 0; ai < 2; ++ai)
#pragma unroll
            for (int m = 0; m < 4; ++m) { float* yr = Y + (size_t)(row0 + ai * HALF + m * 16) * DM + col0;
#pragma unroll
                for (int bj = 0; bj < 2; ++bj)
#pragma unroll
                    for (int n = 0; n < 2; ++n) { const f32x4 v = acc[ai][bj][m][n]; float* y = yr + bj * HALF + n * 16;
#pragma unroll
                        for (int e = 0; e < 4; ++e) __hip_atomic_fetch_add(y + e, v[e], __ATOMIC_RELAXED, __HIP_MEMORY_SCOPE_AGENT); } }
    }
};

template <class Epi, class Sched, bool ALIGN_EPI = false, bool SP2 = false>
__device__ __forceinline__ void gemm_phase(PG8_LAS unsigned char* lds, const Gemm g, const Sched& S, const Epi& E) {
    const int tid = tid_fresh(), wid = __builtin_amdgcn_readfirstlane(tid >> 6), lane = tid & 63, wr = wid >> 2, wc = wid & 3, fr = lane & 15, fq = lane >> 4;
    const int K = g.ld, nt = g.K / BK;
    unsigned voffA[2], voffB[2];
#pragma unroll
    for (int i = 0; i < 2; ++i) { int R, C; stage_rc(tid * 16 + i * 8192, R, C); const int Rb = Epi::PERM ? ((R & ~31) + perm32(R & 31)) : R;
        voffA[i] = (unsigned)(R * K + C) * 2u; voffB[i] = (unsigned)(Rb * K + C) * 2u; }
    const size_t kstep = (size_t)(BK * 2);
    const size_t hstep = (size_t)HALF * K * 2;
    const size_t tstep = 2 * hstep;
    const unsigned ldsw = (unsigned)wid * 1024u;
    const int aoff = lds_byte(wr * 64 + fr, fq * 8), boff = lds_byte(wc * 32 + fr, fq * 8);
#define PG8_SA(b, h) (((b) * 2 + (h)) * HTB)
#define PG8_SB(b, h) ((4 + (b) * 2 + (h)) * HTB)
#define PG8_STAGE(bufoff, gbase, voff) do { _Pragma("unroll") for (int _i = 0; _i < 2; ++_i) \
        __builtin_amdgcn_global_load_lds((const unsigned*)((const char*)(gbase) + (voff)[_i]), (PG8_LAS unsigned*)(lds + (bufoff) + ldsw + _i * 8192), 16, 0, 0); } while (0)
#define PG8_LDA(dst, b, h) do { _Pragma("unroll") for (int m = 0; m < 4; ++m) _Pragma("unroll") for (int k = 0; k < 2; ++k) dst[m][k] = *(const PG8_LAS bf16x8*)(lds + PG8_SA(b, h) + aoff + m * 2048 + k * 1024); } while (0)
#define PG8_LDB(dst, b, h) do { _Pragma("unroll") for (int n = 0; n < 2; ++n) _Pragma("unroll") for (int k = 0; k < 2; ++k) dst[n][k] = *(const PG8_LAS bf16x8*)(lds + PG8_SB(b, h) + boff + n * 2048 + k * 1024); } while (0)
#define PG8_MMA(ai, bj, At, Bt) do { __builtin_amdgcn_s_setprio(1); _Pragma("unroll") for (int m = 0; m < 4; ++m) _Pragma("unroll") for (int n = 0; n < 2; ++n) _Pragma("unroll") for (int k = 0; k < 2; ++k) \
        acc[ai][bj][m][n] = __builtin_amdgcn_mfma_f32_16x16x32_bf16(Bt[n][k], At[m][k], acc[ai][bj][m][n], 0, 0, 0); __builtin_amdgcn_s_setprio(0); } while (0)
#define PG8_WAIT_V(n) asm volatile("s_waitcnt vmcnt(" #n ")" ::: "memory")
#define PG8_WAIT_L(n) asm volatile("s_waitcnt lgkmcnt(" #n ")" ::: "memory")
#define PG8_BAR __builtin_amdgcn_s_barrier()
#define PG8_SCHED __builtin_amdgcn_sched_barrier(0)
    Unit cur, nxt; int ui = 0;
    if (!S.next(0, cur)) return;
    f32x4 acc[2][2][4][2];
#pragma unroll
    for (int a = 0; a < 2; ++a)
#pragma unroll
        for (int b = 0; b < 2; ++b)
#pragma unroll
            for (int m = 0; m < 4; ++m)
#pragma unroll
                for (int n = 0; n < 2; ++n) acc[a][b][m][n] = (f32x4){0.f, 0.f, 0.f, 0.f};
    bf16x8 At[4][2], B0[2][2], B1[2][2];
    const char* cA = (const char*)g.A + (size_t)cur.pm * tstep; const char* cB = (const char*)g.Bt + (size_t)cur.pn * tstep;
    S.a_ready(cur);
    if constexpr (SP2) {
        PG8_STAGE(PG8_SB(0, 0), cB, voffB); PG8_STAGE(PG8_SB(0, 1), cB + hstep, voffB); PG8_STAGE(PG8_SA(0, 0), cA, voffA); PG8_STAGE(PG8_SA(0, 1), cA + hstep, voffA);
        if (wr == 1) PG8_BAR;
        PG8_WAIT_V(2); PG8_BAR;
        PG8_STAGE(PG8_SB(1, 0), cB + kstep, voffB); PG8_STAGE(PG8_SA(1, 0), cA + kstep, voffA); PG8_STAGE(PG8_SB(1, 1), cB + hstep + kstep, voffB);
        PG8_WAIT_V(6); PG8_BAR;
    } else {
        PG8_STAGE(PG8_SB(0, 0), cB, voffB); PG8_STAGE(PG8_SA(0, 0), cA, voffA); PG8_STAGE(PG8_SB(0, 1), cB + hstep, voffB); PG8_STAGE(PG8_SA(0, 1), cA + hstep, voffA);
        if (wr == 1) PG8_BAR;
        PG8_WAIT_V(4); PG8_BAR;
        PG8_STAGE(PG8_SB(1, 0), cB + kstep, voffB); PG8_STAGE(PG8_SA(1, 0), cA + kstep, voffA); PG8_STAGE(PG8_SB(1, 1), cB + hstep + kstep, voffB);
        PG8_WAIT_V(6); PG8_BAR;
    }
    for (;;) {
        const bool has_next = S.next(ui + 1, nxt);
        const char* nA = has_next ? (const char*)g.A + (size_t)nxt.pm * tstep : cA; const char* nB = has_next ? (const char*)g.Bt + (size_t)nxt.pn * tstep : cB;
        for (int t = 0; t < nt; t += 2) {
            const bool last = (t == nt - 2);
            const char* a1 = cA + (size_t)(t + 1) * kstep;
            const char* a2 = last ? nA : cA + (size_t)(t + 2) * kstep; const char* b2 = last ? nB : cB + (size_t)(t + 2) * kstep;
            const char* a3 = a2 + kstep; const char* b3 = b2 + kstep;
            if (last && has_next) S.a_ready(nxt);
            if constexpr (SP2) {
            PG8_LDB(B0, 0, 0); PG8_LDB(B1, 0, 1); PG8_SCHED; PG8_LDA(At, 0, 0); PG8_STAGE(PG8_SA(1, 1), a1 + hstep, voffA);
            PG8_WAIT_V(8); PG8_WAIT_L(0); PG8_BAR; PG8_MMA(0, 0, At, B0); PG8_MMA(0, 1, At, B1); PG8_BAR; PG8_SCHED;
            PG8_LDA(At, 0, 1); PG8_STAGE(PG8_SB(0, 0), b2, voffB); PG8_STAGE(PG8_SB(0, 1), b2 + hstep, voffB); PG8_STAGE(PG8_SA(0, 0), a2, voffA);
            PG8_WAIT_V(8); PG8_WAIT_L(0); PG8_BAR; PG8_MMA(1, 0, At, B0); PG8_MMA(1, 1, At, B1); PG8_BAR; PG8_SCHED;
            PG8_LDB(B0, 1, 0); PG8_LDB(B1, 1, 1); PG8_SCHED; PG8_LDA(At, 1, 0); PG8_STAGE(PG8_SA(0, 1), a2 + hstep, voffA);
            PG8_WAIT_V(8); PG8_WAIT_L(0); PG8_BAR; PG8_MMA(0, 0, At, B0); PG8_MMA(0, 1, At, B1); PG8_BAR; PG8_SCHED;
            PG8_LDA(At, 1, 1); PG8_STAGE(PG8_SB(1, 0), b3, voffB); PG8_STAGE(PG8_SB(1, 1), b3 + hstep, voffB); PG8_STAGE(PG8_SA(1, 0), a3, voffA);
            PG8_WAIT_V(8); PG8_WAIT_L(0); PG8_BAR; PG8_MMA(1, 0, At, B0); PG8_MMA(1, 1, At, B1); PG8_BAR; PG8_SCHED;
            } else {
            PG8_LDB(B0, 0, 0); PG8_SCHED; PG8_LDA(At, 0, 0); PG8_STAGE(PG8_SA(1, 1), a1 + hstep, voffA);
            PG8_WAIT_L(8); PG8_BAR; PG8_WAIT_L(0); PG8_MMA(0, 0, At, B0); PG8_BAR; PG8_SCHED;
            PG8_LDB(B1, 0, 1); PG8_STAGE(PG8_SB(0, 0), b2, voffB);
            PG8_BAR; PG8_WAIT_L(0); PG8_MMA(0, 1, At, B1); PG8_BAR;
            PG8_LDA(At, 0, 1); PG8_STAGE(PG8_SA(0, 0), a2, voffA);
            PG8_BAR; PG8_WAIT_L(0); PG8_MMA(1, 0, At, B0); PG8_BAR; PG8_SCHED;
            PG8_STAGE(PG8_SB(0, 1), b2 + hstep, voffB);
            PG8_WAIT_V(6); PG8_BAR; PG8_MMA(1, 1, At, B1); PG8_BAR;
            PG8_LDB(B0, 1, 0); PG8_SCHED; PG8_LDA(At, 1, 0); PG8_STAGE(PG8_SA(0, 1), a2 + hstep, voffA);
            PG8_WAIT_L(8); PG8_BAR; PG8_WAIT_L(0); PG8_MMA(0, 0, At, B0); PG8_BAR; PG8_SCHED;
            PG8_LDB(B1, 1, 1); PG8_STAGE(PG8_SB(1, 0), b3, voffB);
            PG8_BAR; PG8_WAIT_L(0); PG8_MMA(0, 1, At, B1); PG8_BAR;
            PG8_LDA(At, 1, 1); PG8_STAGE(PG8_SA(1, 0), a3, voffA);
            PG8_BAR; PG8_WAIT_L(0); PG8_MMA(1, 0, At, B0); PG8_BAR; PG8_SCHED;
            PG8_STAGE(PG8_SB(1, 1), b3 + hstep, voffB);
            PG8_WAIT_V(6); PG8_BAR; PG8_MMA(1, 1, At, B1); PG8_BAR;
            }
        }
        if constexpr (ALIGN_EPI) { if (wr == 0) PG8_BAR; }
        if constexpr (!Epi::AFTER_DRAIN) { E(acc, cur, wr, wc, fr, fq); S.done(cur); }
        if (!has_next) break;
#pragma unroll
        for (int a = 0; a < 2; ++a)
#pragma unroll
            for (int b = 0; b < 2; ++b)
#pragma unroll
                for (int m = 0; m < 4; ++m)
#pragma unroll
                    for (int n = 0; n < 2; ++n) acc[a][b][m][n] = (f32x4){0.f, 0.f, 0.f, 0.f};
        cur = nxt; cA = nA; cB = nB; ++ui;
        if constexpr (ALIGN_EPI) { if (wr == 1) PG8_BAR; }
    }
    PG8_WAIT_V(0);
    if constexpr (!ALIGN_EPI) { if (wr == 0) PG8_BAR; }
    PG8_BAR;
    if constexpr (Epi::AFTER_DRAIN) { E.fused(acc, cur, wr, wc, fr, fq, lds, wid, lane); S.done(cur); }
#undef PG8_SA
#undef PG8_SB
#undef PG8_STAGE
#undef PG8_LDA
#undef PG8_LDB
#undef PG8_MMA
#undef PG8_WAIT_V
#undef PG8_WAIT_L
#undef PG8_BAR
#undef PG8_SCHED
}
}
#include <hip/hip_bf16.h>
#include <cmath>
namespace attn_body {
using bf16=__hip_bfloat16;
using bf16x8=__attribute__((ext_vector_type(8)))short;
using s16x4=__attribute__((ext_vector_type(4)))short;
using f32x16=__attribute__((ext_vector_type(16)))float;
using u32x4=__attribute__((ext_vector_type(4)))unsigned;
using f32x4b=__attribute__((ext_vector_type(4)))float;
constexpr int BATCH=16,NHEAD=8,SEQ=2048,D=64,PQ=3584,PO=1024;
constexpr int NW=8,QBLK=32,QB=QBLK*NW,KVBLK=64,NQB=SEQ/QB;
constexpr int ATTN_UNIT_ROWS=QB;
__device__ __forceinline__ int crow(int r,int hi){return (r&3)+8*(r>>2)+4*hi;}
#define SBAR() __builtin_amdgcn_sched_barrier(0)
__device__ __forceinline__ void cmask(f32x16&p0,f32x16&p1,int jb,int qrel,int hi){
  const float NEG=-INFINITY; int kb=64*jb+4*hi;
  #pragma unroll
  for(int r=0;r<16;++r){int kv=kb+(r&3)+8*(r>>2); if(kv>qrel)p0[r]=NEG; if(kv+32>qrel)p1[r]=NEG;}
}

constexpr int NSLOT=3, SLOTB=8192;
constexpr int LDS_K=0, LDS_V=NSLOT*SLOTB, LDS_WS=2*NSLOT*SLOTB, LDS_OST=LDS_WS+NW*64*4, LDS_BIAS=LDS_OST+NW*4096, LDS_BYTES=LDS_BIAS+SEQ*4;
constexpr float C2=0.125f*1.4426950408889634f;
__device__ __forceinline__ void glds16(const void*gsrc,unsigned lds_dst){unsigned keep;
  asm volatile("s_mov_b32 %0, m0\n\ts_mov_b32 m0, %2\n\ts_nop 0\n\tglobal_load_lds_dwordx4 %1, off\n\ts_mov_b32 m0, %0":"=&s"(keep):"v"(gsrc),"s"(lds_dst):"memory");}
__device__ __forceinline__ float max3f(float a,float b,float c){float r;asm("v_max3_f32 %0, %1, %2, %3":"=v"(r):"v"(a),"v"(b),"v"(c));return r;}
__device__ __forceinline__ float max2f(float a,float b){float r;asm("v_max_f32_e32 %0, %1, %2":"=v"(r):"v"(a),"v"(b));return r;}
__device__ __forceinline__ float fadd_s(float a,float b){float r;asm("v_add_f32_e32 %0, %1, %2":"=v"(r):"v"(a),"v"(b));return r;}
__device__ __forceinline__ float fsub_s(float a,float b){float r;asm("v_sub_f32_e32 %0, %1, %2":"=v"(r):"v"(a),"v"(b));return r;}
typedef float f32x2_t __attribute__((ext_vector_type(2))); typedef __bf16 bf16x2_t __attribute__((ext_vector_type(2)));
__device__ __forceinline__ unsigned cvtpk_s(float lo,float hi){f32x2_t v={lo,hi};bf16x2_t b=__builtin_convertvector(v,bf16x2_t);return __builtin_bit_cast(unsigned,b);}
#define WAIT_BAR(N) asm volatile("s_waitcnt vmcnt(" #N ") lgkmcnt(0)\n\ts_barrier":::"memory")

__device__ __forceinline__ void qkt(f32x16&p0,f32x16&p1,const char*Kslot,const bf16x8*qr,const f32x16&negm,int r32,int hi){
  const char*kb=Kslot+hi*1024+r32*16;
  #pragma unroll
  for(int d0=0;d0<4;++d0){
    const bf16x8 b0=*reinterpret_cast<const bf16x8*>(kb+d0*2048);
    const bf16x8 b1=*reinterpret_cast<const bf16x8*>(kb+d0*2048+512);
    if(d0==0){p0=__builtin_amdgcn_mfma_f32_32x32x16_bf16(b0,qr[0],negm,0,0,0);p1=__builtin_amdgcn_mfma_f32_32x32x16_bf16(b1,qr[0],negm,0,0,0);}
    else{p0=__builtin_amdgcn_mfma_f32_32x32x16_bf16(b0,qr[d0],p0,0,0,0);p1=__builtin_amdgcn_mfma_f32_32x32x16_bf16(b1,qr[d0],p1,0,0,0);}}
}
typedef __attribute__((address_space(3))) const char* lds_cptr;
typedef short v4i16_t __attribute__((ext_vector_type(4)));
__device__ __forceinline__ void kload8(bf16x8*kf,lds_cptr kp){
  kf[0]=*(const __attribute__((address_space(3))) bf16x8*)(kp);      kf[1]=*(const __attribute__((address_space(3))) bf16x8*)(kp+512);
  kf[2]=*(const __attribute__((address_space(3))) bf16x8*)(kp+2048); kf[3]=*(const __attribute__((address_space(3))) bf16x8*)(kp+2560);
  kf[4]=*(const __attribute__((address_space(3))) bf16x8*)(kp+4096); kf[5]=*(const __attribute__((address_space(3))) bf16x8*)(kp+4608);
  kf[6]=*(const __attribute__((address_space(3))) bf16x8*)(kp+6144); kf[7]=*(const __attribute__((address_space(3))) bf16x8*)(kp+6656);
}
__device__ __forceinline__ void kload2(bf16x8*kf,lds_cptr kp,int j){ kf[2*j]=*(const __attribute__((address_space(3))) bf16x8*)(kp+j*2048); kf[2*j+1]=*(const __attribute__((address_space(3))) bf16x8*)(kp+j*2048+512); }
__device__ __forceinline__ s16x4 vtr(lds_cptr p){ return __builtin_bit_cast(s16x4,__builtin_amdgcn_ds_read_tr16_b64_v4i16((__attribute__((address_space(3))) v4i16_t*)p)); }
__device__ __forceinline__ float rowmax(const f32x16&p0,const f32x16&p1){
  float a=max3f(p0[0],p0[1],p1[0]),b=max3f(p0[2],p0[3],p1[1]);a=max3f(a,p1[2],p1[3]);
  #pragma unroll
  for(int r=4;r<16;r+=4){a=max3f(a,p0[r],p0[r+1]);b=max3f(b,p0[r+2],p0[r+3]);a=max3f(a,p1[r],p1[r+1]);b=max3f(b,p1[r+2],p1[r+3]);}
  const float m=max2f(a,b);
  auto rr=__builtin_amdgcn_permlane32_swap(__float_as_uint(m),__float_as_uint(m),false,false);
  return max2f(__uint_as_float(rr[0]),__uint_as_float(rr[1]));
}
__device__ __forceinline__ void pv(f32x16*o,int vb,bf16x8 pa0,bf16x8 pa1,bf16x8 pa2,bf16x8 pa3){
  #pragma unroll
  for(int d0=0;d0<2;++d0){s16x4 lo[4],hi[4];
    #pragma unroll
    for(int ks=0;ks<4;++ks){
      asm volatile("ds_read_b64_tr_b16 %0,%1 offset:%c2":"=&v"(lo[ks]):"v"(vb),"i"(d0*4096+ks*1024):"memory");
      asm volatile("ds_read_b64_tr_b16 %0,%1 offset:%c2":"=&v"(hi[ks]):"v"(vb),"i"(d0*4096+ks*1024+512):"memory");}
    asm volatile("s_waitcnt lgkmcnt(0)":::"memory");SBAR();
    #define PK(k) (bf16x8){lo[k][0],lo[k][1],lo[k][2],lo[k][3],hi[k][0],hi[k][1],hi[k][2],hi[k][3]}
    o[d0]=__builtin_amdgcn_mfma_f32_32x32x16_bf16(pa0,PK(0),o[d0],0,0,0);
    o[d0]=__builtin_amdgcn_mfma_f32_32x32x16_bf16(pa1,PK(1),o[d0],0,0,0);
    o[d0]=__builtin_amdgcn_mfma_f32_32x32x16_bf16(pa2,PK(2),o[d0],0,0,0);
    o[d0]=__builtin_amdgcn_mfma_f32_32x32x16_bf16(pa3,PK(3),o[d0],0,0,0);
    #undef PK
  }
}

#ifndef ATTN_STORE16
#define ATTN_STORE16(p,v) (*(u32x4*)(p)=(v))
#endif
template<int THRL> __device__ __forceinline__ void attn_unit(int b,int h,int qb,const bf16*Q,const bf16*__restrict__ K,const bf16*__restrict__ V,bf16*O,const float*__restrict__ CB,char*shm){
  const int tid=tid_fresh(),lane=tid&63,r32=lane&31,hi=lane>>5; const int wid=__builtin_amdgcn_readfirstlane(tid>>6);
  const long rowbase=(long)b*SEQ; const int q0=qb*QB;
  const bf16*Qw=Q+(rowbase+q0+wid*QBLK)*PQ+h*D;
  const bf16*Kh=K+rowbase*PQ+h*D,*Vh=V+rowbase*PQ+h*D;
  const unsigned lds0=(unsigned)(uintptr_t)shm;
  float*wsf=(float*)(shm+LDS_WS)+wid*64;
  const bf16*ksrc=Kh+(long)lane*PQ+wid*8;
  const bf16*vsrc=Vh+(long)(16*(wid&3)+(lane>>2))*PQ+(wid>>2)*32+(lane&3)*8;
  const unsigned kdst=lds0+LDS_K+wid*1024, vdst=lds0+LDS_V+wid*1024;
  #define DMA_K(t,slot) glds16(ksrc+(long)(t)*KVBLK*PQ,(unsigned)__builtin_amdgcn_readfirstlane(kdst+(slot)))
  #define DMA_V(t,slot) glds16(vsrc+(long)(t)*KVBLK*PQ,(unsigned)__builtin_amdgcn_readfirstlane(vdst+(slot)))
  const int vb0=(int)(lds0+LDS_V)+((lane>>4)&1)*32+(lane&3)*8+(4*hi+((lane&15)>>2))*64;
  const char*Kbase=shm+LDS_K; bf16x8 kf[8];
  const lds_cptr shm3=(lds_cptr)shm; const lds_cptr kp0=shm3+LDS_K+hi*1024+r32*16; const lds_cptr vp0=shm3+LDS_V+((lane>>4)&1)*32+(lane&3)*8+(4*hi+((lane&15)>>2))*64;
  const int NT=(q0+QB)/KVBLK;
  { const float*cb=CB+(long)(b*NHEAD+h)*SEQ; float*bl=(float*)(shm+LDS_BIAS); for(int i=tid;i<NT*KVBLK;i+=NW*64)bl[i]=cb[i]*(-1.4426950408889634f); }
  const lds_cptr bp0=(lds_cptr)shm+LDS_BIAS+hi*16;
  #define KBIAS(P0,P1,t) do{ const lds_cptr bp_=bp0+(t)*256; _Pragma("unroll") for(int g_=0;g_<4;++g_){ const f32x4b a_=*(const __attribute__((address_space(3))) f32x4b*)(bp_+g_*32); const f32x4b c_=*(const __attribute__((address_space(3))) f32x4b*)(bp_+128+g_*32); \
      P0[4*g_]+=a_[0];P0[4*g_+1]+=a_[1];P0[4*g_+2]+=a_[2];P0[4*g_+3]+=a_[3]; P1[4*g_]+=c_[0];P1[4*g_+1]+=c_[1];P1[4*g_+2]+=c_[2];P1[4*g_+3]+=c_[3]; } }while(0)
  DMA_K(0,0);DMA_V(0,0);DMA_K(1,SLOTB);
  bf16x8 qr[4];
  #pragma unroll
  for(int d0=0;d0<4;++d0)qr[d0]=*reinterpret_cast<const bf16x8*>(&Qw[(long)r32*PQ+d0*16+hi*8]);
  float mhat=0.f,l_reg=0.f;f32x16 o[2];o[0]=f32x16{};o[1]=f32x16{};f32x16 negm=f32x16{};asm volatile("":"+v"(negm));
  const int qrel=wid*QBLK+r32;
  #define CMASK(P0,P1,t) do{int jb_=(t)-(NT-4); if(jb_>=0)cmask(P0,P1,jb_,qrel,hi);}while(0)
  bool resc=false;
  #define START(P0,P1) do{ const float rm=rowmax(P0,P1); resc=false; \
    { const float dl=rm; mhat=fadd_s(mhat,dl); \
      _Pragma("unroll") for(int r=0;r<16;++r){P0[r]=fsub_s(P0[r],dl);P1[r]=fsub_s(P1[r],dl);} \
      _Pragma("unroll") for(int r=0;r<16;++r)negm[r]=-mhat; asm volatile("":"+v"(negm)); } \
    _Pragma("unroll") for(int r=0;r<16;++r)P0[r]=__builtin_amdgcn_exp2f(P0[r]); }while(0)
  #define RESC() do{ if(resc){ asm volatile("s_waitcnt lgkmcnt(0)":::"memory"); \
      _Pragma("unroll") for(int d_=0;d_<2;++d_) _Pragma("unroll") for(int r=0;r<16;++r)o[d_][r]*=wsf[crow(r,hi)]; } }while(0)
  f32x16 pA0,pA1,pB0,pB1;
  int sl_prev=0,sl_cur=0,sl_next=SLOTB;
  #define ROT() do{sl_prev=sl_cur;sl_cur=sl_next;sl_next=(sl_next==(NSLOT-1)*SLOTB)?0:sl_next+SLOTB;}while(0)
  DMA_K(2,2*SLOTB);
  WAIT_BAR(3);
  qkt(pA0,pA1,Kbase,qr,negm,r32,hi);KBIAS(pA0,pA1,0);asm volatile("s_nop 15\n\ts_nop 7":"+v"(pA0),"+v"(pA1));CMASK(pA0,pA1,0);
  START(pA0,pA1);
  _Pragma("unroll") for(int r=0;r<16;++r)pA1[r]=__builtin_amdgcn_exp2f(pA1[r]);
  WAIT_BAR(0);
  DMA_K(3,0);DMA_V(1,SLOTB);
  ROT();
  kload8(kf,kp0+sl_cur);
  WAIT_BAR(2);
  s16x4 vlo[8],vhi[8]; u32x4 pw0,pw1,pw2,pw3;
  #define PKW(P,B) cvtpk_s(P[B],P[B+1])
  #define PAF(k) __builtin_bit_cast(bf16x8,pw##k)
  #define VFR(i) (bf16x8){vlo[i][0],vlo[i][1],vlo[i][2],vlo[i][3],vhi[i][0],vhi[i][1],vhi[i][2],vhi[i][3]}
  #define PIN(x) asm volatile("":"+v"(x))
  #define MX3(a,b,c) __builtin_fmaxf(__builtin_fmaxf((a),(b)),(c))
  #define GAPA(MF,A0,A1,A2,A3,W0,W1,PW) do{ MF; sacc+=A0; sacc+=A1; sacc+=A2; sacc+=A3; PIN(sacc); W0; W1; PIN(PW); SBAR(); }while(0)
  #define EX(v) __builtin_amdgcn_exp2f(v)
  #define GAPB(MF,X,B) do{ MF; X[B]=EX(X[B]); X[B+1]=EX(X[B+1]); X[B+2]=EX(X[B+2]); X[B+3]=EX(X[B+3]); PIN(X); SBAR(); }while(0)
  #define VRD(i) do{ vlo[i]=vtr(vp_+(((i)>>2)*4096+((i)&3)*1024)); vhi[i]=vtr(vp_+(((i)>>2)*4096+((i)&3)*1024+512)); }while(0)
  #define KRD(G,j) do{ if(G){ kload2(kf,kp0+sl_next,j); SBAR(); } }while(0)
  #define STEP(C0,C1,P0,P1,t,GK,GV,GL) do{ SBAR(); \
    const lds_cptr vp_=vp0+sl_prev; \
    VRD(0); SBAR(); float sacc=(P0[0]+P0[1]); \
    GAPA(C0=__builtin_amdgcn_mfma_f32_32x32x16_bf16(kf[0],qr[0],negm,0,0,0), P0[2],P0[3],P0[4],P0[5],     pw0[0]=PKW(P0,0), pw0[1]=PKW(P0,2), pw0); \
    VRD(4); SBAR(); GAPA(C1=__builtin_amdgcn_mfma_f32_32x32x16_bf16(kf[1],qr[0],negm,0,0,0), P0[6],P0[7],P0[8],P0[9],     pw0[2]=PKW(P0,4), pw0[3]=PKW(P0,6), pw0); \
    VRD(1); SBAR(); GAPA(C0=__builtin_amdgcn_mfma_f32_32x32x16_bf16(kf[2],qr[1],C0,0,0,0),   P0[10],P0[11],P0[12],P0[13], pw1[0]=PKW(P0,8), pw1[1]=PKW(P0,10), pw1); \
    VRD(5); SBAR(); GAPA(C1=__builtin_amdgcn_mfma_f32_32x32x16_bf16(kf[3],qr[1],C1,0,0,0),   P0[14],P0[15],P1[0],P1[1],   pw1[2]=PKW(P0,12),pw1[3]=PKW(P0,14), pw1); \
    VRD(2); SBAR(); GAPA(C0=__builtin_amdgcn_mfma_f32_32x32x16_bf16(kf[4],qr[2],C0,0,0,0),   P1[2],P1[3],P1[4],P1[5],     pw2[0]=PKW(P1,0), pw2[1]=PKW(P1,2), pw2); \
    VRD(6); SBAR(); GAPA(C1=__builtin_amdgcn_mfma_f32_32x32x16_bf16(kf[5],qr[2],C1,0,0,0),   P1[6],P1[7],P1[8],P1[9],     pw2[2]=PKW(P1,4), pw2[3]=PKW(P1,6), pw2); \
    VRD(3); SBAR(); GAPA(C0=__builtin_amdgcn_mfma_f32_32x32x16_bf16(kf[6],qr[3],C0,0,0,0),   P1[10],P1[11],P1[12],P1[13], pw3[0]=PKW(P1,8), pw3[1]=PKW(P1,10), pw3); \
    VRD(7); SBAR(); GAPA(C1=__builtin_amdgcn_mfma_f32_32x32x16_bf16(kf[7],qr[3],C1,0,0,0),   P1[14],P1[15],0.f,0.f,       pw3[2]=PKW(P1,12),pw3[3]=PKW(P1,14), pw3); \
    l_reg+=sacc; \
    if(GK){DMA_K((t)+3,sl_cur);} if(GV){DMA_V((t)+1,sl_next);} \
    KBIAS(C0,C1,t); CMASK(C0,C1,t); \
    { float a=MX3(C0[0],C0[1],C1[0]),b=MX3(C0[2],C0[3],C1[1]); a=MX3(a,C1[2],C1[3]); \
      _Pragma("unroll") for(int r=4;r<16;r+=4){a=MX3(a,C0[r],C0[r+1]);b=MX3(b,C0[r+2],C0[r+3]);a=MX3(a,C1[r],C1[r+1]);b=MX3(b,C1[r+2],C1[r+3]);} \
      float rm=__builtin_fmaxf(a,b); { auto rr=__builtin_amdgcn_permlane32_swap(__float_as_uint(rm),__float_as_uint(rm),false,false); rm=__builtin_fmaxf(__uint_as_float(rr[0]),__uint_as_float(rr[1])); } \
      resc=false; \
      if(__builtin_expect(__any(rm>(float)THRL),0)){ const float dl=__builtin_fmaxf(rm,0.f); mhat+=dl; \
        _Pragma("unroll") for(int r=0;r<16;++r){C0[r]-=dl;C1[r]-=dl;} \
        _Pragma("unroll") for(int r=0;r<16;++r)negm[r]=-mhat; asm volatile("":"+v"(negm)); \
        const float f=__builtin_amdgcn_exp2f(-dl); l_reg*=f; if(hi==0)wsf[r32]=f; resc=true; } } \
    SBAR(); \
    GAPB(o[0]=__builtin_amdgcn_mfma_f32_32x32x16_bf16(PAF(0),VFR(0),o[0],0,0,0), C0,0); \
    GAPB(o[1]=__builtin_amdgcn_mfma_f32_32x32x16_bf16(PAF(0),VFR(4),o[1],0,0,0), C0,4); \
    KRD(GL,0); GAPB(o[0]=__builtin_amdgcn_mfma_f32_32x32x16_bf16(PAF(1),VFR(1),o[0],0,0,0), C0,8); \
    KRD(GL,1); GAPB(o[1]=__builtin_amdgcn_mfma_f32_32x32x16_bf16(PAF(1),VFR(5),o[1],0,0,0), C0,12); \
    KRD(GL,2); GAPB(o[0]=__builtin_amdgcn_mfma_f32_32x32x16_bf16(PAF(2),VFR(2),o[0],0,0,0), C1,0); \
    KRD(GL,3); GAPB(o[1]=__builtin_amdgcn_mfma_f32_32x32x16_bf16(PAF(2),VFR(6),o[1],0,0,0), C1,4); \
    GAPB(o[0]=__builtin_amdgcn_mfma_f32_32x32x16_bf16(PAF(3),VFR(3),o[0],0,0,0), C1,8); \
    GAPB(o[1]=__builtin_amdgcn_mfma_f32_32x32x16_bf16(PAF(3),VFR(7),o[1],0,0,0), C1,12); \
    }while(0)
  int t=1;
  #undef CMASK
  #define CMASK(P0,P1,t) do{}while(0)
  for(;t+5<NT;t+=2){
    STEP(pB0,pB1,pA0,pA1,t,true,true,true);     WAIT_BAR(2); RESC(); ROT();
    STEP(pA0,pA1,pB0,pB1,t+1,true,true,true);   WAIT_BAR(2); RESC(); ROT();
  }
  #undef CMASK
  #define CMASK(P0,P1,t) do{int jb_=(t)-(NT-4); if(jb_>=0)cmask(P0,P1,jb_,qrel,hi);}while(0)
  #define ENDW(tt) do{ if((tt)+3<NT){WAIT_BAR(2);} else if((tt)+2<NT){WAIT_BAR(1);} else {WAIT_BAR(0);} }while(0)
  for(;t+1<NT;t+=2){
    STEP(pB0,pB1,pA0,pA1,t,(t+3<NT),(t+1<NT),(t+1<NT));       ENDW(t);   RESC(); ROT();
    STEP(pA0,pA1,pB0,pB1,t+1,(t+4<NT),(t+2<NT),(t+2<NT));     ENDW(t+1); RESC(); ROT();
  }
  STEP(pB0,pB1,pA0,pA1,NT-1,false,false,false); RESC();
  { float sacc=pB0[0]+pB0[1]; _Pragma("unroll") for(int r=2;r<16;++r)sacc+=pB0[r]; _Pragma("unroll") for(int r=0;r<16;++r)sacc+=pB1[r]; l_reg+=sacc;
    pw0=(u32x4){PKW(pB0,0),PKW(pB0,2),PKW(pB0,4),PKW(pB0,6)};pw1=(u32x4){PKW(pB0,8),PKW(pB0,10),PKW(pB0,12),PKW(pB0,14)};pw2=(u32x4){PKW(pB1,0),PKW(pB1,2),PKW(pB1,4),PKW(pB1,6)};pw3=(u32x4){PKW(pB1,8),PKW(pB1,10),PKW(pB1,12),PKW(pB1,14)};
    SBAR(); pv(o,vb0+sl_cur,PAF(0),PAF(1),PAF(2),PAF(3)); }
  #undef PKW
  #undef PAF
  #undef VFR
  #undef PIN
  #undef MX3
  #undef GAPA
  #undef GAPB
  #undef EX
  #undef VRD
  #undef KRD
  #undef STEP
  #undef ENDW
  {auto rr=__builtin_amdgcn_permlane32_swap(__float_as_uint(l_reg),__float_as_uint(l_reg),false,false);l_reg=__uint_as_float(rr[0])+__uint_as_float(rr[1]);}
  if(hi==0)wsf[32+r32]=l_reg;asm volatile("s_waitcnt lgkmcnt(0)":::"memory");
  float rli[16];
  #pragma unroll
  for(int r=0;r<16;++r)rli[r]=__builtin_amdgcn_rcpf(wsf[32+crow(r,hi)]);
  bf16*Ow=O+(rowbase+q0+wid*QBLK)*PO+h*D;
  { bf16*stg=(bf16*)(shm+LDS_OST)+wid*2048;
    #pragma unroll
    for(int r=0;r<16;++r){const int orow=crow(r,hi);
      #pragma unroll
      for(int d0=0;d0<2;++d0)stg[orow*64+d0*32+r32]=__float2bfloat16(o[d0][r]*rli[r]);}
    asm volatile("s_waitcnt lgkmcnt(0)":::"memory");
    #pragma unroll
    for(int i=0;i<4;++i){const int row=i*8+(lane>>3),ch=lane&7; const u32x4 v=*(const u32x4*)(stg+row*64+ch*8); ATTN_STORE16(Ow+(long)row*PO+ch*8,v);} }
  asm volatile("s_waitcnt lgkmcnt(0)\n\ts_barrier":::"memory");
  #undef KBIAS
  #undef DMA_K
  #undef DMA_V
  #undef CMASK
  #undef START
  #undef RESC
  #undef ROT
}
constexpr int ATTN_LDS_BYTES=LDS_BYTES;
#undef SBAR
#undef WAIT_BAR
}
#define LAS __attribute__((address_space(3)))
typedef unsigned short bf16;
typedef unsigned u32x4 __attribute__((ext_vector_type(4)));
typedef unsigned u32x2 __attribute__((ext_vector_type(2)));
typedef float f32x4 __attribute__((ext_vector_type(4)));
typedef float f32x2 __attribute__((ext_vector_type(2)));
typedef float f32x16 __attribute__((ext_vector_type(16)));
typedef short bf16x8 __attribute__((ext_vector_type(8)));
#define RLX_AGENT __ATOMIC_RELAXED, __HIP_MEMORY_SCOPE_AGENT
constexpr int NWAVES = 8, NTHR = 512;
constexpr int LDS_BYTES = 147456, MISC_OFF = 131072 + 8192;
constexpr float LOG2E = 1.4426950408889634f;
__device__ __forceinline__ unsigned pk2(float lo, float hi) { return pg8::cvt_pk_bf16(lo, hi); }
__device__ __forceinline__ float bf2f(unsigned u16) { return __uint_as_float(u16 << 16); }
__device__ __forceinline__ int crow(int r, int hi) { return (r & 3) + 8 * (r >> 2) + 4 * hi; }
__device__ __forceinline__ float wave_sum(float v) {
#pragma unroll
    for (int o = 1; o < 64; o <<= 1) v += __shfl_xor(v, o);
    return v;
}
__device__ __forceinline__ void sincos_cw(float x, float& s, float& c) {
    const float k = rintf(x * 0.636619772367581343f);
    float r = fmaf(k, -1.5703125f, x); r = fmaf(k, -4.837512969970703125e-4f, r); r = fmaf(k, -7.54978995489188216e-8f, r);
    const float z = r * r;
    const float sp = r + r * z * (-1.6666654611e-1f + z * (8.3321608736e-3f + z * -1.9515295891e-4f));
    const float cp = 1.0f - 0.5f * z + z * z * (4.166664568298827e-2f + z * (-1.388731625493765e-3f + z * 2.443315711809948e-5f));
    const int q = ((int)k) & 3;
    s = (q == 0) ? sp : (q == 1) ? cp : (q == 2) ? -sp : -cp;
    c = (q == 0) ? cp : (q == 1) ? -sp : (q == 2) ? -cp : sp;
}
__device__ __forceinline__ float block_scan(float v, float& tot, LAS float* scr, int lane, int wid) {
#pragma unroll
    for (int o = 1; o < 64; o <<= 1) { const float n = __shfl_up(v, o); if (lane >= o) v += n; }
    if (lane == 63) scr[wid] = v;
    __syncthreads();
    float off = 0.f; tot = 0.f;
#pragma unroll
    for (int w = 0; w < NWAVES; ++w) { const float x = scr[w]; if (w < wid) off += x; tot += x; }
    __syncthreads();
    return v + off;
}

template <int MODE> __device__ __forceinline__ int rowmap(int n) {
    if (MODE == 1) return n < 1024 ? ((n & ~127) | ((n & 63) << 1) | ((n >> 6) & 1)) : n;
    if (MODE == 2) return 2 * n;
    if (MODE == 3) return 2 * n + 1;
    return n;
}
template <int MODE> __device__ __forceinline__ void p0_transpose_item(const float* W, int ldw, int K, int N, const float* ks, bf16* WT, LAS float* scr, int item, int lane) {
    const int nblk = N / 32, kb = item / nblk, nb = item % nblk, k0 = 64 * kb, n0 = 32 * nb;
#pragma unroll
    for (int i = 0; i < 32; ++i) { const int kk = 2 * i + (lane >> 5); float w = W[(size_t)(k0 + kk) * ldw + n0 + (lane & 31)]; if (ks) w *= ks[k0 + kk]; scr[kk * 33 + (lane & 31)] = w; }
    asm volatile("s_waitcnt lgkmcnt(0)" ::: "memory");
    const int c = lane & 7;
#pragma unroll
    for (int j = 0; j < 4; ++j) { const int n = (lane >> 3) + 8 * j; const LAS float* s = scr + (8 * c) * 33 + n;
        u32x4 o; o.x = pk2(s[0 * 33], s[1 * 33]); o.y = pk2(s[2 * 33], s[3 * 33]); o.z = pk2(s[4 * 33], s[5 * 33]); o.w = pk2(s[6 * 33], s[7 * 33]);
        *(u32x4*)(WT + (size_t)rowmap<MODE>(n0 + n) * K + k0 + 8 * c) = o; }
    asm volatile("s_waitcnt lgkmcnt(0)" ::: "memory");
}
__device__ __forceinline__ void p0_prep(const Params& p, LAS unsigned char* lds, int vcu, int G) {
    const int tid = tid_fresh(), lane = tid & 63, wid = __builtin_amdgcn_readfirstlane(tid >> 6);
    unsigned char* ws = p.ws;
    for (int i = blockIdx.x * NTHR + tid; i < (int)(CTL_BYTES / 4); i += G * NTHR) if (i < 4096 || i >= 4096 + 3456) ((unsigned*)(ws + WS_CTL))[i] = 0u;
    { float* cs = (float*)(ws + WS_CS);
      for (int i = blockIdx.x * NTHR + tid; i < (TSEQ + NSMP) * 64; i += G * NTHR) { const int tix = i >> 6, d = i & 63; const float pos = (float)(tix < TSEQ ? tix : PAST + tix - TSEQ);
          const float inv = exp2f((float)d * (-13.287712379549449f / 64.0f)); float s, c; sincos_cw(pos * inv, s, c); cs[2 * i] = c; cs[2 * i + 1] = s; } }
    LAS float* scr = (LAS float*)(lds + wid * 16384);
    const int gw = vcu * NWAVES + wid, NGW = G * NWAVES;
    constexpr int I_IN = (DM / 64) * (NZ / 32), I_O = (DM / 64) * (DM / 32), I_G = (DM / 64) * (DFF / 32), I_D = (DFF / 64) * (DM / 32);
#ifndef REP_P0T
#define REP_P0T 1
#endif
    for (int rept = 0; rept < REP_P0T; ++rept)
    for (int it = gw; it < I_IN + I_O + 2 * I_G + I_D; it += NGW) {
        int r = it;
        if (r < I_IN) { p0_transpose_item<1>(p.win, DIN, DM, NZ, nullptr, (bf16*)(ws + WS_WIN), scr, r, lane); continue; } r -= I_IN;
        if (r < I_O) { p0_transpose_item<0>(p.wout, DM, DM, DM, nullptr, (bf16*)(ws + WS_WO), scr, r, lane); continue; } r -= I_O;
        if (r < I_G) { p0_transpose_item<2>(p.wg, DFF, DM, DFF, p.gffn, (bf16*)(ws + WS_WGU), scr, r, lane); continue; } r -= I_G;
        if (r < I_G) { p0_transpose_item<3>(p.wu, DFF, DM, DFF, p.gffn, (bf16*)(ws + WS_WGU), scr, r, lane); continue; } r -= I_G;
        p0_transpose_item<0>(p.wd, DM, DFF, DM, nullptr, (bf16*)(ws + WS_WD), scr, r, lane);
    }
    __syncthreads();
    LAS f32x4* wl = (LAS f32x4*)lds;
    for (int i = tid; i < 2048; i += NTHR) { const int ln = i & 63, q = i >> 6, half = q & 1, e = (q >> 1) & 3, j = q >> 3;
        wl[i] = *(const f32x4*)(p.win + (size_t)(4 * ln + 256 * j + e) * DIN + NZ + 4 * half); }
    __syncthreads();
    f32x4 gm[4];
#pragma unroll
    for (int j = 0; j < 4; ++j) gm[j] = *(const f32x4*)(p.gmix + 4 * lane + 256 * j);
    bf16* XN = (bf16*)(ws + WS_XN);
    constexpr int NQUAD = MTOK / 4;
#ifndef REP_P0R
#define REP_P0R 1
#endif
    for (int repr_ = 0; repr_ < REP_P0R; ++repr_)
    for (int qd = gw; qd < NQUAD; qd += NGW) {
        const int m0 = 4 * qd; const float* xr = (m0 < MP) ? p.xp + (size_t)m0 * DM : p.xs + (size_t)(m0 - MP) * DM;
        f32x4 v[4][4];
#pragma unroll
        for (int rr = 0; rr < 4; ++rr)
#pragma unroll
            for (int j = 0; j < 4; ++j) v[rr][j] = *(const f32x4*)(xr + (size_t)rr * DM + 4 * lane + 256 * j);
        asm volatile("" ::: "memory");
        float ss[4]; f32x4 a0[4], a1[4];
#pragma unroll
        for (int rr = 0; rr < 4; ++rr) { ss[rr] = 0.f; a0[rr] = (f32x4){0.f, 0.f, 0.f, 0.f}; a1[rr] = a0[rr]; }
#pragma unroll
        for (int j = 0; j < 4; ++j) {
#pragma unroll
            for (int rr = 0; rr < 4; ++rr) { ss[rr] += (v[rr][j][0] * v[rr][j][0] + v[rr][j][1] * v[rr][j][1]) + (v[rr][j][2] * v[rr][j][2] + v[rr][j][3] * v[rr][j][3]); v[rr][j] = v[rr][j] * gm[j]; }
#pragma unroll
            for (int e = 0; e < 4; ++e) { const f32x4 w0 = wl[((j * 4 + e) * 2) * 64 + lane], w1 = wl[((j * 4 + e) * 2 + 1) * 64 + lane];
#pragma unroll
                for (int rr = 0; rr < 4; ++rr) { a0[rr] += w0 * v[rr][j][e]; a1[rr] += w1 * v[rr][j][e]; } } }
        const int b5 = lane >> 5, b4 = (lane >> 4) & 1, b3 = (lane >> 3) & 1;
#pragma unroll
        for (int rr = 0; rr < 4; ++rr) {
            const float r = 1.0f / sqrtf(wave_sum(ss[rr]) * (1.0f / DM) + 1e-6f);
            float t4[4], t2[2];
#pragma unroll
            for (int i = 0; i < 4; ++i) { const float mine = b5 ? a1[rr][i] : a0[rr][i], send = b5 ? a0[rr][i] : a1[rr][i]; t4[i] = mine + __shfl_xor(send, 32); }
#pragma unroll
            for (int i = 0; i < 2; ++i) { const float mine = b4 ? t4[2 + i] : t4[i], send = b4 ? t4[i] : t4[2 + i]; t2[i] = mine + __shfl_xor(send, 16); }
            float t1; { const float mine = b3 ? t2[1] : t2[0], send = b3 ? t2[0] : t2[1]; t1 = mine + __shfl_xor(send, 8); }
            t1 += __shfl_xor(t1, 4); t1 += __shfl_xor(t1, 2); t1 += __shfl_xor(t1, 1);
            const int m = m0 + rr;
#pragma unroll
            for (int j = 0; j < 4; ++j) { u32x2 w; const f32x4 xa = v[rr][j] * r; w.x = pk2(xa[0], xa[1]); w.y = pk2(xa[2], xa[3]); *(u32x2*)(XN + (size_t)m * DM + 4 * lane + 256 * j) = w; }
            if ((lane & 7) == 0) { const int idx = lane >> 3; const float t = t1 * r + p.bfg[idx]; const float lf = fminf(t, 0.f) - log1pf(expf(-fabsf(t)));
                float* o = (m < MP) ? p.out + O_LFP + (size_t)m * 8 : p.out + O_LFS + (size_t)(m - MP) * 8; o[idx] = lf; }
        }
    }
}
__device__ __forceinline__ void p1_cumsum(const Params& p, LAS unsigned char* lds) {
    const int tid = tid_fresh(), lane = tid & 63, wid = __builtin_amdgcn_readfirstlane(tid >> 6);
    const int bh = blockIdx.x; if (bh >= NB * 8) return;
    const int b = bh >> 3, h = bh & 7; const float* lf = p.out + O_LFP + (size_t)b * TSEQ * 8 + h;
    float c[4]; float run = 0.f;
#pragma unroll
    for (int e = 0; e < 4; ++e) { run += lf[(size_t)(4 * tid + e) * 8]; c[e] = run; }
    float tot; const float inc = block_scan(run, tot, (LAS float*)lds, lane, wid); const float exc = inc - run;
    float* cb = (float*)(p.ws + WS_CB) + (size_t)bh * TSEQ + 4 * tid;
    *(f32x4*)cb = (f32x4){exc + c[0], exc + c[1], exc + c[2], exc + c[3]};
}
__device__ __forceinline__ void p6_final(const Params& p, int vcu, int G) {
    const int tid = tid_fresh(), lane = tid & 63, wid = __builtin_amdgcn_readfirstlane(tid >> 6);
    f32x4 gf[4];
#pragma unroll
    for (int j = 0; j < 4; ++j) gf[j] = *(const f32x4*)(p.gfin + 4 * lane + 256 * j);
    for (int m = 2 * (vcu * NWAVES + wid); m < MTOK; m += 2 * G * NWAVES) { float* y = p.out + O_Y + (size_t)m * DM + 4 * lane;
        f32x4 v[2][4]; float s0 = 0.f, s1 = 0.f;
#pragma unroll
        for (int j = 0; j < 4; ++j) { v[0][j] = *(const f32x4*)(y + 256 * j); v[1][j] = *(const f32x4*)(y + DM + 256 * j); }
#pragma unroll
        for (int j = 0; j < 4; ++j) { s0 += (v[0][j][0] * v[0][j][0] + v[0][j][1] * v[0][j][1]) + (v[0][j][2] * v[0][j][2] + v[0][j][3] * v[0][j][3]);
            s1 += (v[1][j][0] * v[1][j][0] + v[1][j][1] * v[1][j][1]) + (v[1][j][2] * v[1][j][2] + v[1][j][3] * v[1][j][3]); }
        const float r0 = 1.0f / sqrtf(wave_sum(s0) * (1.0f / DM) + 1e-6f), r1 = 1.0f / sqrtf(wave_sum(s1) * (1.0f / DM) + 1e-6f);
#pragma unroll
        for (int j = 0; j < 4; ++j) { *(f32x4*)(y + 256 * j) = v[0][j] * r0 * gf[j]; *(f32x4*)(y + DM + 256 * j) = v[1][j] * r1 * gf[j]; } }
}
#define XB_TMO      128
#define XB_XCNT(j)  (256  + 64 * (j))
#define XB_XSUB(j)  (1280 + 64 * (j))
#define XB_XGEN(j)  (2304 + 64 * (j))
#define XB_TOP      3328
#define XB_TOPGEN   3392
#define XCD_BAR_WORDS 3456
#define XB_SPIN_CAP (1u << 18)

__device__ __forceinline__ unsigned xb_ld(unsigned* p)              { return __hip_atomic_load(p, __ATOMIC_RELAXED, __HIP_MEMORY_SCOPE_AGENT); }
__device__ __forceinline__ unsigned xb_add(unsigned* p, unsigned v) { return __hip_atomic_fetch_add(p, v, __ATOMIC_RELAXED, __HIP_MEMORY_SCOPE_AGENT); }
__device__ __forceinline__ unsigned xb_xcc_id() { return (unsigned)__builtin_amdgcn_s_getreg((3 << 11) | 20) & 0xFu; }
#define XB_SPIN(cond, bar) do { unsigned _sp = 0; while (cond) { __builtin_amdgcn_s_sleep(1); \
    if ((++_sp & 255u) == 0u) { if (xb_ld(&(bar)[XB_TMO])) break; if (_sp > XB_SPIN_CAP) { atomicAdd(&(bar)[XB_TMO], 1u); break; } } } } while (0)

struct XcdBarrier {
    unsigned* bar; unsigned x;
    volatile LAS unsigned* st;
};

__device__ __forceinline__ XcdBarrier xcd_barrier_post(unsigned* bar, volatile LAS unsigned* st) {
    XcdBarrier b; b.bar = bar; b.x = xb_xcc_id(); b.st = st;
    if (threadIdx.x == 0) (void)xb_add(&bar[XB_XCNT(b.x)], 1u);
    return b;
}
__device__ __forceinline__ void xcd_barrier_complete(unsigned* bar, unsigned x, unsigned& nloc, unsigned& nx) {
    const unsigned G = gridDim.x * gridDim.y * gridDim.z;
    unsigned sum, cnt, mine, sp = 0u;
    for (;;) {
        sum = 0u; cnt = 0u; mine = 0u;
#pragma unroll
        for (unsigned j = 0; j < 16; ++j) { const unsigned c = xb_ld(&bar[XB_XCNT(j)]); sum += c; cnt += (c > 0u) ? 1u : 0u; mine = (j == x) ? c : mine; }
        if (sum == G) break;
        __builtin_amdgcn_s_sleep(1);
        if ((++sp & 255u) == 0u) { if (xb_ld(&bar[XB_TMO])) break; if (sp > XB_SPIN_CAP) { atomicAdd(&bar[XB_TMO], 1u); break; } }
    }
    nloc = mine > 0u ? mine : 1u; nx = cnt > 0u ? cnt : 1u;
}

__device__ __forceinline__ void xcd_barrier(const XcdBarrier& b) {
    asm volatile("s_waitcnt vmcnt(0)" ::: "memory");
    __syncthreads();
    if (threadIdx.x == 0) {
        unsigned* bar = b.bar;
        __builtin_amdgcn_s_waitcnt(0);
        unsigned nloc = b.st[0], nx = b.st[1];
        if (nloc == 0u) { xcd_barrier_complete(bar, b.x, nloc, nx); b.st[0] = nloc; b.st[1] = nx; }
        const unsigned old = xb_add(&bar[XB_XSUB(b.x)], 1u);
        const unsigned gen = old / nloc;
        if (old + 1u == (gen + 1u) * nloc) {
            __builtin_amdgcn_fence(__ATOMIC_RELEASE, "agent");
            asm volatile("s_waitcnt vmcnt(0)" ::: "memory");
            const unsigned og = xb_add(&bar[XB_TOP], 1u);
            const unsigned tg = og / nx;
            if (og + 1u == (tg + 1u) * nx) xb_add(&bar[XB_TOPGEN], 1u);
            else XB_SPIN(xb_ld(&bar[XB_TOPGEN]) == tg, bar);
            __builtin_amdgcn_fence(__ATOMIC_ACQUIRE, "agent");
            xb_add(&bar[XB_XGEN(b.x)], 1u);
            asm volatile("s_waitcnt vmcnt(0)" ::: "memory");
        } else {
            XB_SPIN(xb_ld(&bar[XB_XGEN(b.x)]) == gen, bar);
            __builtin_amdgcn_fence(__ATOMIC_ACQUIRE, "agent");
            asm volatile("s_waitcnt vmcnt(0)" ::: "memory");
        }
    }
    __syncthreads();
}
#ifndef RJ_SKIP
#define RJ_SKIP 0
#endif
#define MFMA32(a, b, c) __builtin_amdgcn_mfma_f32_32x32x16_bf16((a), (b), (c), 0, 0, 0)
__device__ __forceinline__ void ret_job(LAS unsigned char* lds, const Params& p_, const bool sample, const int b, const int h) {
    const Params p = fresh_params(p_);
    const int tid = tid_fresh(), lane = tid & 63, wid = __builtin_amdgcn_readfirstlane(tid >> 6), r32 = lane & 31, hi = lane >> 5;
    constexpr int PQK = 272, PT = 144;
    LAS unsigned char* Qr = lds; LAS unsigned char* Kr = lds + 17408; LAS unsigned char* Kdt = lds + 34816; LAS unsigned char* Vt = lds + 53248;
    LAS unsigned char* St = lds + 71680; LAS unsigned char* Am = lds + 106496; LAS f32x2* stats = (LAS f32x2*)(lds + 115712);
    const float lg2 = h == 0 ? -0.045803689613124746f : h == 1 ? -0.022720076500083907f : h == 2 ? -0.011315313227834146f : -0.005646563141142062f;
    const float cdec = __builtin_amdgcn_exp2f(lg2 * 64.0f);
    const int nch = sample ? 1 : TSEQ / 64; const size_t row0 = sample ? (size_t)MP + b * NSMP : (size_t)b * TSEQ;
    const bf16* Z = (const bf16*)(p.ws + WS_Z); bf16* MIX = (bf16*)(p.ws + WS_MIX);
    const int dkb = wid & 3, dvh = wid >> 2;
    f32x16 S0, S1;
    if (sample) { const float* sp = p.sr + (size_t)(b * 4 + h) * 16384 + 64 * dvh + r32;
#pragma unroll
        for (int r = 0; r < 16; ++r) { const int dk = 32 * dkb + crow(r, hi); S0[r] = sp[dk * 128]; S1[r] = sp[dk * 128 + 32]; } }
    else {
#pragma unroll
        for (int r = 0; r < 16; ++r) { S0[r] = 0.f; S1[r] = 0.f; } }
    u32x4 pq0, pq1, pk0, pk1, pv0, pv1; u32x2 pg[4];
#define RJ_LOAD(c_) do { const bf16* zr = Z + (row0 + (size_t)(c_) * 64 + 2 * (tid & 31)) * NZ + h * 128 + (tid >> 5) * 8; \
        pq0 = *(const u32x4*)zr; pq1 = *(const u32x4*)(zr + NZ); pk0 = *(const u32x4*)(zr + 512); pk1 = *(const u32x4*)(zr + NZ + 512); pv0 = *(const u32x4*)(zr + 1024); pv1 = *(const u32x4*)(zr + NZ + 1024); } while (0)
    RJ_LOAD(0);
    f32x4 gnv[4];
#pragma unroll
    for (int g = 0; g < 4; ++g) gnv[g] = *(const f32x4*)(p.gn + h * 128 + 32 * (wid >> 1) + 8 * g + 4 * hi);
    for (int c = 0; c < nch; ++c) {
        const size_t r0 = row0 + (size_t)c * 64;
#if !(RJ_SKIP & 1)
        { const int jp = tid & 31, ch = tid >> 5;
            *(LAS u32x4*)(Qr + (2 * jp) * PQK + ch * 16) = pq0; *(LAS u32x4*)(Qr + (2 * jp + 1) * PQK + ch * 16) = pq1;
            *(LAS u32x4*)(Kr + (2 * jp) * PQK + ch * 16) = pk0; *(LAS u32x4*)(Kr + (2 * jp + 1) * PQK + ch * 16) = pk1;
            const float kd0 = __builtin_amdgcn_exp2f(lg2 * (float)(63 - 2 * jp)), kd1 = __builtin_amdgcn_exp2f(lg2 * (float)(62 - 2 * jp));
#pragma unroll
            for (int e = 0; e < 8; ++e) { const unsigned a0 = pk0[e >> 1], a1 = pk1[e >> 1], b0 = pv0[e >> 1], b1 = pv1[e >> 1];
                const float f0 = (e & 1) ? __uint_as_float(a0 & 0xffff0000u) : __uint_as_float(a0 << 16), f1 = (e & 1) ? __uint_as_float(a1 & 0xffff0000u) : __uint_as_float(a1 << 16);
                *(LAS unsigned*)(Kdt + (ch * 8 + e) * PT + jp * 4) = pk2(f0 * kd0, f1 * kd1);
                *(LAS unsigned*)(Vt + (ch * 8 + e) * PT + jp * 4) = (e & 1) ? ((b0 >> 16) | (b1 & 0xffff0000u)) : ((b0 & 0xffffu) | (b1 << 16)); } }
#pragma unroll
        for (int g = 0; g < 4; ++g) { const int dk0 = 32 * dkb + 8 * g + 4 * hi;
            u32x2 w0, w1; w0.x = pk2(S0[4 * g], S0[4 * g + 1]); w0.y = pk2(S0[4 * g + 2], S0[4 * g + 3]); w1.x = pk2(S1[4 * g], S1[4 * g + 1]); w1.y = pk2(S1[4 * g + 2], S1[4 * g + 3]);
            *(LAS u32x2*)(St + (64 * dvh + r32) * PQK + dk0 * 2) = w0; *(LAS u32x2*)(St + (64 * dvh + 32 + r32) * PQK + dk0 * 2) = w1; }
        if (c + 1 < nch) RJ_LOAD(c + 1);
        { const bf16* grow = Z + (r0 + 32 * (wid & 1) + r32) * NZ + 1536 + h * 128 + 32 * (wid >> 1) + 4 * hi;
#pragma unroll
          for (int g = 0; g < 4; ++g) pg[g] = *(const u32x2*)(grow + 8 * g); }
#endif
        __syncthreads();
#if !(RJ_SKIP & 2)
        if (wid < 4) { const int jb = wid >> 1, ib = wid & 1; f32x16 a;
#pragma unroll
            for (int r = 0; r < 16; ++r) a[r] = 0.f;
#pragma unroll 2
            for (int ks = 0; ks < 8; ++ks) { const bf16x8 kf = *(const LAS bf16x8*)(Kr + (32 * jb + r32) * PQK + (16 * ks + 8 * hi) * 2), qf = *(const LAS bf16x8*)(Qr + (32 * ib + r32) * PQK + (16 * ks + 8 * hi) * 2);
                a = MFMA32(kf, qf, a); }
            const int i = 32 * ib + r32;
#pragma unroll
            for (int g = 0; g < 4; ++g) { const int j0 = 32 * jb + 8 * g + 4 * hi; float t[4];
#pragma unroll
                for (int e = 0; e < 4; ++e) t[e] = a[4 * g + e] * __builtin_amdgcn_exp2f(lg2 * fabsf((float)(i - (j0 + e))));
                u32x2 w; w.x = pk2(t[0], t[1]); w.y = pk2(t[2], t[3]); *(LAS u32x2*)(Am + i * PT + j0 * 2) = w; } }
#endif
        __syncthreads();
#if !(RJ_SKIP & 4)
        { const int dvb = wid >> 1, ib = wid & 1; f32x16 oi, ox;
#pragma unroll
            for (int r = 0; r < 16; ++r) { oi[r] = 0.f; ox[r] = 0.f; }
#pragma unroll
            for (int ks = 0; ks < 4; ++ks) { const bf16x8 vf = *(const LAS bf16x8*)(Vt + (32 * dvb + r32) * PT + (16 * ks + 8 * hi) * 2), af = *(const LAS bf16x8*)(Am + (32 * ib + r32) * PT + (16 * ks + 8 * hi) * 2);
                oi = MFMA32(vf, af, oi); }
#pragma unroll 2
            for (int ks = 0; ks < 8; ++ks) { const bf16x8 sf = *(const LAS bf16x8*)(St + (32 * dvb + r32) * PQK + (16 * ks + 8 * hi) * 2), qf = *(const LAS bf16x8*)(Qr + (32 * ib + r32) * PQK + (16 * ks + 8 * hi) * 2);
                ox = MFMA32(sf, qf, ox); }
            const int i = 32 * ib + r32; const float qd = __builtin_amdgcn_exp2f(lg2 * (float)(i + 1)); float s1 = 0.f, s2 = 0.f;
#pragma unroll
            for (int r = 0; r < 16; ++r) { oi[r] += ox[r] * qd; s1 += oi[r]; s2 += oi[r] * oi[r]; }
            s1 += __shfl_xor(s1, 32); s2 += __shfl_xor(s2, 32);
            if (hi == 0) stats[i * 4 + dvb] = (f32x2){s1, s2};
            __syncthreads();
            float m1 = 0.f, m2 = 0.f;
#pragma unroll
            for (int t = 0; t < 4; ++t) { const f32x2 st = stats[i * 4 + t]; m1 += st.x; m2 += st.y; }
            const float mu = m1 * (1.0f / 128.0f), var = fmaxf(m2 * (1.0f / 128.0f) - mu * mu, 0.f), rstd = 1.0f / sqrtf(var + 1e-5f);
            bf16* mrow = MIX + (r0 + i) * DM + h * 128;
#pragma unroll
            for (int g = 0; g < 4; ++g) { const int dv0 = 32 * dvb + 8 * g + 4 * hi; const u32x2 gw = pg[g]; const f32x4 gn = gnv[g];
                const float g0 = bf2f(gw.x & 0xffffu), g1 = bf2f(gw.x >> 16), g2 = bf2f(gw.y & 0xffffu), g3 = bf2f(gw.y >> 16);
                const float y0 = (oi[4 * g] - mu) * rstd * gn[0] * pg8::silu_f(g0), y1 = (oi[4 * g + 1] - mu) * rstd * gn[1] * pg8::silu_f(g1);
                const float y2 = (oi[4 * g + 2] - mu) * rstd * gn[2] * pg8::silu_f(g2), y3 = (oi[4 * g + 3] - mu) * rstd * gn[3] * pg8::silu_f(g3);
                u32x2 w; w.x = pk2(y0, y1); w.y = pk2(y2, y3); *(u32x2*)(mrow + dv0) = w; } }
#endif
#if !(RJ_SKIP & 8)
#pragma unroll
        for (int r = 0; r < 16; ++r) { S0[r] *= cdec; S1[r] *= cdec; }
#pragma unroll
        for (int ks = 0; ks < 4; ++ks) { const bf16x8 kdf = *(const LAS bf16x8*)(Kdt + (32 * dkb + r32) * PT + (16 * ks + 8 * hi) * 2);
            const bf16x8 v0 = *(const LAS bf16x8*)(Vt + (64 * dvh + r32) * PT + (16 * ks + 8 * hi) * 2), v1 = *(const LAS bf16x8*)(Vt + (64 * dvh + 32 + r32) * PT + (16 * ks + 8 * hi) * 2);
            S0 = MFMA32(kdf, v0, S0); S1 = MFMA32(kdf, v1, S1); }
#endif
        __syncthreads();
    }
#undef RJ_LOAD
    { float* so = p.out + (sample ? O_SRS : O_SRP) + (size_t)(b * 4 + h) * 16384 + 64 * dvh + r32;
#pragma unroll
        for (int r = 0; r < 16; ++r) { const int dk = 32 * dkb + crow(r, hi); so[dk * 128] = S0[r]; so[dk * 128 + 32] = S1[r]; } }
}

constexpr size_t WS_PART = WS_END + 6 * MiB;
constexpr int PART_STRIDE = 4224;
__device__ __forceinline__ void fs_chunk_job(LAS unsigned char* lds, const Params& p_, const int b, const int c) {
    const Params p = fresh_params(p_);
    const int tid = tid_fresh(), lane = tid & 63, wid = __builtin_amdgcn_readfirstlane(tid >> 6), r32 = lane & 31, hi = lane >> 5;
    const int h = wid;
    LAS float* ab = (LAS float*)(lds + wid * 1280);
    LAS float* red = (LAS float*)(lds + 10240);
    LAS unsigned char* vtw = lds + 12288 + wid * 5120;
    { const float* clf = p.clf + (size_t)b * PAST * 8; float acc = 0.f;
      for (int j = 256 * (c + 1) + (tid >> 3); j < PAST; j += 64) acc += clf[(size_t)j * 8 + (tid & 7)];
      acc += __shfl_xor(acc, 8); acc += __shfl_xor(acc, 16); acc += __shfl_xor(acc, 32);
      if (lane < 8) red[wid * 8 + lane] = acc;
      __syncthreads();
      float Sh = 0.f;
#pragma unroll
      for (int w = 0; w < NWAVES; ++w) Sh += red[w * 8 + h];
      float v[4]; float tt = 0.f;
#pragma unroll
      for (int e = 0; e < 4; ++e) { v[e] = clf[(size_t)(256 * c + 4 * lane + e) * 8 + h]; tt += v[e]; }
      float inc = tt;
#pragma unroll
      for (int o = 1; o < 64; o <<= 1) { const float n = __shfl_up(inc, o); if (lane >= o) inc += n; }
      const float tot = __shfl(inc, 63); float suf = Sh + (tot - inc);
#pragma unroll
      for (int e = 3; e >= 0; --e) { ab[4 * lane + e] = suf * LOG2E; suf += v[e]; }
      if (c == 15) { float x = p.out[O_LFS + (size_t)(b * NSMP + lane) * 8 + h];
#pragma unroll
          for (int o = 1; o < 64; o <<= 1) { const float n = __shfl_up(x, o); if (lane >= o) x += n; }
          ab[256 + lane] = -x * LOG2E; } }
    const bf16* Zq = (const bf16*)(p.ws + WS_Z) + ((size_t)MP + b * NSMP) * NZ + 2048 + h * 64;
    bf16x8 qr[2][4];
#pragma unroll
    for (int qb = 0; qb < 2; ++qb)
#pragma unroll
        for (int d0 = 0; d0 < 4; ++d0) qr[qb][d0] = *(const bf16x8*)(Zq + (size_t)(32 * qb + r32) * NZ + 16 * d0 + 8 * hi);
    f32x16 o[2][2]; float mrun[2] = {-1e30f, -1e30f}, lrun[2] = {0.f, 0.f};
#pragma unroll
    for (int a = 0; a < 2; ++a)
#pragma unroll
        for (int cc = 0; cc < 2; ++cc)
#pragma unroll
            for (int r = 0; r < 16; ++r) o[a][cc][r] = 0.f;
    const size_t hoff = (size_t)h * 64;
    const float* ckb = p.ck + ((size_t)b * PAST + 256 * c) * 512 + hoff; const float* cvb = p.cv + ((size_t)b * PAST + 256 * c) * 512 + hoff;
    const float* nkb = p.out + O_FKS + (size_t)b * NSMP * 512 + hoff; const float* nvb = p.out + O_FVS + (size_t)b * NSMP * 512 + hoff;
    const int nstep = (c == 15) ? 10 : 8;
    f32x4 kraw[8], vraw[8];
#define FS_LOAD(s_) do { const int s__ = (s_); const float* kp = s__ < 8 ? ckb + (size_t)s__ * 32 * 512 : nkb + (size_t)(s__ - 8) * 32 * 512; \
        const float* vp = s__ < 8 ? cvb + (size_t)s__ * 32 * 512 : nvb + (size_t)(s__ - 8) * 32 * 512; \
        _Pragma("unroll") for (int d0 = 0; d0 < 4; ++d0) { kraw[2 * d0] = *(const f32x4*)(kp + r32 * 512 + 16 * d0 + 8 * hi); kraw[2 * d0 + 1] = *(const f32x4*)(kp + r32 * 512 + 16 * d0 + 8 * hi + 4); } \
        _Pragma("unroll") for (int i = 0; i < 4; ++i) { const int pr = 4 * i + (lane >> 4); vraw[2 * i] = *(const f32x4*)(vp + (2 * pr) * 512 + 4 * (lane & 15)); vraw[2 * i + 1] = *(const f32x4*)(vp + (2 * pr + 1) * 512 + 4 * (lane & 15)); } } while (0)
    FS_LOAD(0);
    for (int s = 0; s < nstep; ++s) {
        bf16x8 kf[4];
#pragma unroll
        for (int d0 = 0; d0 < 4; ++d0) { u32x4 w; w.x = pk2(kraw[2 * d0][0], kraw[2 * d0][1]); w.y = pk2(kraw[2 * d0][2], kraw[2 * d0][3]); w.z = pk2(kraw[2 * d0 + 1][0], kraw[2 * d0 + 1][1]); w.w = pk2(kraw[2 * d0 + 1][2], kraw[2 * d0 + 1][3]);
            kf[d0] = __builtin_bit_cast(bf16x8, w); }
#pragma unroll
        for (int i = 0; i < 4; ++i) { const int kap = 2 * (4 * i + (lane >> 4)); const int pos = (kap & ~12) | ((kap & 4) << 1) | ((kap & 8) >> 1);
#pragma unroll
            for (int e = 0; e < 4; ++e) *(LAS unsigned*)(vtw + (4 * (lane & 15) + e) * 80 + pos * 2) = pk2(vraw[2 * i][e], vraw[2 * i + 1][e]); }
        if (s + 1 < nstep) FS_LOAD(s + 1);
        f32x16 sc[2];
#pragma unroll
        for (int qb = 0; qb < 2; ++qb) {
#pragma unroll
            for (int r = 0; r < 16; ++r) sc[qb][r] = 0.f;
#pragma unroll
            for (int d0 = 0; d0 < 4; ++d0) sc[qb] = MFMA32(kf[d0], qr[qb][d0], sc[qb]); }
        const int key0 = 32 * s;
#pragma unroll
        for (int g = 0; g < 4; ++g) { const f32x4 bv = *(const LAS f32x4*)(ab + key0 + 8 * g + 4 * hi);
#pragma unroll
            for (int e = 0; e < 4; ++e) { sc[0][4 * g + e] += bv[e]; sc[1][4 * g + e] += bv[e]; } }
        if (s >= 8) {
#pragma unroll
            for (int qb = 0; qb < 2; ++qb)
#pragma unroll
                for (int r = 0; r < 16; ++r) { const int kn = key0 - 256 + crow(r, hi); if (kn > 32 * qb + r32) sc[qb][r] = -INFINITY; } }
        bf16x8 pf[2][2];
#pragma unroll
        for (int qb = 0; qb < 2; ++qb) { float rm = sc[qb][0];
#pragma unroll
            for (int r = 1; r < 16; ++r) rm = fmaxf(rm, sc[qb][r]);
            rm = fmaxf(rm, __shfl_xor(rm, 32));
            const float mn = fmaxf(mrun[qb], rm), alpha = __builtin_amdgcn_exp2f(mrun[qb] - mn); mrun[qb] = mn; float ps = 0.f;
#pragma unroll
            for (int r = 0; r < 16; ++r) { const float e_ = __builtin_amdgcn_exp2f(sc[qb][r] - mn); sc[qb][r] = e_; ps += e_; }
            lrun[qb] = lrun[qb] * alpha + ps;
#pragma unroll
            for (int r = 0; r < 16; ++r) { o[qb][0][r] *= alpha; o[qb][1][r] *= alpha; }
#pragma unroll
            for (int ks = 0; ks < 2; ++ks) { u32x4 w; w.x = pk2(sc[qb][8 * ks], sc[qb][8 * ks + 1]); w.y = pk2(sc[qb][8 * ks + 2], sc[qb][8 * ks + 3]); w.z = pk2(sc[qb][8 * ks + 4], sc[qb][8 * ks + 5]); w.w = pk2(sc[qb][8 * ks + 6], sc[qb][8 * ks + 7]);
                pf[qb][ks] = __builtin_bit_cast(bf16x8, w); } }
#pragma unroll
        for (int db = 0; db < 2; ++db)
#pragma unroll
            for (int ks = 0; ks < 2; ++ks) { const bf16x8 vf = *(const LAS bf16x8*)(vtw + (32 * db + r32) * 80 + (16 * ks + 8 * hi) * 2);
                o[0][db] = MFMA32(vf, pf[0][ks], o[0][db]); o[1][db] = MFMA32(vf, pf[1][ks], o[1][db]); }
    }
#undef FS_LOAD
    lrun[0] += __shfl_xor(lrun[0], 32); lrun[1] += __shfl_xor(lrun[1], 32);
    float* part = (float*)(p.ws + WS_PART) + (size_t)((b * 8 + h) * 16 + c) * PART_STRIDE;
#pragma unroll
    for (int qb = 0; qb < 2; ++qb) { const int q = 32 * qb + r32;
        if (hi == 0) { part[4096 + q] = mrun[qb]; part[4160 + q] = lrun[qb]; }
#pragma unroll
        for (int db = 0; db < 2; ++db)
#pragma unroll
            for (int g = 0; g < 4; ++g) *(f32x4*)(part + q * 64 + 32 * db + 8 * g + 4 * hi) = (f32x4){o[qb][db][4 * g], o[qb][db][4 * g + 1], o[qb][db][4 * g + 2], o[qb][db][4 * g + 3]}; }
}
__device__ __forceinline__ void fs_combine_job(const Params& p_, const int b, const int h) {
    const Params p = fresh_params(p_);
    const int tid = tid_fresh(), q = tid >> 3, dg = tid & 7;
    const float* part = (const float*)(p.ws + WS_PART) + (size_t)((b * 8 + h) * 16) * PART_STRIDE;
    float M = -3e38f;
#pragma unroll
    for (int c = 0; c < 16; ++c) M = fmaxf(M, part[(size_t)c * PART_STRIDE + 4096 + q]);
    float L = 0.f; f32x4 a0 = {0.f, 0.f, 0.f, 0.f}, a1 = a0;
#pragma unroll
    for (int c = 0; c < 16; ++c) { const float* pc = part + (size_t)c * PART_STRIDE; const float wg = __builtin_amdgcn_exp2f(pc[4096 + q] - M); L += wg * pc[4160 + q];
        a0 += *(const f32x4*)(pc + q * 64 + 8 * dg) * wg; a1 += *(const f32x4*)(pc + q * 64 + 8 * dg + 4) * wg; }
    const float inv = 1.0f / L; u32x4 w; w.x = pk2(a0[0] * inv, a0[1] * inv); w.y = pk2(a0[2] * inv, a0[3] * inv); w.z = pk2(a1[0] * inv, a1[1] * inv); w.w = pk2(a1[2] * inv, a1[3] * inv);
    *(u32x4*)((bf16*)(p.ws + WS_MIX) + ((size_t)MP + b * NSMP + q) * DM + 512 + h * 64 + 8 * dg) = w;
}
constexpr int NFP = NB * 8 * (TSEQ / 256);
constexpr int Q_FSC = NB * 16, Q_RETS = NB * 4, Q_RETP = NB * 4, Q_FSM = NB * 8, Q_P3S = 16, Q_FP1 = 300, Q_P4S = 4 * 22, Q_FP2 = 300, Q_P5S = 64;
constexpr int Q_FP3 = NFP - Q_FP1 - Q_FP2;
constexpr int NJOBS = Q_FSC + Q_RETS + Q_RETP + Q_FSM + Q_P3S + Q_FP1 + Q_P4S + Q_FP2 + Q_P5S + Q_FP3;
constexpr size_t WS_HS = WS_END;
constexpr size_t WS_END2 = WS_PART + (size_t)NB * 8 * 16 * PART_STRIDE * 4;
__device__ __forceinline__ void gate_wait(unsigned* c, unsigned target) {
    if (tid_fresh() == 0) { unsigned sp = 0; while (__hip_atomic_load(c, RLX_AGENT) < target && ++sp < (1u << 22)) __builtin_amdgcn_s_sleep(4);
        __builtin_amdgcn_fence(__ATOMIC_ACQUIRE, "agent"); asm volatile("s_waitcnt vmcnt(0)" ::: "memory"); }
    __syncthreads();
}
__device__ __forceinline__ void job_signal(unsigned* c) {
    asm volatile("s_waitcnt vmcnt(0)" ::: "memory");
    __syncthreads();
    if (tid_fresh() == 0) { __builtin_amdgcn_fence(__ATOMIC_RELEASE, "agent"); asm volatile("s_waitcnt vmcnt(0)" ::: "memory"); __hip_atomic_fetch_add(c, 1u, RLX_AGENT); }
}
__global__ void __launch_bounds__(NTHR, 2) hybrid_fwd(Params p) {
    extern __shared__ __attribute__((aligned(16))) unsigned char lds_raw[];
    LAS unsigned char* lds = (LAS unsigned char*)lds_raw;
    cg::grid_group grid = cg::this_grid();
    const int G = gridDim.x, bx = blockIdx.x, vcu = (G % 8 == 0) ? (bx % 8) * (G / 8) + bx / 8 : bx;
    unsigned char* ws = p.ws;
    volatile LAS unsigned* MISCU = (volatile LAS unsigned*)(lds + MISC_OFF);
    if (threadIdx.x < 32) MISCU[threadIdx.x] = 0u;
    __syncthreads();
    if (p.ws == nullptr) grid.sync();
    const XcdBarrier xbar = xcd_barrier_post((unsigned*)(ws + WS_CTL) + 4096, MISCU + 8);
    p0_prep(p, lds, vcu, G);
    xcd_barrier(xbar);
    p1_cumsum(p, lds);
    __syncthreads();
    { pg8::Gemm g{(const bf16*)(ws + WS_XN), (const bf16*)(ws + WS_WIN), MTOK, NZ, DM, DM}; pg8::StaticOrder S; S.init(MTOK, NZ, G, bx);
      pg8::EpiInProj E{(bf16*)(ws + WS_Z), p.out, (const float*)(ws + WS_CS)};
      pg8::gemm_phase<pg8::EpiInProj, pg8::StaticOrder, true, true>(lds, g, S, E); }
    xcd_barrier(xbar);
    { volatile LAS int* MISC = (volatile LAS int*)(lds + MISC_OFF);
      for (;;) {
          if (tid_fresh() == 0) MISC[0] = (int)atomicAdd((unsigned*)(ws + WS_CTL), 1u);
          __syncthreads();
          int job = __builtin_amdgcn_readfirstlane(MISC[0]);
          __syncthreads();
#ifndef DUP_KIND
#define DUP_KIND 0
#endif
          constexpr int NDUP = DUP_KIND == 1 ? 2560 : DUP_KIND == 2 ? 1024 : 0;
          if (job >= NJOBS + NDUP) break;
          if (job >= NJOBS) { const int d = job - NJOBS;
              if (DUP_KIND == 2) { const Params q = fresh_params(p); bf16* Z = (bf16*)(q.ws + WS_Z); attn_body::attn_unit<8>((d & 127) >> 3, d & 7, 7 - (d >> 7), (const attn_body::bf16*)(Z + 2048), (const attn_body::bf16*)(Z + 2560), (const attn_body::bf16*)(Z + 3072), (attn_body::bf16*)((bf16*)(q.ws + WS_MIX) + 512), (const float*)(q.ws + WS_CB), (char*)lds_raw); }
              __syncthreads(); continue; }
          const Params q = fresh_params(p);
          unsigned char* qws = q.ws; unsigned* cnt = (unsigned*)(qws + WS_CTL);
          bf16* Z = (bf16*)(qws + WS_Z); bf16* MIX = (bf16*)(qws + WS_MIX); bf16* XN = (bf16*)(qws + WS_XN);
          int fp = -1;
          if (job < Q_FSC) { fs_chunk_job(lds, p, job >> 4, job & 15); job_signal(cnt + 64 + 64 * (job >> 4)); }
          else if ((job -= Q_FSC) < Q_RETS) { ret_job(lds, p, true, job >> 2, job & 3); job_signal(cnt + 1216); }
          else if ((job -= Q_RETS) < Q_RETP) ret_job(lds, p, false, job >> 2, job & 3);
          else if ((job -= Q_RETP) < Q_FSM) { gate_wait(cnt + 64 + 64 * (job >> 3), 16); fs_combine_job(p, job >> 3, job & 7); job_signal(cnt + 1216); }
          else if ((job -= Q_FSM) < Q_P3S) { gate_wait(cnt + 1216, Q_RETS + Q_FSM);
              pg8::Gemm g{MIX, (const bf16*)(qws + WS_WO), MTOK, DM, DM, DM}; pg8::OneUnit S{MP / 256 + job / 4, job % 4};
              pg8::EpiResid E{q.xp, q.xs, q.out + O_Y, XN, (float*)(qws + WS_SS1)};
              pg8::gemm_phase<pg8::EpiResid, pg8::OneUnit, true, true>(lds, g, S, E); job_signal(cnt + 1280); }
          else if ((job -= Q_P3S) < Q_FP1) fp = job;
          else if ((job -= Q_FP1) < Q_P4S) { gate_wait(cnt + 1280, Q_P3S);
              pg8::Gemm g{XN, (const bf16*)(qws + WS_WGU), MTOK, NGU, DM, DM}; pg8::OneUnit S{MP / 256 + job / 22, job % 22};
              pg8::EpiGateUp E{(bf16*)(qws + WS_HS) - (size_t)MP * DFF, (const float*)(qws + WS_SS1)};
              pg8::gemm_phase<pg8::EpiGateUp, pg8::OneUnit, true, true>(lds, g, S, E); job_signal(cnt + 1344); }
          else if ((job -= Q_P4S) < Q_FP2) fp = Q_FP1 + job;
          else if ((job -= Q_FP2) < Q_P5S) { gate_wait(cnt + 1344, Q_P4S);
              const int kq = job & 3, un = job >> 2, koff = (kq == 0 ? 0 : kq == 1 ? 768 : kq == 2 ? 1408 : 2176), klen = (kq & 1) ? 640 : 768;
              pg8::Gemm g{(const bf16*)(qws + WS_HS) - (size_t)MP * DFF + koff, (const bf16*)(qws + WS_WD) + koff, MTOK, DM, klen, DFF}; pg8::OneUnit S{MP / 256 + un / 4, un % 4};
              pg8::EpiAtomic E{q.out + O_Y};
              pg8::gemm_phase<pg8::EpiAtomic, pg8::OneUnit, true, true>(lds, g, S, E); }
          else fp = Q_FP1 + Q_FP2 + (job - Q_P5S);
          if (fp >= 0) { const int qb = (TSEQ / 256 - 1) - (fp >> 7), bh = fp & 127;
              attn_body::attn_unit<8>(bh >> 3, bh & 7, qb, (const attn_body::bf16*)(Z + 2048), (const attn_body::bf16*)(Z + 2560), (const attn_body::bf16*)(Z + 3072),
                                      (attn_body::bf16*)(MIX + 512), (const float*)(qws + WS_CB), (char*)lds_raw); }
          __syncthreads();
      } }
    xcd_barrier(xbar);
#ifndef REP_G
#define REP_G 1
#endif
    for (int rep = 0; rep < REP_G; ++rep) { pg8::Gemm g{(const bf16*)(ws + WS_MIX), (const bf16*)(ws + WS_WO), MP, DM, DM, DM}; pg8::StaticOrder S; S.init(MP, DM, G, bx);
      pg8::EpiResid E{p.xp, p.xs, p.out + O_Y, (bf16*)(ws + WS_XN), rep ? (float*)(ws + WS_SS2) : (float*)(ws + WS_SS1)};
      pg8::gemm_phase<pg8::EpiResid, pg8::StaticOrder, true, true>(lds, g, S, E);
    xcd_barrier(xbar); }
    for (int rep = 0; rep < REP_G; ++rep) { pg8::Gemm g{(const bf16*)(ws + WS_XN), (const bf16*)(ws + WS_WGU), MP, NGU, DM, DM}; pg8::StaticOrder S; S.init(MP, NGU, G, bx);
      pg8::EpiGateUp E{(bf16*)(ws + WS_H), (const float*)(ws + WS_SS1)};
      pg8::gemm_phase<pg8::EpiGateUp, pg8::StaticOrder, true, true>(lds, g, S, E);
    xcd_barrier(xbar); }
    for (int rep = REP_G - 1; rep >= 0; --rep) { pg8::Gemm g{(const bf16*)(ws + WS_H), (const bf16*)(ws + WS_WD), MP, DM, DFF, DFF}; pg8::StaticOrder S; S.init(MP, DM, G, bx);
      pg8::EpiResid E{rep ? p.out + O_Y : nullptr, nullptr, rep ? (float*)(ws + WS_XN) : p.out + O_Y, nullptr, nullptr};
      pg8::gemm_phase<pg8::EpiResid, pg8::StaticOrder, true, true>(lds, g, S, E);
    xcd_barrier(xbar); }
    p6_final(p, vcu, G);
}

extern "C" void kernel_launch(void* const* d_in, const int* in_sizes, int n_in, void* d_out, int out_size, void* d_ws, size_t ws_size, hipStream_t stream) {
    static int grid = 0;
    if (grid == 0) {
        if (n_in != 16 || out_size != (int)O_END || ws_size < WS_END2) { fprintf(stderr, "kernel_launch: unexpected shapes (n_in %d, out %d, ws %zu); nothing launched\n", n_in, out_size, ws_size); grid = -1; return; }
        int dev = 0, cus = 0, per_cu = 0;
        if (hipGetDevice(&dev) != hipSuccess || hipDeviceGetAttribute(&cus, hipDeviceAttributeMultiprocessorCount, dev) != hipSuccess) { grid = -1; return; }
        if (hipFuncSetAttribute((const void*)hybrid_fwd, hipFuncAttributeMaxDynamicSharedMemorySize, LDS_BYTES) != hipSuccess) { fprintf(stderr, "kernel_launch: hipFuncSetAttribute failed\n"); grid = -1; return; }
        if (hipOccupancyMaxActiveBlocksPerMultiprocessor(&per_cu, (const void*)hybrid_fwd, NTHR, LDS_BYTES) != hipSuccess || per_cu < 1) { fprintf(stderr, "kernel_launch: occupancy query says %d blocks per CU\n", per_cu); per_cu = 1; }
        (void)hipGetLastError();
        grid = cus * per_cu;
    }
    if (grid < 0) return;
    Params p{};
    p.xp = (const float*)d_in[0]; p.xs = (const float*)d_in[1]; p.ck = (const float*)d_in[2]; p.cv = (const float*)d_in[3]; p.clf = (const float*)d_in[4]; p.sr = (const float*)d_in[5];
    p.win = (const float*)d_in[6]; p.bfg = (const float*)d_in[7]; p.gn = (const float*)d_in[8]; p.wout = (const float*)d_in[9]; p.gmix = (const float*)d_in[10]; p.gffn = (const float*)d_in[11];
    p.wg = (const float*)d_in[12]; p.wu = (const float*)d_in[13]; p.wd = (const float*)d_in[14]; p.gfin = (const float*)d_in[15];
    p.out = (float*)d_out; p.ws = (unsigned char*)d_ws;
    void* args[] = {&p};
    (void)hipMemsetAsync((char*)d_ws + WS_CTL + 4096 * 4, 0, XCD_BAR_WORDS * 4, stream);
    const hipError_t e = hipLaunchCooperativeKernel((const void*)hybrid_fwd, dim3(grid), dim3(NTHR), args, LDS_BYTES, stream);
    if (e != hipSuccess) fprintf(stderr, "kernel_launch: cooperative launch failed: %s (grid %d)\n", hipGetErrorString(e), grid);
}
```

```cpp
#include <hip/hip_runtime.h>
#include <hip/hip_cooperative_groups.h>
#include <hip/hip_bf16.h>
#include <cstdio>
#include <cstdint>
#include <cmath>
namespace cg = cooperative_groups;

constexpr int DM = 1024, NB = 16, TSEQ = 2048, MP = NB * TSEQ, NSMP = 64, MS = NB * NSMP, MTOK = MP + MS, PAST = 4096;
constexpr int DIN = 3592, NZ = 3584, DFF = 2816, NGU = 2 * DFF;
constexpr size_t O_Y = 0, O_SRP = (size_t)MTOK * DM, O_FKP = O_SRP + 1048576, O_FVP = O_FKP + 16777216, O_LFP = O_FVP + 16777216, O_SRS = O_LFP + 262144,
                 O_FKS = O_SRS + 1048576, O_FVS = O_FKS + 524288, O_LFS = O_FVS + 524288, O_END = O_LFS + 8192;
constexpr size_t MiB = 1u << 20;
constexpr size_t WS_CTL = 0, WS_SS1 = 64 * 1024, WS_SS2 = 256 * 1024, CTL_BYTES = 512 * 1024;
constexpr size_t WS_CS = 1 * MiB, WS_CB = 3 * MiB, WS_WIN = 4 * MiB, WS_WO = 11 * MiB, WS_WGU = 13 * MiB, WS_WD = 24 * MiB;
constexpr size_t WS_XN = 32 * MiB, WS_MIX = 98 * MiB, WS_Z = 164 * MiB, WS_H = WS_Z, WS_END = 395 * MiB;
constexpr float C2F = 0.125f * 1.4426950408889634f;

struct Params {
    const float *xp, *xs, *ck, *cv, *clf, *sr, *win, *bfg, *gn, *wout, *gmix, *gffn, *wg, *wu, *wd, *gfin;
    float* out; unsigned char* ws;
};

__device__ __forceinline__ int tid_fresh() { int t = threadIdx.x; asm volatile("" : "+v"(t)); return t; }

__device__ __forceinline__ Params fresh_params(const Params& p) {
    Params q = p;
    asm volatile("" : "+s"(q.out), "+s"(q.ws), "+s"(q.ck), "+s"(q.cv), "+s"(q.clf), "+s"(q.sr), "+s"(q.gn));
    return q;
}

namespace pg8 {
#define PG8_LAS __attribute__((address_space(3)))
typedef unsigned short bf16_t;
typedef short bf16x8 __attribute__((ext_vector_type(8)));
typedef float f32x4 __attribute__((ext_vector_type(4)));
typedef unsigned u32x4 __attribute__((ext_vector_type(4)));
constexpr int BM = 256, BK = 64, HALF = 128, HTB = HALF * BK * 2  , STAGE_BYTES = 8 * HTB, NXCD = 8, WGM = 8;

__host__ __device__ __forceinline__ int lds_byte(int r, int c) { const int st = (r >> 4) * 2 + (c >> 5), rr = r & 15, cc = c & 31, ob = rr * 64 + cc * 2; return st * 1024 + (ob ^ (((ob >> 9) & 1) << 5)); }
__host__ __device__ __forceinline__ void stage_rc(int b, int& R, int& C) { const int st = b / 1024, sb = b % 1024, swz = sb ^ (((sb >> 9) & 1) << 5); R = (st >> 1) * 16 + swz / 64; C = (st & 1) * 32 + (swz % 64) / 2; }
__host__ __device__ __forceinline__ int perm32(int rho) { const int n = rho >> 4, i = rho & 15; return 8 * (i >> 2) + 4 * n + (i & 3); }

struct Unit { int pm, pn; };
struct Gemm { const bf16_t* A; const bf16_t* Bt; int M, N, K, ld; };

struct StaticOrder {
    int nM, nN, nwg, G, c;
    __host__ __device__ void init(int M, int N, int G_, int c_) { nM = M / BM; nN = N / BM; nwg = nM * nN; G = G_; c = c_; }
    __host__ __device__ bool next(int i, Unit& u) const {
        const long L = (long)i * G + c; if (L >= nwg) return false;
        int wgid = (int)L; { const int q = nwg / NXCD, r = nwg % NXCD, xcd = wgid % NXCD, off = wgid / NXCD; wgid = (xcd < r ? xcd * (q + 1) : r * (q + 1) + (xcd - r) * q) + off; }
        const int nig = WGM * nN, gid = wgid / nig, fm = gid * WGM, gsz = (nM - fm) < WGM ? (nM - fm) : WGM;
        u.pm = fm + ((wgid % nig) % gsz); u.pn = (wgid % nig) / gsz; return true;
    }
    __device__ __forceinline__ void a_ready(const Unit&) const {}
    __device__ __forceinline__ void done(const Unit&) const {}
};


struct OneUnit { int pm, pn;
    __device__ __forceinline__ bool next(int i, Unit& u) const { if (i) return false; u.pm = pm; u.pn = pn; return true; }
    __device__ __forceinline__ void a_ready(const Unit&) const {}
    __device__ __forceinline__ void done(const Unit&) const {}
};
typedef float f32x2 __attribute__((ext_vector_type(2)));
typedef __bf16 bf16x2_t __attribute__((ext_vector_type(2)));
typedef unsigned u32x2 __attribute__((ext_vector_type(2)));
__device__ __forceinline__ unsigned cvt_pk_bf16(float lo, float hi) { f32x2 v = {lo, hi}; bf16x2_t b = __builtin_convertvector(v, bf16x2_t); return __builtin_bit_cast(unsigned, b); }
__device__ __forceinline__ float silu_f(float x) { return x * __builtin_amdgcn_rcpf(1.f + __builtin_amdgcn_exp2f(x * -1.4426950408889634f)); }

struct EpiInProj {
    static constexpr bool PERM = true, AFTER_DRAIN = false;
    bf16_t* Z; float* out; const float* cs;
    __device__ __forceinline__ void operator()(const f32x4 (&acc)[2][2][4][2], const Unit& u, int wr, int wc, int fr, int fq) const {
        const int pn = u.pn, row0 = u.pm * BM + wr * 64 + fr; const bool prompt = u.pm < (MP / BM);
        if (pn < 4) {
            const float sc = pn < 2 ? 0.08838834764831845f : 1.f; const int d0 = 16 * wc + 4 * fq;
#pragma unroll
            for (int ai = 0; ai < 2; ++ai)
#pragma unroll
                for (int m = 0; m < 4; ++m) { const int row = row0 + ai * HALF + m * 16; const int tix = prompt ? (row & (TSEQ - 1)) : TSEQ + ((row - MP) & (NSMP - 1));
                    const float* cr = cs + (size_t)tix * 128 + 2 * d0; const f32x4 c01 = *(const f32x4*)cr, c23 = *(const f32x4*)(cr + 4);
                    bf16_t* zrow = Z + (size_t)row * NZ + pn * BM + d0;
#pragma unroll
                    for (int bj = 0; bj < 2; ++bj) { const f32x4 v0 = acc[ai][bj][m][0], v1 = acc[ai][bj][m][1];
                        const float a0 = (v0[0] * c01[0] - v0[1] * c01[1]) * sc, b0 = (v0[0] * c01[1] + v0[1] * c01[0]) * sc;
                        const float a1 = (v0[2] * c01[2] - v0[3] * c01[3]) * sc, b1 = (v0[2] * c01[3] + v0[3] * c01[2]) * sc;
                        const float a2 = (v1[0] * c23[0] - v1[1] * c23[1]) * sc, b2 = (v1[0] * c23[1] + v1[1] * c23[0]) * sc;
                        const float a3 = (v1[2] * c23[2] - v1[3] * c23[3]) * sc, b3 = (v1[2] * c23[3] + v1[3] * c23[2]) * sc;
                        u32x2 w1, w2; w1.x = cvt_pk_bf16(a0, a1); w1.y = cvt_pk_bf16(a2, a3); w2.x = cvt_pk_bf16(b0, b1); w2.y = cvt_pk_bf16(b2, b3);
                        *(u32x2*)(zrow + bj * HALF) = w1; *(u32x2*)(zrow + bj * HALF + 64) = w2; } }
        } else {
            const float sc = (pn == 8 || pn == 9) ? C2F : 1.f; const int cw = wc * 32 + 8 * fq;
            float* fo = nullptr; size_t fstride = 512;
            if (pn >= 10) { const bool isv = pn >= 12; const int cb = (pn - (isv ? 12 : 10)) * BM + cw;
                fo = prompt ? out + (isv ? O_FVP : O_FKP) + (size_t)row0 * 512 + cb : out + (isv ? O_FVS : O_FKS) + (size_t)(row0 - MP) * 512 + cb; }
#pragma unroll
            for (int ai = 0; ai < 2; ++ai)
#pragma unroll
                for (int m = 0; m < 4; ++m) { bf16_t* rowp = Z + (size_t)(row0 + ai * HALF + m * 16) * NZ + pn * BM + cw; float* fr_ = fo + (size_t)(ai * HALF + m * 16) * fstride;
#pragma unroll
                    for (int bj = 0; bj < 2; ++bj) { const f32x4 v0 = acc[ai][bj][m][0] * sc, v1 = acc[ai][bj][m][1] * sc;
                        u32x4 w; w.x = cvt_pk_bf16(v0[0], v0[1]); w.y = cvt_pk_bf16(v0[2], v0[3]); w.z = cvt_pk_bf16(v1[0], v1[1]); w.w = cvt_pk_bf16(v1[2], v1[3]);
                        *(u32x4*)(rowp + bj * HALF) = w;
                        if (fo) { *(f32x4*)(fr_ + bj * HALF) = v0; *(f32x4*)(fr_ + bj * HALF + 4) = v1; } } }
        }
    }
};
struct EpiResid {
    static constexpr bool PERM = false, AFTER_DRAIN = false;
    const float* xp; const float* xs; float* Y; bf16_t* Yb; float* ss; const bf16_t* Xb;
    __device__ __forceinline__ void operator()(const f32x4 (&acc)[2][2][4][2], const Unit& u, int wr, int wc, int fr, int fq) const {
        const int row0 = u.pm * BM + wr * 64 + fr, col0 = u.pn * BM + wc * 32 + 4 * fq; const bool prompt = u.pm < (MP / BM);
#pragma unroll
        for (int ai = 0; ai < 2; ++ai)
#pragma unroll
            for (int m = 0; m < 4; ++m) { const int row = row0 + ai * HALF + m * 16; const size_t off = (size_t)row * DM + col0; float* yr = Y ? Y + off : nullptr;
                const float* br = xp ? (prompt ? xp + off : xs + ((size_t)(row - MP) * DM + col0)) : (const float*)yr; float s = 0.f;
#pragma unroll
                for (int bj = 0; bj < 2; ++bj)
#pragma unroll
                    for (int n = 0; n < 2; ++n) { const int co = bj * HALF + n * 16; f32x4 bs;
                        if (Xb) { const u32x2 w = *(const u32x2*)(Xb + off + co); bs = (f32x4){__uint_as_float(w.x << 16), __uint_as_float(w.x & 0xffff0000u), __uint_as_float(w.y << 16), __uint_as_float(w.y & 0xffff0000u)}; }
                        else if (br) bs = *(const f32x4*)(br + co); else bs = (f32x4){0.f, 0.f, 0.f, 0.f};
                        const f32x4 v = acc[ai][bj][m][n] + bs; if (Y) *(f32x4*)(yr + co) = v;
                        s += (v[0] * v[0] + v[1] * v[1]) + (v[2] * v[2] + v[3] * v[3]);
                        if (Yb) { u32x2 w; w.x = cvt_pk_bf16(v[0], v[1]); w.y = cvt_pk_bf16(v[2], v[3]); *(u32x2*)(Yb + off + co) = w; } }
                if (ss) { s += __shfl_xor(s, 16); s += __shfl_xor(s, 32); }
                if (ss && fq == 0) atomicAdd(ss + row, s); }
    }
};
struct EpiGateUp {
    static constexpr bool PERM = true, AFTER_DRAIN = false;
    bf16_t* H; const float* ss;
    __device__ __forceinline__ void operator()(const f32x4 (&acc)[2][2][4][2], const Unit& u, int wr, int wc, int fr, int fq) const {
        const int row0 = u.pm * BM + wr * 64 + fr, f0 = u.pn * 128 + wc * 16 + 4 * fq;
#pragma unroll
        for (int ai = 0; ai < 2; ++ai)
#pragma unroll
            for (int m = 0; m < 4; ++m) { const int row = row0 + ai * HALF + m * 16; const float r = 1.0f / sqrtf(ss[row] * (1.0f / DM) + 1e-6f);
#pragma unroll
                for (int bj = 0; bj < 2; ++bj) { const f32x4 v0 = acc[ai][bj][m][0] * r, v1 = acc[ai][bj][m][1] * r;
                    u32x2 w; w.x = cvt_pk_bf16(silu_f(v0[0]) * v0[1], silu_f(v0[2]) * v0[3]); w.y = cvt_pk_bf16(silu_f(v1[0]) * v1[1], silu_f(v1[2]) * v1[3]);
                    *(u32x2*)(H + (size_t)row * DFF + f0 + bj * 64) = w; } }
    }
};

struct EpiAtomic {
    static constexpr bool PERM = false, AFTER_DRAIN = false;
    float* Y;
    __device__ __forceinline__ void operator()(const f32x4 (&acc)[2][2][4][2], const Unit& u, int wr, int wc, int fr, int fq) const {
        const int row0 = u.pm * BM + wr * 64 + fr, col0 = u.pn * BM + wc * 32 + 4 * fq;
#pragma unroll
        for (int ai = 0; ai < 2; ++ai)
#pragma unroll
            for (int m = 0; m < 4; ++m) { float* yr = Y + (size_t)(row0 + ai * HALF + m * 16) * DM + col0;
#pragma unroll
                for (int bj = 0; bj < 2; ++bj)
#pragma unroll
                    for (int n = 0; n < 2; ++n) { const f32x4 v = acc[ai][bj][m][n]; float* y = yr + bj * HALF + n * 16;
#pragma unroll
                        for (int e = 0; e < 4; ++e) __hip_atomic_fetch_add(y + e, v[e], __ATOMIC_RELAXED, __HIP_MEMORY_SCOPE_AGENT); } }
    }
};

template <class Epi, class Sched, bool ALIGN_EPI = false, bool SP2 = false>
__device__ __forceinline__ void gemm_phase(PG8_LAS unsigned char* lds, const Gemm g, const Sched& S, const Epi& E) {
    const int tid = tid_fresh(), wid = __builtin_amdgcn_readfirstlane(tid >> 6), lane = tid & 63, wr = wid >> 2, wc = wid & 3, fr = lane & 15, fq = lane >> 4;
    const int K = g.ld, nt = g.K / BK;
    unsigned voffA[2], voffB[2];
#pragma unroll
    for (int i = 0; i < 2; ++i) { int R, C; stage_rc(tid * 16 + i * 8192, R, C); const int Rb = Epi::PERM ? ((R & ~31) + perm32(R & 31)) : R;
        voffA[i] = (unsigned)(R * K + C) * 2u; voffB[i] = (unsigned)(Rb * K + C) * 2u; }
    const size_t kstep = (size_t)(BK * 2);
    const size_t hstep = (size_t)HALF * K * 2;
    const size_t tstep = 2 * hstep;
    const unsigned ldsw = (unsigned)wid * 1024u;
    const int aoff = lds_byte(wr * 64 + fr, fq * 8), boff = lds_byte(wc * 32 + fr, fq * 8);
#define PG8_SA(b, h) (((b) * 2 + (h)) * HTB)
#define PG8_SB(b, h) ((4 + (b) * 2 + (h)) * HTB)
#define PG8_STAGE(bufoff, gbase, voff) do { _Pragma("unroll") for (int _i = 0; _i < 2; ++_i) \
        __builtin_amdgcn_global_load_lds((const unsigned*)((const char*)(gbase) + (voff)[_i]), (PG8_LAS unsigned*)(lds + (bufoff) + ldsw + _i * 8192), 16, 0, 0); } while (0)
#define PG8_LDA(dst, b, h) do { _Pragma("unroll") for (int m = 0; m < 4; ++m) _Pragma("unroll") for (int k = 0; k < 2; ++k) dst[m][k] = *(const PG8_LAS bf16x8*)(lds + PG8_SA(b, h) + aoff + m * 2048 + k * 1024); } while (0)
#define PG8_LDB(dst, b, h) do { _Pragma("unroll") for (int n = 0; n < 2; ++n) _Pragma("unroll") for (int k = 0; k < 2; ++k) dst[n][k] = *(const PG8_LAS bf16x8*)(lds + PG8_SB(b, h) + boff + n * 2048 + k * 1024); } while (0)
#define PG8_MMA(ai, bj, At, Bt) do { __builtin_amdgcn_s_setprio(1); _Pragma("unroll") for (int m = 0; m < 4; ++m) _Pragma("unroll") for (int n = 0; n < 2; ++n) _Pragma("unroll") for (int k = 0; k < 2; ++k) \
        acc[ai][bj][m][n] = __builtin_amdgcn_mfma_f32_16x16x32_bf16(Bt[n][k], At[m][k], acc[ai][bj][m][n], 0, 0, 0); __builtin_amdgcn_s_setprio(0); } while (0)
#define PG8_WAIT_V(n) asm volatile("s_waitcnt vmcnt(" #n ")" ::: "memory")
#define PG8_WAIT_L(n) asm volatile("s_waitcnt lgkmcnt(" #n ")" ::: "memory")
#define PG8_BAR __builtin_amdgcn_s_barrier()
#define PG8_SCHED __builtin_amdgcn_sched_barrier(0)
    Unit cur, nxt; int ui = 0;
    if (!S.next(0, cur)) return;
    f32x4 acc[2][2][4][2];
#pragma unroll
    for (int a = 0; a < 2; ++a)
#pragma unroll
        for (int b = 0; b < 2; ++b)
#pragma unroll
            for (int m = 0; m < 4; ++m)
#pragma unroll
                for (int n = 0; n < 2; ++n) acc[a][b][m][n] = (f32x4){0.f, 0.f, 0.f, 0.f};
    bf16x8 At[4][2], B0[2][2], B1[2][2];
    const char* cA = (const char*)g.A + (size_t)cur.pm * tstep; const char* cB = (const char*)g.Bt + (size_t)cur.pn * tstep;
    S.a_ready(cur);
    if constexpr (SP2) {
        PG8_STAGE(PG8_SB(0, 0), cB, voffB); PG8_STAGE(PG8_SB(0, 1), cB + hstep, voffB); PG8_STAGE(PG8_SA(0, 0), cA, voffA); PG8_STAGE(PG8_SA(0, 1), cA + hstep, voffA);
        if (wr == 1) PG8_BAR;
        PG8_WAIT_V(2); PG8_BAR;
        PG8_STAGE(PG8_SB(1, 0), cB + kstep, voffB); PG8_STAGE(PG8_SA(1, 0), cA + kstep, voffA); PG8_STAGE(PG8_SB(1, 1), cB + hstep + kstep, voffB);
        PG8_WAIT_V(6); PG8_BAR;
    } else {
        PG8_STAGE(PG8_SB(0, 0), cB, voffB); PG8_STAGE(PG8_SA(0, 0), cA, voffA); PG8_STAGE(PG8_SB(0, 1), cB + hstep, voffB); PG8_STAGE(PG8_SA(0, 1), cA + hstep, voffA);
        if (wr == 1) PG8_BAR;
        PG8_WAIT_V(4); PG8_BAR;
        PG8_STAGE(PG8_SB(1, 0), cB + kstep, voffB); PG8_STAGE(PG8_SA(1, 0), cA + kstep, voffA); PG8_STAGE(PG8_SB(1, 1), cB + hstep + kstep, voffB);
        PG8_WAIT_V(6); PG8_BAR;
    }
    for (;;) {
        const bool has_next = S.next(ui + 1, nxt);
        const char* nA = has_next ? (const char*)g.A + (size_t)nxt.pm * tstep : cA; const char* nB = has_next ? (const char*)g.Bt + (size_t)nxt.pn * tstep : cB;
        for (int t = 0; t < nt; t += 2) {
            const bool last = (t == nt - 2);
            const char* a1 = cA + (size_t)(t + 1) * kstep;
            const char* a2 = last ? nA : cA + (size_t)(t + 2) * kstep; const char* b2 = last ? nB : cB + (size_t)(t + 2) * kstep;
            const char* a3 = a2 + kstep; const char* b3 = b2 + kstep;
            if (last && has_next) S.a_ready(nxt);
            if constexpr (SP2) {
            PG8_LDB(B0, 0, 0); PG8_LDB(B1, 0, 1); PG8_SCHED; PG8_LDA(At, 0, 0); PG8_STAGE(PG8_SA(1, 1), a1 + hstep, voffA);
            PG8_WAIT_V(8); PG8_WAIT_L(0); PG8_BAR; PG8_MMA(0, 0, At, B0); PG8_MMA(0, 1, At, B1); PG8_BAR; PG8_SCHED;
            PG8_LDA(At, 0, 1); PG8_STAGE(PG8_SB(0, 0), b2, voffB); PG8_STAGE(PG8_SB(0, 1), b2 + hstep, voffB); PG8_STAGE(PG8_SA(0, 0), a2, voffA);
            PG8_WAIT_V(8); PG8_WAIT_L(0); PG8_BAR; PG8_MMA(1, 0, At, B0); PG8_MMA(1, 1, At, B1); PG8_BAR; PG8_SCHED;
            PG8_LDB(B0, 1, 0); PG8_LDB(B1, 1, 1); PG8_SCHED; PG8_LDA(At, 1, 0); PG8_STAGE(PG8_SA(0, 1), a2 + hstep, voffA);
            PG8_WAIT_V(8); PG8_WAIT_L(0); PG8_BAR; PG8_MMA(0, 0, At, B0); PG8_MMA(0, 1, At, B1); PG8_BAR; PG8_SCHED;
            PG8_LDA(At, 1, 1); PG8_STAGE(PG8_SB(1, 0), b3, voffB); PG8_STAGE(PG8_SB(1, 1), b3 + hstep, voffB); PG8_STAGE(PG8_SA(1, 0), a3, voffA);
            PG8_WAIT_V(8); PG8_WAIT_L(0); PG8_BAR; PG8_MMA(1, 0, At, B0); PG8_MMA(1, 1, At, B1); PG8_BAR; PG8_SCHED;
            } else {
            PG8_LDB(B0, 0, 0); PG8_SCHED; PG8_LDA(At, 0, 0); PG8_STAGE(PG8_SA(1, 1), a1 + hstep, voffA);
            PG8_WAIT_L(8); PG8_BAR; PG8_WAIT_L(0); PG8_MMA(0, 0, At, B0); PG8_BAR; PG8_SCHED;
            PG8_LDB(B1, 0, 1); PG8_STAGE(PG8_SB(0, 0), b2, voffB);
            PG8_BAR; PG8_WAIT_L(0); PG8_MMA(0, 1, At, B1); PG8_BAR;
            PG8_LDA(At, 0, 1); PG8_STAGE(PG8_SA(0, 0), a2, voffA);
            PG8_BAR; PG8_WAIT_L(0); PG8_MMA(1, 0, At, B0); PG8_BAR; PG8_SCHED;
            PG8_STAGE(PG8_SB(0, 1), b2 + hstep, voffB);
            PG8_WAIT_V(6); PG8_BAR; PG8_MMA(1, 1, At, B1); PG8_BAR;
            PG8_LDB(B0, 1, 0); PG8_SCHED; PG8_LDA(At, 1, 0); PG8_STAGE(PG8_SA(0, 1), a2 + hstep, voffA);
            PG8_WAIT_L(8); PG8_BAR; PG8_WAIT_L(0); PG8_MMA(0, 0, At, B0); PG8_BAR; PG8_SCHED;
            PG8_LDB(B1, 1, 1); PG8_STAGE(PG8_SB(1, 0), b3, voffB);
            PG8_BAR; PG8_WAIT_L(0); PG8_MMA(0, 1, At, B1); PG8_BAR;
            PG8_LDA(At, 1, 1); PG8_STAGE(PG8_SA(1, 0), a3, voffA);
            PG8_BAR; PG8_WAIT_L(0); PG8_MMA(1, 0, At, B0); PG8_BAR; PG8_SCHED;
            PG8_STAGE(PG8_SB(1, 1), b3 + hstep, voffB);
            PG8_WAIT_V(6); PG8_BAR; PG8_MMA(1, 1, At, B1); PG8_BAR;
            }
        }
        if constexpr (ALIGN_EPI) { if (wr == 0) PG8_BAR; }
        if constexpr (!Epi::AFTER_DRAIN) { E(acc, cur, wr, wc, fr, fq); S.done(cur); }
        if (!has_next) break;
#pragma unroll
        for (int a = 0; a < 2; ++a)
#pragma unroll
            for (int b = 0; b < 2; ++b)
#pragma unroll
                for (int m = 0; m < 4; ++m)
#pragma unroll
                    for (int n = 0; n < 2; ++n) acc[a][b][m][n] = (f32x4){0.f, 0.f, 0.f, 0.f};
        cur = nxt; cA = nA; cB = nB; ++ui;
        if constexpr (ALIGN_EPI) { if (wr == 1) PG8_BAR; }
    }
    PG8_WAIT_V(0);
    if constexpr (!ALIGN_EPI) { if (wr == 0) PG8_BAR; }
    PG8_BAR;
    if constexpr (Epi::AFTER_DRAIN) { E.fused(acc, cur, wr, wc, fr, fq, lds, wid, lane); S.done(cur); }
#undef PG8_SA
#undef PG8_SB
#undef PG8_STAGE
#undef PG8_LDA
#undef PG8_LDB
#undef PG8_MMA
#undef PG8_WAIT_V
#undef PG8_WAIT_L
#undef PG8_BAR
#undef PG8_SCHED
}
}
#include <hip/hip_bf16.h>
#include <cmath>
namespace attn_body {
using bf16=__hip_bfloat16;
using bf16x8=__attribute__((ext_vector_type(8)))short;
using s16x4=__attribute__((ext_vector_type(4)))short;
using f32x16=__attribute__((ext_vector_type(16)))float;
using u32x4=__attribute__((ext_vector_type(4)))unsigned;
using f32x4b=__attribute__((ext_vector_type(4)))float;
constexpr int BATCH=16,NHEAD=8,SEQ=2048,D=64,PQ=3584,PO=1024;
constexpr int NW=8,QBLK=32,QB=QBLK*NW,KVBLK=64,NQB=SEQ/QB;
constexpr int ATTN_UNIT_ROWS=QB;
__device__ __forceinline__ int crow(int r,int hi){return (r&3)+8*(r>>2)+4*hi;}
#define SBAR() __builtin_amdgcn_sched_barrier(0)
__device__ __forceinline__ void cmask(f32x16&p0,f32x16&p1,int jb,int qrel,int hi){
  const float NEG=-INFINITY; int kb=64*jb+4*hi;
  #pragma unroll
  for(int r=0;r<16;++r){int kv=kb+(r&3)+8*(r>>2); if(kv>qrel)p0[r]=NEG; if(kv+32>qrel)p1[r]=NEG;}
}

constexpr int NSLOT=3, SLOTB=8192;
constexpr int LDS_K=0, LDS_V=NSLOT*SLOTB, LDS_WS=2*NSLOT*SLOTB, LDS_OST=LDS_WS+NW*64*4, LDS_BIAS=LDS_OST+NW*4096, LDS_BYTES=LDS_BIAS+SEQ*4;
constexpr float C2=0.125f*1.4426950408889634f;
__device__ __forceinline__ void glds16(const void*gsrc,unsigned lds_dst){unsigned keep;
  asm volatile("s_mov_b32 %0, m0\n\ts_mov_b32 m0, %2\n\ts_nop 0\n\tglobal_load_lds_dwordx4 %1, off\n\ts_mov_b32 m0, %0":"=&s"(keep):"v"(gsrc),"s"(lds_dst):"memory");}
__device__ __forceinline__ float max3f(float a,float b,float c){float r;asm("v_max3_f32 %0, %1, %2, %3":"=v"(r):"v"(a),"v"(b),"v"(c));return r;}
__device__ __forceinline__ float max2f(float a,float b){float r;asm("v_max_f32_e32 %0, %1, %2":"=v"(r):"v"(a),"v"(b));return r;}
__device__ __forceinline__ float fadd_s(float a,float b){float r;asm("v_add_f32_e32 %0, %1, %2":"=v"(r):"v"(a),"v"(b));return r;}
__device__ __forceinline__ float fsub_s(float a,float b){float r;asm("v_sub_f32_e32 %0, %1, %2":"=v"(r):"v"(a),"v"(b));return r;}
typedef float f32x2_t __attribute__((ext_vector_type(2))); typedef __bf16 bf16x2_t __attribute__((ext_vector_type(2)));
__device__ __forceinline__ unsigned cvtpk_s(float lo,float hi){f32x2_t v={lo,hi};bf16x2_t b=__builtin_convertvector(v,bf16x2_t);return __builtin_bit_cast(unsigned,b);}
#define WAIT_BAR(N) asm volatile("s_waitcnt vmcnt(" #N ") lgkmcnt(0)\n\ts_barrier":::"memory")

__device__ __forceinline__ void qkt(f32x16&p0,f32x16&p1,const char*Kslot,const bf16x8*qr,const f32x16&negm,int r32,int hi){
  const char*kb=Kslot+hi*1024+r32*16;
  #pragma unroll
  for(int d0=0;d0<4;++d0){
    const bf16x8 b0=*reinterpret_cast<const bf16x8*>(kb+d0*2048);
    const bf16x8 b1=*reinterpret_cast<const bf16x8*>(kb+d0*2048+512);
    if(d0==0){p0=__builtin_amdgcn_mfma_f32_32x32x16_bf16(b0,qr[0],negm,0,0,0);p1=__builtin_amdgcn_mfma_f32_32x32x16_bf16(b1,qr[0],negm,0,0,0);}
    else{p0=__builtin_amdgcn_mfma_f32_32x32x16_bf16(b0,qr[d0],p0,0,0,0);p1=__builtin_amdgcn_mfma_f32_32x32x16_bf16(b1,qr[d0],p1,0,0,0);}}
}
typedef __attribute__((address_space(3))) const char* lds_cptr;
typedef short v4i16_t __attribute__((ext_vector_type(4)));
__device__ __forceinline__ void kload8(bf16x8*kf,lds_cptr kp){
  kf[0]=*(const __attribute__((address_space(3))) bf16x8*)(kp);      kf[1]=*(const __attribute__((address_space(3))) bf16x8*)(kp+512);
  kf[2]=*(const __attribute__((address_space(3))) bf16x8*)(kp+2048); kf[3]=*(const __attribute__((address_space(3))) bf16x8*)(kp+2560);
  kf[4]=*(const __attribute__((address_space(3))) bf16x8*)(kp+4096); kf[5]=*(const __attribute__((address_space(3))) bf16x8*)(kp+4608);
  kf[6]=*(const __attribute__((address_space(3))) bf16x8*)(kp+6144); kf[7]=*(const __attribute__((address_space(3))) bf16x8*)(kp+6656);
}
__device__ __forceinline__ void kload2(bf16x8*kf,lds_cptr kp,int j){ kf[2*j]=*(const __attribute__((address_space(3))) bf16x8*)(kp+j*2048); kf[2*j+1]=*(const __attribute__((address_space(3))) bf16x8*)(kp+j*2048+512); }
__device__ __forceinline__ s16x4 vtr(lds_cptr p){ return __builtin_bit_cast(s16x4,__builtin_amdgcn_ds_read_tr16_b64_v4i16((__attribute__((address_space(3))) v4i16_t*)p)); }
__device__ __forceinline__ float rowmax(const f32x16&p0,const f32x16&p1){
  float a=max3f(p0[0],p0[1],p1[0]),b=max3f(p0[2],p0[3],p1[1]);a=max3f(a,p1[2],p1[3]);
  #pragma unroll
  for(int r=4;r<16;r+=4){a=max3f(a,p0[r],p0[r+1]);b=max3f(b,p0[r+2],p0[r+3]);a=max3f(a,p1[r],p1[r+1]);b=max3f(b,p1[r+2],p1[r+3]);}
  const float m=max2f(a,b);
  auto rr=__builtin_amdgcn_permlane32_swap(__float_as_uint(m),__float_as_uint(m),false,false);
  return max2f(__uint_as_float(rr[0]),__uint_as_float(rr[1]));
}
__device__ __forceinline__ void pv(f32x16*o,int vb,bf16x8 pa0,bf16x8 pa1,bf16x8 pa2,bf16x8 pa3){
  #pragma unroll
  for(int d0=0;d0<2;++d0){s16x4 lo[4],hi[4];
    #pragma unroll
    for(int ks=0;ks<4;++ks){
      asm volatile("ds_read_b64_tr_b16 %0,%1 offset:%c2":"=&v"(lo[ks]):"v"(vb),"i"(d0*4096+ks*1024):"memory");
      asm volatile("ds_read_b64_tr_b16 %0,%1 offset:%c2":"=&v"(hi[ks]):"v"(vb),"i"(d0*4096+ks*1024+512):"memory");}
    asm volatile("s_waitcnt lgkmcnt(0)":::"memory");SBAR();
    #define PK(k) (bf16x8){lo[k][0],lo[k][1],lo[k][2],lo[k][3],hi[k][0],hi[k][1],hi[k][2],hi[k][3]}
    o[d0]=__builtin_amdgcn_mfma_f32_32x32x16_bf16(pa0,PK(0),o[d0],0,0,0);
    o[d0]=__builtin_amdgcn_mfma_f32_32x32x16_bf16(pa1,PK(1),o[d0],0,0,0);
    o[d0]=__builtin_amdgcn_mfma_f32_32x32x16_bf16(pa2,PK(2),o[d0],0,0,0);
    o[d0]=__builtin_amdgcn_mfma_f32_32x32x16_bf16(pa3,PK(3),o[d0],0,0,0);
    #undef PK
  }
}

#ifndef ATTN_STORE16
#define ATTN_STORE16(p,v) (*(u32x4*)(p)=(v))
#endif
template<int THRL> __device__ __forceinline__ void attn_unit(int b,int h,int qb,const bf16*Q,const bf16*__restrict__ K,const bf16*__restrict__ V,bf16*O,const float*__restrict__ CB,char*shm){
  const int tid=tid_fresh(),lane=tid&63,r32=lane&31,hi=lane>>5; const int wid=__builtin_amdgcn_readfirstlane(tid>>6);
  const long rowbase=(long)b*SEQ; const int q0=qb*QB;
  const bf16*Qw=Q+(rowbase+q0+wid*QBLK)*PQ+h*D;
  const bf16*Kh=K+rowbase*PQ+h*D,*Vh=V+rowbase*PQ+h*D;
  const unsigned lds0=(unsigned)(uintptr_t)shm;
  float*wsf=(float*)(shm+LDS_WS)+wid*64;
  const bf16*ksrc=Kh+(long)lane*PQ+wid*8;
  const bf16*vsrc=Vh+(long)(16*(wid&3)+(lane>>2))*PQ+(wid>>2)*32+(lane&3)*8;
  const unsigned kdst=lds0+LDS_K+wid*1024, vdst=lds0+LDS_V+wid*1024;
  #define DMA_K(t,slot) glds16(ksrc+(long)(t)*KVBLK*PQ,(unsigned)__builtin_amdgcn_readfirstlane(kdst+(slot)))
  #define DMA_V(t,slot) glds16(vsrc+(long)(t)*KVBLK*PQ,(unsigned)__builtin_amdgcn_readfirstlane(vdst+(slot)))
  const int vb0=(int)(lds0+LDS_V)+((lane>>4)&1)*32+(lane&3)*8+(4*hi+((lane&15)>>2))*64;
  const char*Kbase=shm+LDS_K; bf16x8 kf[8];
  const lds_cptr shm3=(lds_cptr)shm; const lds_cptr kp0=shm3+LDS_K+hi*1024+r32*16; const lds_cptr vp0=shm3+LDS_V+((lane>>4)&1)*32+(lane&3)*8+(4*hi+((lane&15)>>2))*64;
  const int NT=(q0+QB)/KVBLK;
  { const float*cb=CB+(long)(b*NHEAD+h)*SEQ; float*bl=(float*)(shm+LDS_BIAS); for(int i=tid;i<NT*KVBLK;i+=NW*64)bl[i]=cb[i]*(-1.4426950408889634f); }
  const lds_cptr bp0=(lds_cptr)shm+LDS_BIAS+hi*16;
  #define KBIAS(P0,P1,t) do{ const lds_cptr bp_=bp0+(t)*256; _Pragma("unroll") for(int g_=0;g_<4;++g_){ const f32x4b a_=*(const __attribute__((address_space(3))) f32x4b*)(bp_+g_*32); const f32x4b c_=*(const __attribute__((address_space(3))) f32x4b*)(bp_+128+g_*32); \
      P0[4*g_]+=a_[0];P0[4*g_+1]+=a_[1];P0[4*g_+2]+=a_[2];P0[4*g_+3]+=a_[3]; P1[4*g_]+=c_[0];P1[4*g_+1]+=c_[1];P1[4*g_+2]+=c_[2];P1[4*g_+3]+=c_[3]; } }while(0)
  DMA_K(0,0);DMA_V(0,0);DMA_K(1,SLOTB);
  bf16x8 qr[4];
  #pragma unroll
  for(int d0=0;d0<4;++d0)qr[d0]=*reinterpret_cast<const bf16x8*>(&Qw[(long)r32*PQ+d0*16+hi*8]);
  float mhat=0.f,l_reg=0.f;f32x16 o[2];o[0]=f32x16{};o[1]=f32x16{};f32x16 negm=f32x16{};asm volatile("":"+v"(negm));
  const int qrel=wid*QBLK+r32;
  #define CMASK(P0,P1,t) do{int jb_=(t)-(NT-4); if(jb_>=0)cmask(P0,P1,jb_,qrel,hi);}while(0)
  bool resc=false;
  #define START(P0,P1) do{ const float rm=rowmax(P0,P1); resc=false; \
    { const float dl=rm; mhat=fadd_s(mhat,dl); \
      _Pragma("unroll") for(int r=0;r<16;++r){P0[r]=fsub_s(P0[r],dl);P1[r]=fsub_s(P1[r],dl);} \
      _Pragma("unroll") for(int r=0;r<16;++r)negm[r]=-mhat; asm volatile("":"+v"(negm)); } \
    _Pragma("unroll") for(int r=0;r<16;++r)P0[r]=__builtin_amdgcn_exp2f(P0[r]); }while(0)
  #define RESC() do{ if(resc){ asm volatile("s_waitcnt lgkmcnt(0)":::"memory"); \
      _Pragma("unroll") for(int d_=0;d_<2;++d_) _Pragma("unroll") for(int r=0;r<16;++r)o[d_][r]*=wsf[crow(r,hi)]; } }while(0)
  f32x16 pA0,pA1,pB0,pB1;
  int sl_prev=0,sl_cur=0,sl_next=SLOTB;
  #define ROT() do{sl_prev=sl_cur;sl_cur=sl_next;sl_next=(sl_next==(NSLOT-1)*SLOTB)?0:sl_next+SLOTB;}while(0)
  DMA_K(2,2*SLOTB);
  WAIT_BAR(3);
  qkt(pA0,pA1,Kbase,qr,negm,r32,hi);KBIAS(pA0,pA1,0);asm volatile("s_nop 15\n\ts_nop 7":"+v"(pA0),"+v"(pA1));CMASK(pA0,pA1,0);
  START(pA0,pA1);
  _Pragma("unroll") for(int r=0;r<16;++r)pA1[r]=__builtin_amdgcn_exp2f(pA1[r]);
  WAIT_BAR(0);
  DMA_K(3,0);DMA_V(1,SLOTB);
  ROT();
  kload8(kf,kp0+sl_cur);
  WAIT_BAR(2);
  s16x4 vlo[8],vhi[8]; u32x4 pw0,pw1,pw2,pw3;
  #define PKW(P,B) cvtpk_s(P[B],P[B+1])
  #define PAF(k) __builtin_bit_cast(bf16x8,pw##k)
  #define VFR(i) (bf16x8){vlo[i][0],vlo[i][1],vlo[i][2],vlo[i][3],vhi[i][0],vhi[i][1],vhi[i][2],vhi[i][3]}
  #define PIN(x) asm volatile("":"+v"(x))
  #define MX3(a,b,c) __builtin_fmaxf(__builtin_fmaxf((a),(b)),(c))
  #define GAPA(MF,A0,A1,A2,A3,W0,W1,PW) do{ MF; sacc+=A0; sacc+=A1; sacc+=A2; sacc+=A3; PIN(sacc); W0; W1; PIN(PW); SBAR(); }while(0)
  #define EX(v) __builtin_amdgcn_exp2f(v)
  #define GAPB(MF,X,B) do{ MF; X[B]=EX(X[B]); X[B+1]=EX(X[B+1]); X[B+2]=EX(X[B+2]); X[B+3]=EX(X[B+3]); PIN(X); SBAR(); }while(0)
  #define VRD(i) do{ vlo[i]=vtr(vp_+(((i)>>2)*4096+((i)&3)*1024)); vhi[i]=vtr(vp_+(((i)>>2)*4096+((i)&3)*1024+512)); }while(0)
  #define KRD(G,j) do{ if(G){ kload2(kf,kp0+sl_next,j); SBAR(); } }while(0)
  #define STEP(C0,C1,P0,P1,t,GK,GV,GL) do{ SBAR(); \
    const lds_cptr vp_=vp0+sl_prev; \
    VRD(0); SBAR(); float sacc=(P0[0]+P0[1]); \
    GAPA(C0=__builtin_amdgcn_mfma_f32_32x32x16_bf16(kf[0],qr[0],negm,0,0,0), P0[2],P0[3],P0[4],P0[5],     pw0[0]=PKW(P0,0), pw0[1]=PKW(P0,2), pw0); \
    VRD(4); SBAR(); GAPA(C1=__builtin_amdgcn_mfma_f32_32x32x16_bf16(kf[1],qr[0],negm,0,0,0), P0[6],P0[7],P0[8],P0[9],     pw0[2]=PKW(P0,4), pw0[3]=PKW(P0,6), pw0); \
    VRD(1); SBAR(); GAPA(C0=__builtin_amdgcn_mfma_f32_32x32x16_bf16(kf[2],qr[1],C0,0,0,0),   P0[10],P0[11],P0[12],P0[13], pw1[0]=PKW(P0,8), pw1[1]=PKW(P0,10), pw1); \
    VRD(5); SBAR(); GAPA(C1=__builtin_amdgcn_mfma_f32_32x32x16_bf16(kf[3],qr[1],C1,0,0,0),   P0[14],P0[15],P1[0],P1[1],   pw1[2]=PKW(P0,12),pw1[3]=PKW(P0,14), pw1); \
    VRD(2); SBAR(); GAPA(C0=__builtin_amdgcn_mfma_f32_32x32x16_bf16(kf[4],qr[2],C0,0,0,0),   P1[2],P1[3],P1[4],P1[5],     pw2[0]=PKW(P1,0), pw2[1]=PKW(P1,2), pw2); \
    VRD(6); SBAR(); GAPA(C1=__builtin_amdgcn_mfma_f32_32x32x16_bf16(kf[5],qr[2],C1,0,0,0),   P1[6],P1[7],P1[8],P1[9],     pw2[2]=PKW(P1,4), pw2[3]=PKW(P1,6), pw2); \
    VRD(3); SBAR(); GAPA(C0=__builtin_amdgcn_mfma_f32_32x32x16_bf16(kf[6],qr[3],C0,0,0,0),   P1[10],P1[11],P1[12],P1[13], pw3[0]=PKW(P1,8), pw3[1]=PKW(P1,10), pw3); \
    VRD(7); SBAR(); GAPA(C1=__builtin_amdgcn_mfma_f32_32x32x16_bf16(kf[7],qr[3],C1,0,0,0),   P1[14],P1[15],0.f,0.f,       pw3[2]=PKW(P1,12),pw3[3]=PKW(P1,14), pw3); \
    l_reg+=sacc; \
    if(GK){DMA_K((t)+3,sl_cur);} if(GV){DMA_V((t)+1,sl_next);} \
    KBIAS(C0,C1,t); CMASK(C0,C1,t); \
    { float a=MX3(C0[0],C0[1],C1[0]),b=MX3(C0[2],C0[3],C1[1]); a=MX3(a,C1[2],C1[3]); \
      _Pragma("unroll") for(int r=4;r<16;r+=4){a=MX3(a,C0[r],C0[r+1]);b=MX3(b,C0[r+2],C0[r+3]);a=MX3(a,C1[r],C1[r+1]);b=MX3(b,C1[r+2],C1[r+3]);} \
      float rm=__builtin_fmaxf(a,b); { auto rr=__builtin_amdgcn_permlane32_swap(__float_as_uint(rm),__float_as_uint(rm),false,false); rm=__builtin_fmaxf(__uint_as_float(rr[0]),__uint_as_float(rr[1])); } \
      resc=false; \
      if(__builtin_expect(__any(rm>(float)THRL),0)){ const float dl=__builtin_fmaxf(rm,0.f); mhat+=dl; \
        _Pragma("unroll") for(int r=0;r<16;++r){C0[r]-=dl;C1[r]-=dl;} \
        _Pragma("unroll") for(int r=0;r<16;++r)negm[r]=-mhat; asm volatile("":"+v"(negm)); \
        const float f=__builtin_amdgcn_exp2f(-dl); l_reg*=f; if(hi==0)wsf[r32]=f; resc=true; } } \
    SBAR(); \
    GAPB(o[0]=__builtin_amdgcn_mfma_f32_32x32x16_bf16(PAF(0),VFR(0),o[0],0,0,0), C0,0); \
    GAPB(o[1]=__builtin_amdgcn_mfma_f32_32x32x16_bf16(PAF(0),VFR(4),o[1],0,0,0), C0,4); \
    KRD(GL,0); GAPB(o[0]=__builtin_amdgcn_mfma_f32_32x32x16_bf16(PAF(1),VFR(1),o[0],0,0,0), C0,8); \
    KRD(GL,1); GAPB(o[1]=__builtin_amdgcn_mfma_f32_32x32x16_bf16(PAF(1),VFR(5),o[1],0,0,0), C0,12); \
    KRD(GL,2); GAPB(o[0]=__builtin_amdgcn_mfma_f32_32x32x16_bf16(PAF(2),VFR(2),o[0],0,0,0), C1,0); \
    KRD(GL,3); GAPB(o[1]=__builtin_amdgcn_mfma_f32_32x32x16_bf16(PAF(2),VFR(6),o[1],0,0,0), C1,4); \
    GAPB(o[0]=__builtin_amdgcn_mfma_f32_32x32x16_bf16(PAF(3),VFR(3),o[0],0,0,0), C1,8); \
    GAPB(o[1]=__builtin_amdgcn_mfma_f32_32x32x16_bf16(PAF(3),VFR(7),o[1],0,0,0), C1,12); \
    }while(0)
  int t=1;
  #undef CMASK
  #define CMASK(P0,P1,t) do{}while(0)
  for(;t+5<NT;t+=2){
    STEP(pB0,pB1,pA0,pA1,t,true,true,true);     WAIT_BAR(2); RESC(); ROT();
    STEP(pA0,pA1,pB0,pB1,t+1,true,true,true);   WAIT_BAR(2); RESC(); ROT();
  }
  #undef CMASK
  #define CMASK(P0,P1,t) do{int jb_=(t)-(NT-4); if(jb_>=0)cmask(P0,P1,jb_,qrel,hi);}while(0)
  #define ENDW(tt) do{ if((tt)+3<NT){WAIT_BAR(2);} else if((tt)+2<NT){WAIT_BAR(1);} else {WAIT_BAR(0);} }while(0)
  for(;t+1<NT;t+=2){
    STEP(pB0,pB1,pA0,pA1,t,(t+3<NT),(t+1<NT),(t+1<NT));       ENDW(t);   RESC(); ROT();
    STEP(pA0,pA1,pB0,pB1,t+1,(t+4<NT),(t+2<NT),(t+2<NT));     ENDW(t+1); RESC(); ROT();
  }
  STEP(pB0,pB1,pA0,pA1,NT-1,false,false,false); RESC();
  { float sacc=pB0[0]+pB0[1]; _Pragma("unroll") for(int r=2;r<16;++r)sacc+=pB0[r]; _Pragma("unroll") for(int r=0;r<16;++r)sacc+=pB1[r]; l_reg+=sacc;
    pw0=(u32x4){PKW(pB0,0),PKW(pB0,2),PKW(pB0,4),PKW(pB0,6)};pw1=(u32x4){PKW(pB0,8),PKW(pB0,10),PKW(pB0,12),PKW(pB0,14)};pw2=(u32x4){PKW(pB1,0),PKW(pB1,2),PKW(pB1,4),PKW(pB1,6)};pw3=(u32x4){PKW(pB1,8),PKW(pB1,10),PKW(pB1,12),PKW(pB1,14)};
    SBAR(); pv(o,vb0+sl_cur,PAF(0),PAF(1),PAF(2),PAF(3)); }
  #undef PKW
  #undef PAF
  #undef VFR
  #undef PIN
  #undef MX3
  #undef GAPA
  #undef GAPB
  #undef EX
  #undef VRD
  #undef KRD
  #undef STEP
  #undef ENDW
  {auto rr=__builtin_amdgcn_permlane32_swap(__float_as_uint(l_reg),__float_as_uint(l_reg),false,false);l_reg=__uint_as_float(rr[0])+__uint_as_float(rr[1]);}
  if(hi==0)wsf[32+r32]=l_reg;asm volatile("s_waitcnt lgkmcnt(0)":::"memory");
  float rli[16];
  #pragma unroll
  for(int r=0;r<16;++r)rli[r]=__builtin_amdgcn_rcpf(wsf[32+crow(r,hi)]);
  bf16*Ow=O+(rowbase+q0+wid*QBLK)*PO+h*D;
  { bf16*stg=(bf16*)(shm+LDS_OST)+wid*2048;
    #pragma unroll
    for(int r=0;r<16;++r){const int orow=crow(r,hi);
      #pragma unroll
      for(int d0=0;d0<2;++d0)stg[orow*64+d0*32+r32]=__float2bfloat16(o[d0][r]*rli[r]);}
    asm volatile("s_waitcnt lgkmcnt(0)":::"memory");
    #pragma unroll
    for(int i=0;i<4;++i){const int row=i*8+(lane>>3),ch=lane&7; const u32x4 v=*(const u32x4*)(stg+row*64+ch*8); ATTN_STORE16(Ow+(long)row*PO+ch*8,v);} }
  asm volatile("s_waitcnt lgkmcnt(0)\n\ts_barrier":::"memory");
  #undef KBIAS
  #undef DMA_K
  #undef DMA_V
  #undef CMASK
  #undef START
  #undef RESC
  #undef ROT
}
constexpr int ATTN_LDS_BYTES=LDS_BYTES;
#undef SBAR
#undef WAIT_BAR
}
#define LAS __attribute__((address_space(3)))
typedef unsigned short bf16;
typedef unsigned u32x4 __attribute__((ext_vector_type(4)));
typedef unsigned u32x2 __attribute__((ext_vector_type(2)));
typedef float f32x4 __attribute__((ext_vector_type(4)));
typedef float f32x2 __attribute__((ext_vector_type(2)));
typedef float f32x16 __attribute__((ext_vector_type(16)));
typedef short bf16x8 __attribute__((ext_vector_type(8)));
#define RLX_AGENT __ATOMIC_RELAXED, __HIP_MEMORY_SCOPE_AGENT
constexpr int NWAVES = 8, NTHR = 512;
constexpr int LDS_BYTES = 147456, MISC_OFF = 131072 + 8192;
constexpr float LOG2E = 1.4426950408889634f;
__device__ __forceinline__ unsigned pk2(float lo, float hi) { return pg8::cvt_pk_bf16(lo, hi); }
__device__ __forceinline__ float bf2f(unsigned u16) { return __uint_as_float(u16 << 16); }
__device__ __forceinline__ int crow(int r, int hi) { return (r & 3) + 8 * (r >> 2) + 4 * hi; }
__device__ __forceinline__ float wave_sum(float v) {
#pragma unroll
    for (int o = 1; o < 64; o <<= 1) v += __shfl_xor(v, o);
    return v;
}
__device__ __forceinline__ void sincos_cw(float x, float& s, float& c) {
    const float k = rintf(x * 0.636619772367581343f);
    float r = fmaf(k, -1.5703125f, x); r = fmaf(k, -4.837512969970703125e-4f, r); r = fmaf(k, -7.54978995489188216e-8f, r);
    const float z = r * r;
    const float sp = r + r * z * (-1.6666654611e-1f + z * (8.3321608736e-3f + z * -1.9515295891e-4f));
    const float cp = 1.0f - 0.5f * z + z * z * (4.166664568298827e-2f + z * (-1.388731625493765e-3f + z * 2.443315711809948e-5f));
    const int q = ((int)k) & 3;
    s = (q == 0) ? sp : (q == 1) ? cp : (q == 2) ? -sp : -cp;
    c = (q == 0) ? cp : (q == 1) ? -sp : (q == 2) ? -cp : sp;
}
__device__ __forceinline__ float block_scan(float v, float& tot, LAS float* scr, int lane, int wid) {
#pragma unroll
    for (int o = 1; o < 64; o <<= 1) { const float n = __shfl_up(v, o); if (lane >= o) v += n; }
    if (lane == 63) scr[wid] = v;
    __syncthreads();
    float off = 0.f; tot = 0.f;
#pragma unroll
    for (int w = 0; w < NWAVES; ++w) { const float x = scr[w]; if (w < wid) off += x; tot += x; }
    __syncthreads();
    return v + off;
}

template <int MODE> __device__ __forceinline__ int rowmap(int n) {
    if (MODE == 1) return n < 1024 ? ((n & ~127) | ((n & 63) << 1) | ((n >> 6) & 1)) : n;
    if (MODE == 2) return 2 * n;
    if (MODE == 3) return 2 * n + 1;
    return n;
}
template <int MODE> __device__ __forceinline__ void p0_transpose_item(const float* W, int ldw, int K, int N, const float* ks, bf16* WT, LAS float* scr, int item, int lane) {
    const int nblk = N / 32, kb = item / nblk, nb = item % nblk, k0 = 64 * kb, n0 = 32 * nb;
#pragma unroll
    for (int i = 0; i < 32; ++i) { const int kk = 2 * i + (lane >> 5); float w = W[(size_t)(k0 + kk) * ldw + n0 + (lane & 31)]; if (ks) w *= ks[k0 + kk]; scr[kk * 33 + (lane & 31)] = w; }
    asm volatile("s_waitcnt lgkmcnt(0)" ::: "memory");
    const int c = lane & 7;
#pragma unroll
    for (int j = 0; j < 4; ++j) { const int n = (lane >> 3) + 8 * j; const LAS float* s = scr + (8 * c) * 33 + n;
        u32x4 o; o.x = pk2(s[0 * 33], s[1 * 33]); o.y = pk2(s[2 * 33], s[3 * 33]); o.z = pk2(s[4 * 33], s[5 * 33]); o.w = pk2(s[6 * 33], s[7 * 33]);
        *(u32x4*)(WT + (size_t)rowmap<MODE>(n0 + n) * K + k0 + 8 * c) = o; }
    asm volatile("s_waitcnt lgkmcnt(0)" ::: "memory");
}
__device__ __forceinline__ void p0_prep(const Params& p, LAS unsigned char* lds, int vcu, int G) {
    const int tid = tid_fresh(), lane = tid & 63, wid = __builtin_amdgcn_readfirstlane(tid >> 6);
    unsigned char* ws = p.ws;
    for (int i = blockIdx.x * NTHR + tid; i < (int)(CTL_BYTES / 4); i += G * NTHR) if (i < 4096 || i >= 4096 + 3456) ((unsigned*)(ws + WS_CTL))[i] = 0u;
    { float* cs = (float*)(ws + WS_CS);
      for (int i = blockIdx.x * NTHR + tid; i < (TSEQ + NSMP) * 64; i += G * NTHR) { const int tix = i >> 6, d = i & 63; const float pos = (float)(tix < TSEQ ? tix : PAST + tix - TSEQ);
          const float inv = exp2f((float)d * (-13.287712379549449f / 64.0f)); float s, c; sincos_cw(pos * inv, s, c); cs[2 * i] = c; cs[2 * i + 1] = s; } }
    LAS float* scr = (LAS float*)(lds + wid * 16384);
    const int gw = vcu * NWAVES + wid, NGW = G * NWAVES;
    constexpr int I_IN = (DM / 64) * (NZ / 32), I_O = (DM / 64) * (DM / 32), I_G = (DM / 64) * (DFF / 32), I_D = (DFF / 64) * (DM / 32);
#ifndef REP_P0T
#define REP_P0T 1
#endif
    for (int rept = 0; rept < REP_P0T; ++rept)
    for (int it = gw; it < I_IN + I_O + 2 * I_G + I_D; it += NGW) {
        int r = it;
        if (r < I_IN) { p0_transpose_item<1>(p.win, DIN, DM, NZ, nullptr, (bf16*)(ws + WS_WIN), scr, r, lane); continue; } r -= I_IN;
        if (r < I_O) { p0_transpose_item<0>(p.wout, DM, DM, DM, nullptr, (bf16*)(ws + WS_WO), scr, r, lane); continue; } r -= I_O;
        if (r < I_G) { p0_transpose_item<2>(p.wg, DFF, DM, DFF, p.gffn, (bf16*)(ws + WS_WGU), scr, r, lane); continue; } r -= I_G;
        if (r < I_G) { p0_transpose_item<3>(p.wu, DFF, DM, DFF, p.gffn, (bf16*)(ws + WS_WGU), scr, r, lane); continue; } r -= I_G;
        p0_transpose_item<0>(p.wd, DM, DFF, DM, nullptr, (bf16*)(ws + WS_WD), scr, r, lane);
    }
    __syncthreads();
    LAS f32x4* wl = (LAS f32x4*)lds;
    for (int i = tid; i < 2048; i += NTHR) { const int ln = i & 63, q = i >> 6, half = q & 1, e = (q >> 1) & 3, j = q >> 3;
        wl[i] = *(const f32x4*)(p.win + (size_t)(4 * ln + 256 * j + e) * DIN + NZ + 4 * half); }
    __syncthreads();
    f32x4 gm[4];
#pragma unroll
    for (int j = 0; j < 4; ++j) gm[j] = *(const f32x4*)(p.gmix + 4 * lane + 256 * j);
    bf16* XN = (bf16*)(ws + WS_XN);
    constexpr int NQUAD = MTOK / 4;
#ifndef REP_P0R
#define REP_P0R 1
#endif
    for (int repr_ = 0; repr_ < REP_P0R; ++repr_)
    for (int qd = gw; qd < NQUAD; qd += NGW) {
        const int m0 = 4 * qd; const float* xr = (m0 < MP) ? p.xp + (size_t)m0 * DM : p.xs + (size_t)(m0 - MP) * DM;
        f32x4 v[4][4];
#pragma unroll
        for (int rr = 0; rr < 4; ++rr)
#pragma unroll
            for (int j = 0; j < 4; ++j) v[rr][j] = *(const f32x4*)(xr + (size_t)rr * DM + 4 * lane + 256 * j);
        asm volatile("" ::: "memory");
        float ss[4]; f32x4 a0[4], a1[4];
#pragma unroll
        for (int rr = 0; rr < 4; ++rr) { ss[rr] = 0.f; a0[rr] = (f32x4){0.f, 0.f, 0.f, 0.f}; a1[rr] = a0[rr]; }
#pragma unroll
        for (int j = 0; j < 4; ++j) {
#pragma unroll
            for (int rr = 0; rr < 4; ++rr) { ss[rr] += (v[rr][j][0] * v[rr][j][0] + v[rr][j][1] * v[rr][j][1]) + (v[rr][j][2] * v[rr][j][2] + v[rr][j][3] * v[rr][j][3]); v[rr][j] = v[rr][j] * gm[j]; }
#pragma unroll
            for (int e = 0; e < 4; ++e) { const f32x4 w0 = wl[((j * 4 + e) * 2) * 64 + lane], w1 = wl[((j * 4 + e) * 2 + 1) * 64 + lane];
#pragma unroll
                for (int rr = 0; rr < 4; ++rr) { a0[rr] += w0 * v[rr][j][e]; a1[rr] += w1 * v[rr][j][e]; } } }
        const int b5 = lane >> 5, b4 = (lane >> 4) & 1, b3 = (lane >> 3) & 1;
#pragma unroll
        for (int rr = 0; rr < 4; ++rr) {
            const float r = 1.0f / sqrtf(wave_sum(ss[rr]) * (1.0f / DM) + 1e-6f);
            float t4[4], t2[2];
#pragma unroll
            for (int i = 0; i < 4; ++i) { const float mine = b5 ? a1[rr][i] : a0[rr][i], send = b5 ? a0[rr][i] : a1[rr][i]; t4[i] = mine + __shfl_xor(send, 32); }
#pragma unroll
            for (int i = 0; i < 2; ++i) { const float mine = b4 ? t4[2 + i] : t4[i], send = b4 ? t4[i] : t4[2 + i]; t2[i] = mine + __shfl_xor(send, 16); }
            float t1; { const float mine = b3 ? t2[1] : t2[0], send = b3 ? t2[0] : t2[1]; t1 = mine + __shfl_xor(send, 8); }
            t1 += __shfl_xor(t1, 4); t1 += __shfl_xor(t1, 2); t1 += __shfl_xor(t1, 1);
            const int m = m0 + rr;
#pragma unroll
            for (int j = 0; j < 4; ++j) { u32x2 w; const f32x4 xa = v[rr][j] * r; w.x = pk2(xa[0], xa[1]); w.y = pk2(xa[2], xa[3]); *(u32x2*)(XN + (size_t)m * DM + 4 * lane + 256 * j) = w; }
            if ((lane & 7) == 0) { const int idx = lane >> 3; const float t = t1 * r + p.bfg[idx]; const float lf = fminf(t, 0.f) - log1pf(expf(-fabsf(t)));
                float* o = (m < MP) ? p.out + O_LFP + (size_t)m * 8 : p.out + O_LFS + (size_t)(m - MP) * 8; o[idx] = lf; }
        }
    }
}
__device__ __forceinline__ void p1_cumsum(const Params& p, LAS unsigned char* lds) {
    const int tid = tid_fresh(), lane = tid & 63, wid = __builtin_amdgcn_readfirstlane(tid >> 6);
    const int bh = blockIdx.x; if (bh >= NB * 8) return;
    const int b = bh >> 3, h = bh & 7; const float* lf = p.out + O_LFP + (size_t)b * TSEQ * 8 + h;
    float c[4]; float run = 0.f;
#pragma unroll
    for (int e = 0; e < 4; ++e) { run += lf[(size_t)(4 * tid + e) * 8]; c[e] = run; }
    float tot; const float inc = block_scan(run, tot, (LAS float*)lds, lane, wid); const float exc = inc - run;
    float* cb = (float*)(p.ws + WS_CB) + (size_t)bh * TSEQ + 4 * tid;
    *(f32x4*)cb = (f32x4){exc + c[0], exc + c[1], exc + c[2], exc + c[3]};
}
__device__ __forceinline__ void p6_final(const Params& p, int vcu, int G) {
    const int tid = tid_fresh(), lane = tid & 63, wid = __builtin_amdgcn_readfirstlane(tid >> 6);
    f32x4 gf[4];
#pragma unroll
    for (int j = 0; j < 4; ++j) gf[j] = *(const f32x4*)(p.gfin + 4 * lane + 256 * j);
    for (int m = 2 * (vcu * NWAVES + wid); m < MTOK; m += 2 * G * NWAVES) { float* y = p.out + O_Y + (size_t)m * DM + 4 * lane;
        f32x4 v[2][4]; float s0 = 0.f, s1 = 0.f;
#pragma unroll
        for (int j = 0; j < 4; ++j) { v[0][j] = *(const f32x4*)(y + 256 * j); v[1][j] = *(const f32x4*)(y + DM + 256 * j); }
#pragma unroll
        for (int j = 0; j < 4; ++j) { s0 += (v[0][j][0] * v[0][j][0] + v[0][j][1] * v[0][j][1]) + (v[0][j][2] * v[0][j][2] + v[0][j][3] * v[0][j][3]);
            s1 += (v[1][j][0] * v[1][j][0] + v[1][j][1] * v[1][j][1]) + (v[1][j][2] * v[1][j][2] + v[1][j][3] * v[1][j][3]); }
        const float r0 = 1.0f / sqrtf(wave_sum(s0) * (1.0f / DM) + 1e-6f), r1 = 1.0f / sqrtf(wave_sum(s1) * (1.0f / DM) + 1e-6f);
#pragma unroll
        for (int j = 0; j < 4; ++j) { *(f32x4*)(y + 256 * j) = v[0][j] * r0 * gf[j]; *(f32x4*)(y + DM + 256 * j) = v[1][j] * r1 * gf[j]; } }
}
#define XB_TMO      128
#define XB_XCNT(j)  (256  + 64 * (j))
#define XB_XSUB(j)  (1280 + 64 * (j))
#define XB_XGEN(j)  (2304 + 64 * (j))
#define XB_TOP      3328
#define XB_TOPGEN   3392
#define XCD_BAR_WORDS 3456
#define XB_SPIN_CAP (1u << 18)

__device__ __forceinline__ unsigned xb_ld(unsigned* p)              { return __hip_atomic_load(p, __ATOMIC_RELAXED, __HIP_MEMORY_SCOPE_AGENT); }
__device__ __forceinline__ unsigned xb_add(unsigned* p, unsigned v) { return __hip_atomic_fetch_add(p, v, __ATOMIC_RELAXED, __HIP_MEMORY_SCOPE_AGENT); }
__device__ __forceinline__ unsigned xb_xcc_id() { return (unsigned)__builtin_amdgcn_s_getreg((3 << 11) | 20) & 0xFu; }
#define XB_SPIN(cond, bar) do { unsigned _sp = 0; while (cond) { __builtin_amdgcn_s_sleep(1); \
    if ((++_sp & 255u) == 0u) { if (xb_ld(&(bar)[XB_TMO])) break; if (_sp > XB_SPIN_CAP) { atomicAdd(&(bar)[XB_TMO], 1u); break; } } } } while (0)

struct XcdBarrier {
    unsigned* bar; unsigned x;
    volatile LAS unsigned* st;
};

__device__ __forceinline__ XcdBarrier xcd_barrier_post(unsigned* bar, volatile LAS unsigned* st) {
    XcdBarrier b; b.bar = bar; b.x = xb_xcc_id(); b.st = st;
    if (threadIdx.x == 0) (void)xb_add(&bar[XB_XCNT(b.x)], 1u);
    return b;
}
__device__ __forceinline__ void xcd_barrier_complete(unsigned* bar, unsigned x, unsigned& nloc, unsigned& nx) {
    const unsigned G = gridDim.x * gridDim.y * gridDim.z;
    unsigned sum, cnt, mine, sp = 0u;
    for (;;) {
        sum = 0u; cnt = 0u; mine = 0u;
#pragma unroll
        for (unsigned j = 0; j < 16; ++j) { const unsigned c = xb_ld(&bar[XB_XCNT(j)]); sum += c; cnt += (c > 0u) ? 1u : 0u; mine = (j == x) ? c : mine; }
        if (sum == G) break;
        __builtin_amdgcn_s_sleep(1);
        if ((++sp & 255u) == 0u) { if (xb_ld(&bar[XB_TMO])) break; if (sp > XB_SPIN_CAP) { atomicAdd(&bar[XB_TMO], 1u); break; } }
    }
    nloc = mine > 0u ? mine : 1u; nx = cnt > 0u ? cnt : 1u;
}

__device__ __forceinline__ void xcd_barrier(const XcdBarrier& b) {
    asm volatile("s_waitcnt vmcnt(0)" ::: "memory");
    __syncthreads();
    if (threadIdx.x == 0) {
        unsigned* bar = b.bar;
        __builtin_amdgcn_s_waitcnt(0);
        unsigned nloc = b.st[0], nx = b.st[1];
        if (nloc == 0u) { xcd_barrier_complete(bar, b.x, nloc, nx); b.st[0] = nloc; b.st[1] = nx; }
        const unsigned old = xb_add(&bar[XB_XSUB(b.x)], 1u);
        const unsigned gen = old / nloc;
        if (old + 1u == (gen + 1u) * nloc) {
            __builtin_amdgcn_fence(__ATOMIC_RELEASE, "agent");
            asm volatile("s_waitcnt vmcnt(0)" ::: "memory");
            const unsigned og = xb_add(&bar[XB_TOP], 1u);
            const unsigned tg = og / nx;
            if (og + 1u == (tg + 1u) * nx) xb_add(&bar[XB_TOPGEN], 1u);
            else XB_SPIN(xb_ld(&bar[XB_TOPGEN]) == tg, bar);
            __builtin_amdgcn_fence(__ATOMIC_ACQUIRE, "agent");
            xb_add(&bar[XB_XGEN(b.x)], 1u);
            asm volatile("s_waitcnt vmcnt(0)" ::: "memory");
        } else {
            XB_SPIN(xb_ld(&bar[XB_XGEN(b.x)]) == gen, bar);
            __builtin_amdgcn_fence(__ATOMIC_ACQUIRE, "agent");
            asm volatile("s_waitcnt vmcnt(0)" ::: "memory");
        }
    }
    __syncthreads();
}
#ifndef RJ_SKIP
#define RJ_SKIP 0
#endif
#define MFMA32(a, b, c) __builtin_amdgcn_mfma_f32_32x32x16_bf16((a), (b), (c), 0, 0, 0)
__device__ __forceinline__ void ret_job(LAS unsigned char* lds, const Params& p_, const bool sample, const int b, const int h) {
    const Params p = fresh_params(p_);
    const int tid = tid_fresh(), lane = tid & 63, wid = __builtin_amdgcn_readfirstlane(tid >> 6), r32 = lane & 31, hi = lane >> 5;
    constexpr int PQK = 272, PT = 144;
    LAS unsigned char* Qr = lds; LAS unsigned char* Kr = lds + 17408; LAS unsigned char* Kdt = lds + 34816; LAS unsigned char* Vt = lds + 53248;
    LAS unsigned char* St = lds + 71680; LAS unsigned char* Am = lds + 106496; LAS f32x2* stats = (LAS f32x2*)(lds + 115712);
    const float lg2 = h == 0 ? -0.045803689613124746f : h == 1 ? -0.022720076500083907f : h == 2 ? -0.011315313227834146f : -0.005646563141142062f;
    const float cdec = __builtin_amdgcn_exp2f(lg2 * 64.0f);
    const int nch = sample ? 1 : TSEQ / 64; const size_t row0 = sample ? (size_t)MP + b * NSMP : (size_t)b * TSEQ;
    const bf16* Z = (const bf16*)(p.ws + WS_Z); bf16* MIX = (bf16*)(p.ws + WS_MIX);
    const int dkb = wid & 3, dvh = wid >> 2;
    f32x16 S0, S1;
    if (sample) { const float* sp = p.sr + (size_t)(b * 4 + h) * 16384 + 64 * dvh + r32;
#pragma unroll
        for (int r = 0; r < 16; ++r) { const int dk = 32 * dkb + crow(r, hi); S0[r] = sp[dk * 128]; S1[r] = sp[dk * 128 + 32]; } }
    else {
#pragma unroll
        for (int r = 0; r < 16; ++r) { S0[r] = 0.f; S1[r] = 0.f; } }
    u32x4 pq0, pq1, pk0, pk1, pv0, pv1; u32x2 pg[4];
#define RJ_LOAD(c_) do { const bf16* zr = Z + (row0 + (size_t)(c_) * 64 + 2 * (tid & 31)) * NZ + h * 128 + (tid >> 5) * 8; \
        pq0 = *(const u32x4*)zr; pq1 = *(const u32x4*)(zr + NZ); pk0 = *(const u32x4*)(zr + 512); pk1 = *(const u32x4*)(zr + NZ + 512); pv0 = *(const u32x4*)(zr + 1024); pv1 = *(const u32x4*)(zr + NZ + 1024); } while (0)
    RJ_LOAD(0);
    f32x4 gnv[4];
#pragma unroll
    for (int g = 0; g < 4; ++g) gnv[g] = *(const f32x4*)(p.gn + h * 128 + 32 * (wid >> 1) + 8 * g + 4 * hi);
    for (int c = 0; c < nch; ++c) {
        const size_t r0 = row0 + (size_t)c * 64;
#if !(RJ_SKIP & 1)
        { const int jp = tid & 31, ch = tid >> 5;
            *(LAS u32x4*)(Qr + (2 * jp) * PQK + ch * 16) = pq0; *(LAS u32x4*)(Qr + (2 * jp + 1) * PQK + ch * 16) = pq1;
            *(LAS u32x4*)(Kr + (2 * jp) * PQK + ch * 16) = pk0; *(LAS u32x4*)(Kr + (2 * jp + 1) * PQK + ch * 16) = pk1;
            const float kd0 = __builtin_amdgcn_exp2f(lg2 * (float)(63 - 2 * jp)), kd1 = __builtin_amdgcn_exp2f(lg2 * (float)(62 - 2 * jp));
#pragma unroll
            for (int e = 0; e < 8; ++e) { const unsigned a0 = pk0[e >> 1], a1 = pk1[e >> 1], b0 = pv0[e >> 1], b1 = pv1[e >> 1];
                const float f0 = (e & 1) ? __uint_as_float(a0 & 0xffff0000u) : __uint_as_float(a0 << 16), f1 = (e & 1) ? __uint_as_float(a1 & 0xffff0000u) : __uint_as_float(a1 << 16);
                *(LAS unsigned*)(Kdt + (ch * 8 + e) * PT + jp * 4) = pk2(f0 * kd0, f1 * kd1);
                *(LAS unsigned*)(Vt + (ch * 8 + e) * PT + jp * 4) = (e & 1) ? ((b0 >> 16) | (b1 & 0xffff0000u)) : ((b0 & 0xffffu) | (b1 << 16)); } }
#pragma unroll
        for (int g = 0; g < 4; ++g) { const int dk0 = 32 * dkb + 8 * g + 4 * hi;
            u32x2 w0, w1; w0.x = pk2(S0[4 * g], S0[4 * g + 1]); w0.y = pk2(S0[4 * g + 2], S0[4 * g + 3]); w1.x = pk2(S1[4 * g], S1[4 * g + 1]); w1.y = pk2(S1[4 * g + 2], S1[4 * g + 3]);
            *(LAS u32x2*)(St + (64 * dvh + r32) * PQK + dk0 * 2) = w0; *(LAS u32x2*)(St + (64 * dvh + 32 + r32) * PQK + dk0 * 2) = w1; }
        if (c + 1 < nch) RJ_LOAD(c + 1);
        { const bf16* grow = Z + (r0 + 32 * (wid & 1) + r32) * NZ + 1536 + h * 128 + 32 * (wid >> 1) + 4 * hi;
#pragma unroll
          for (int g = 0; g < 4; ++g) pg[g] = *(const u32x2*)(grow + 8 * g); }
#endif
        __syncthreads();
#if !(RJ_SKIP & 2)
        if (wid < 4) { const int jb = wid >> 1, ib = wid & 1; f32x16 a;
#pragma unroll
            for (int r = 0; r < 16; ++r) a[r] = 0.f;
#pragma unroll 2
            for (int ks = 0; ks < 8; ++ks) { const bf16x8 kf = *(const LAS bf16x8*)(Kr + (32 * jb + r32) * PQK + (16 * ks + 8 * hi) * 2), qf = *(const LAS bf16x8*)(Qr + (32 * ib + r32) * PQK + (16 * ks + 8 * hi) * 2);
                a = MFMA32(kf, qf, a); }
            const int i = 32 * ib + r32;
#pragma unroll
            for (int g = 0; g < 4; ++g) { const int j0 = 32 * jb + 8 * g + 4 * hi; float t[4];
#pragma unroll
                for (int e = 0; e < 4; ++e) t[e] = a[4 * g + e] * __builtin_amdgcn_exp2f(lg2 * fabsf((float)(i - (j0 + e))));
                u32x2 w; w.x = pk2(t[0], t[1]); w.y = pk2(t[2], t[3]); *(LAS u32x2*)(Am + i * PT + j0 * 2) = w; } }
#endif
        __syncthreads();
#if !(RJ_SKIP & 4)
        { const int dvb = wid >> 1, ib = wid & 1; f32x16 oi, ox;
#pragma unroll
            for (int r = 0; r < 16; ++r) { oi[r] = 0.f; ox[r] = 0.f; }
#pragma unroll
            for (int ks = 0; ks < 4; ++ks) { const bf16x8 vf = *(const LAS bf16x8*)(Vt + (32 * dvb + r32) * PT + (16 * ks + 8 * hi) * 2), af = *(const LAS bf16x8*)(Am + (32 * ib + r32) * PT + (16 * ks + 8 * hi) * 2);
                oi = MFMA32(vf, af, oi); }
#pragma unroll 2
            for (int ks = 0; ks < 8; ++ks) { const bf16x8 sf = *(const LAS bf16x8*)(St + (32 * dvb + r32) * PQK + (16 * ks + 8 * hi) * 2), qf = *(const LAS bf16x8*)(Qr + (32 * ib + r32) * PQK + (16 * ks + 8 * hi) * 2);
                ox = MFMA32(sf, qf, ox); }
            const int i = 32 * ib + r32; const float qd = __builtin_amdgcn_exp2f(lg2 * (float)(i + 1)); float s1 = 0.f, s2 = 0.f;
#pragma unroll
            for (int r = 0; r < 16; ++r) { oi[r] += ox[r] * qd; s1 += oi[r]; s2 += oi[r] * oi[r]; }
            s1 += __shfl_xor(s1, 32); s2 += __shfl_xor(s2, 32);
            if (hi == 0) stats[i * 4 + dvb] = (f32x2){s1, s2};
            __syncthreads();
            float m1 = 0.f, m2 = 0.f;
#pragma unroll
            for (int t = 0; t < 4; ++t) { const f32x2 st = stats[i * 4 + t]; m1 += st.x; m2 += st.y; }
            const float mu = m1 * (1.0f / 128.0f), var = fmaxf(m2 * (1.0f / 128.0f) - mu * mu, 0.f), rstd = 1.0f / sqrtf(var + 1e-5f);
            bf16* mrow = MIX + (r0 + i) * DM + h * 128;
#pragma unroll
            for (int g = 0; g < 4; ++g) { const int dv0 = 32 * dvb + 8 * g + 4 * hi; const u32x2 gw = pg[g]; const f32x4 gn = gnv[g];
                const float g0 = bf2f(gw.x & 0xffffu), g1 = bf2f(gw.x >> 16), g2 = bf2f(gw.y & 0xffffu), g3 = bf2f(gw.y >> 16);
                const float y0 = (oi[4 * g] - mu) * rstd * gn[0] * pg8::silu_f(g0), y1 = (oi[4 * g + 1] - mu) * rstd * gn[1] * pg8::silu_f(g1);
                const float y2 = (oi[4 * g + 2] - mu) * rstd * gn[2] * pg8::silu_f(g2), y3 = (oi[4 * g + 3] - mu) * rstd * gn[3] * pg8::silu_f(g3);
                u32x2 w; w.x = pk2(y0, y1); w.y = pk2(y2, y3); *(u32x2*)(mrow + dv0) = w; } }
#endif
#if !(RJ_SKIP & 8)
#pragma unroll
        for (int r = 0; r < 16; ++r) { S0[r] *= cdec; S1[r] *= cdec; }
#pragma unroll
        for (int ks = 0; ks < 4; ++ks) { const bf16x8 kdf = *(const LAS bf16x8*)(Kdt + (32 * dkb + r32) * PT + (16 * ks + 8 * hi) * 2);
            const bf16x8 v0 = *(const LAS bf16x8*)(Vt + (64 * dvh + r32) * PT + (16 * ks + 8 * hi) * 2), v1 = *(const LAS bf16x8*)(Vt + (64 * dvh + 32 + r32) * PT + (16 * ks + 8 * hi) * 2);
            S0 = MFMA32(kdf, v0, S0); S1 = MFMA32(kdf, v1, S1); }
#endif
        __syncthreads();
    }
#undef RJ_LOAD
    { float* so = p.out + (sample ? O_SRS : O_SRP) + (size_t)(b * 4 + h) * 16384 + 64 * dvh + r32;
#pragma unroll
        for (int r = 0; r < 16; ++r) { const int dk = 32 * dkb + crow(r, hi); so[dk * 128] = S0[r]; so[dk * 128 + 32] = S1[r]; } }
}

constexpr size_t WS_PART = WS_END + 6 * MiB;
constexpr int PART_STRIDE = 4224;
__device__ __forceinline__ void fs_chunk_job(LAS unsigned char* lds, const Params& p_, const int b, const int c) {
    const Params p = fresh_params(p_);
    const int tid = tid_fresh(), lane = tid & 63, wid = __builtin_amdgcn_readfirstlane(tid >> 6), r32 = lane & 31, hi = lane >> 5;
    const int h = wid;
    LAS float* ab = (LAS float*)(lds + wid * 1280);
    LAS float* red = (LAS float*)(lds + 10240);
    LAS unsigned char* vtw = lds + 12288 + wid * 5120;
    { const float* clf = p.clf + (size_t)b * PAST * 8; float acc = 0.f;
      for (int j = 256 * (c + 1) + (tid >> 3); j < PAST; j += 64) acc += clf[(size_t)j * 8 + (tid & 7)];
      acc += __shfl_xor(acc, 8); acc += __shfl_xor(acc, 16); acc += __shfl_xor(acc, 32);
      if (lane < 8) red[wid * 8 + lane] = acc;
      __syncthreads();
      float Sh = 0.f;
#pragma unroll
      for (int w = 0; w < NWAVES; ++w) Sh += red[w * 8 + h];
      float v[4]; float tt = 0.f;
#pragma unroll
      for (int e = 0; e < 4; ++e) { v[e] = clf[(size_t)(256 * c + 4 * lane + e) * 8 + h]; tt += v[e]; }
      float inc = tt;
#pragma unroll
      for (int o = 1; o < 64; o <<= 1) { const float n = __shfl_up(inc, o); if (lane >= o) inc += n; }
      const float tot = __shfl(inc, 63); float suf = Sh + (tot - inc);
#pragma unroll
      for (int e = 3; e >= 0; --e) { ab[4 * lane + e] = suf * LOG2E; suf += v[e]; }
      if (c == 15) { float x = p.out[O_LFS + (size_t)(b * NSMP + lane) * 8 + h];
#pragma unroll
          for (int o = 1; o < 64; o <<= 1) { const float n = __shfl_up(x, o); if (lane >= o) x += n; }
          ab[256 + lane] = -x * LOG2E; } }
    const bf16* Zq = (const bf16*)(p.ws + WS_Z) + ((size_t)MP + b * NSMP) * NZ + 2048 + h * 64;
    bf16x8 qr[2][4];
#pragma unroll
    for (int qb = 0; qb < 2; ++qb)
#pragma unroll
        for (int d0 = 0; d0 < 4; ++d0) qr[qb][d0] = *(const bf16x8*)(Zq + (size_t)(32 * qb + r32) * NZ + 16 * d0 + 8 * hi);
    f32x16 o[2][2]; float mrun[2] = {-1e30f, -1e30f}, lrun[2] = {0.f, 0.f};
#pragma unroll
    for (int a = 0; a < 2; ++a)
#pragma unroll
        for (int cc = 0; cc < 2; ++cc)
#pragma unroll
            for (int r = 0; r < 16; ++r) o[a][cc][r] = 0.f;
    const size_t hoff = (size_t)h * 64;
    const float* ckb = p.ck + ((size_t)b * PAST + 256 * c) * 512 + hoff; const float* cvb = p.cv + ((size_t)b * PAST + 256 * c) * 512 + hoff;
    const float* nkb = p.out + O_FKS + (size_t)b * NSMP * 512 + hoff; const float* nvb = p.out + O_FVS + (size_t)b * NSMP * 512 + hoff;
    const int nstep = (c == 15) ? 10 : 8;
    f32x4 kraw[8], vraw[8];
#define FS_LOAD(s_) do { const int s__ = (s_); const float* kp = s__ < 8 ? ckb + (size_t)s__ * 32 * 512 : nkb + (size_t)(s__ - 8) * 32 * 512; \
        const float* vp = s__ < 8 ? cvb + (size_t)s__ * 32 * 512 : nvb + (size_t)(s__ - 8) * 32 * 512; \
        _Pragma("unroll") for (int d0 = 0; d0 < 4; ++d0) { kraw[2 * d0] = *(const f32x4*)(kp + r32 * 512 + 16 * d0 + 8 * hi); kraw[2 * d0 + 1] = *(const f32x4*)(kp + r32 * 512 + 16 * d0 + 8 * hi + 4); } \
        _Pragma("unroll") for (int i = 0; i < 4; ++i) { const int pr = 4 * i + (lane >> 4); vraw[2 * i] = *(const f32x4*)(vp + (2 * pr) * 512 + 4 * (lane & 15)); vraw[2 * i + 1] = *(const f32x4*)(vp + (2 * pr + 1) * 512 + 4 * (lane & 15)); } } while (0)
    FS_LOAD(0);
    for (int s = 0; s < nstep; ++s) {
        bf16x8 kf[4];
#pragma unroll
        for (int d0 = 0; d0 < 4; ++d0) { u32x4 w; w.x = pk2(kraw[2 * d0][0], kraw[2 * d0][1]); w.y = pk2(kraw[2 * d0][2], kraw[2 * d0][3]); w.z = pk2(kraw[2 * d0 + 1][0], kraw[2 * d0 + 1][1]); w.w = pk2(kraw[2 * d0 + 1][2], kraw[2 * d0 + 1][3]);
            kf[d0] = __builtin_bit_cast(bf16x8, w); }
#pragma unroll
        for (int i = 0; i < 4; ++i) { const int kap = 2 * (4 * i + (lane >> 4)); const int pos = (kap & ~12) | ((kap & 4) << 1) | ((kap & 8) >> 1);
#pragma unroll
            for (int e = 0; e < 4; ++e) *(LAS unsigned*)(vtw + (4 * (lane & 15) + e) * 80 + pos * 2) = pk2(vraw[2 * i][e], vraw[2 * i + 1][e]); }
        if (s + 1 < nstep) FS_LOAD(s + 1);
        f32x16 sc[2];
#pragma unroll
        for (int qb = 0; qb < 2; ++qb) {
#pragma unroll
            for (int r = 0; r < 16; ++r) sc[qb][r] = 0.f;
#pragma unroll
            for (int d0 = 0; d0 < 4; ++d0) sc[qb] = MFMA32(kf[d0], qr[qb][d0], sc[qb]); }
        const int key0 = 32 * s;
#pragma unroll
        for (int g = 0; g < 4; ++g) { const f32x4 bv = *(const LAS f32x4*)(ab + key0 + 8 * g + 4 * hi);
#pragma unroll
            for (int e = 0; e < 4; ++e) { sc[0][4 * g + e] += bv[e]; sc[1][4 * g + e] += bv[e]; } }
        if (s >= 8) {
#pragma unroll
            for (int qb = 0; qb < 2; ++qb)
#pragma unroll
                for (int r = 0; r < 16; ++r) { const int kn = key0 - 256 + crow(r, hi); if (kn > 32 * qb + r32) sc[qb][r] = -INFINITY; } }
        bf16x8 pf[2][2];
#pragma unroll
        for (int qb = 0; qb < 2; ++qb) { float rm = sc[qb][0];
#pragma unroll
            for (int r = 1; r < 16; ++r) rm = fmaxf(rm, sc[qb][r]);
            rm = fmaxf(rm, __shfl_xor(rm, 32));
            const float mn = fmaxf(mrun[qb], rm), alpha = __builtin_amdgcn_exp2f(mrun[qb] - mn); mrun[qb] = mn; float ps = 0.f;
#pragma unroll
            for (int r = 0; r < 16; ++r) { const float e_ = __builtin_amdgcn_exp2f(sc[qb][r] - mn); sc[qb][r] = e_; ps += e_; }
            lrun[qb] = lrun[qb] * alpha + ps;
#pragma unroll
            for (int r = 0; r < 16; ++r) { o[qb][0][r] *= alpha; o[qb][1][r] *= alpha; }
#pragma unroll
            for (int ks = 0; ks < 2; ++ks) { u32x4 w; w.x = pk2(sc[qb][8 * ks], sc[qb][8 * ks + 1]); w.y = pk2(sc[qb][8 * ks + 2], sc[qb][8 * ks + 3]); w.z = pk2(sc[qb][8 * ks + 4], sc[qb][8 * ks + 5]); w.w = pk2(sc[qb][8 * ks + 6], sc[qb][8 * ks + 7]);
                pf[qb][ks] = __builtin_bit_cast(bf16x8, w); } }
#pragma unroll
        for (int db = 0; db < 2; ++db)
#pragma unroll
            for (int ks = 0; ks < 2; ++ks) { const bf16x8 vf = *(const LAS bf16x8*)(vtw + (32 * db + r32) * 80 + (16 * ks + 8 * hi) * 2);
                o[0][db] = MFMA32(vf, pf[0][ks], o[0][db]); o[1][db] = MFMA32(vf, pf[1][ks], o[1][db]); }
    }
#undef FS_LOAD
    lrun[0] += __shfl_xor(lrun[0], 32); lrun[1] += __shfl_xor(lrun[1], 32);
    float* part = (float*)(p.ws + WS_PART) + (size_t)((b * 8 + h) * 16 + c) * PART_STRIDE;
#pragma unroll
    for (int qb = 0; qb < 2; ++qb) { const int q = 32 * qb + r32;
        if (hi == 0) { part[4096 + q] = mrun[qb]; part[4160 + q] = lrun[qb]; }
#pragma unroll
        for (int db = 0; db < 2; ++db)
#pragma unroll
            for (int g = 0; g < 4; ++g) *(f32x4*)(part + q * 64 + 32 * db + 8 * g + 4 * hi) = (f32x4){o[qb][db][4 * g], o[qb][db][4 * g + 1], o[qb][db][4 * g + 2], o[qb][db][4 * g + 3]}; }
}
__device__ __forceinline__ void fs_combine_job(const Params& p_, const int b, const int h) {
    const Params p = fresh_params(p_);
    const int tid = tid_fresh(), q = tid >> 3, dg = tid & 7;
    const float* part = (const float*)(p.ws + WS_PART) + (size_t)((b * 8 + h) * 16) * PART_STRIDE;
    float M = -3e38f;
#pragma unroll
    for (int c = 0; c < 16; ++c) M = fmaxf(M, part[(size_t)c * PART_STRIDE + 4096 + q]);
    float L = 0.f; f32x4 a0 = {0.f, 0.f, 0.f, 0.f}, a1 = a0;
#pragma unroll
    for (int c = 0; c < 16; ++c) { const float* pc = part + (size_t)c * PART_STRIDE; const float wg = __builtin_amdgcn_exp2f(pc[4096 + q] - M); L += wg * pc[4160 + q];
        a0 += *(const f32x4*)(pc + q * 64 + 8 * dg) * wg; a1 += *(const f32x4*)(pc + q * 64 + 8 * dg + 4) * wg; }
    const float inv = 1.0f / L; u32x4 w; w.x = pk2(a0[0] * inv, a0[1] * inv); w.y = pk2(a0[2] * inv, a0[3] * inv); w.z = pk2(a1[0] * inv, a1[1] * inv); w.w = pk2(a1[2] * inv, a1[3] * inv);
    *(u32x4*)((bf16*)(p.ws + WS_MIX) + ((size_t)MP + b * NSMP + q) * DM + 512 + h * 64 + 8 * dg) = w;
}
constexpr int NFP = NB * 8 * (TSEQ / 256);
constexpr int Q_FSC = NB * 16, Q_RETS = NB * 4, Q_RETP = NB * 4, Q_FSM = NB * 8, Q_P3S = 16, Q_FP1 = 300, Q_P4S = 4 * 22, Q_FP2 = 300, Q_P5S = 64;
constexpr int Q_FP3 = NFP - Q_FP1 - Q_FP2;
constexpr int NJOBS = Q_FSC + Q_RETS + Q_RETP + Q_FSM + Q_P3S + Q_FP1 + Q_P4S + Q_FP2 + Q_P5S + Q_FP3;
constexpr size_t WS_HS = WS_END;
constexpr size_t WS_END2 = WS_PART + (size_t)NB * 8 * 16 * PART_STRIDE * 4;
__device__ __forceinline__ void gate_wait(unsigned* c, unsigned target) {
    if (tid_fresh() == 0) { unsigned sp = 0; while (__hip_atomic_load(c, RLX_AGENT) < target && ++sp < (1u << 22)) __builtin_amdgcn_s_sleep(4);
        __builtin_amdgcn_fence(__ATOMIC_ACQUIRE, "agent"); asm volatile("s_waitcnt vmcnt(0)" ::: "memory"); }
    __syncthreads();
}
__device__ __forceinline__ void job_signal(unsigned* c) {
    asm volatile("s_waitcnt vmcnt(0)" ::: "memory");
    __syncthreads();
    if (tid_fresh() == 0) { __builtin_amdgcn_fence(__ATOMIC_RELEASE, "agent"); asm volatile("s_waitcnt vmcnt(0)" ::: "memory"); __hip_atomic_fetch_add(c, 1u, RLX_AGENT); }
}
__global__ void __launch_bounds__(NTHR, 2) hybrid_fwd(Params p) {
    extern __shared__ __attribute__((aligned(16))) unsigned char lds_raw[];
    LAS unsigned char* lds = (LAS unsigned char*)lds_raw;
    cg::grid_group grid = cg::this_grid();
    const int G = gridDim.x, bx = blockIdx.x, vcu = (G % 8 == 0) ? (bx % 8) * (G / 8) + bx / 8 : bx;
    unsigned char* ws = p.ws;
    volatile LAS unsigned* MISCU = (volatile LAS unsigned*)(lds + MISC_OFF);
    if (threadIdx.x < 32) MISCU[threadIdx.x] = 0u;
    __syncthreads();
    if (p.ws == nullptr) grid.sync();
    const XcdBarrier xbar = xcd_barrier_post((unsigned*)(ws + WS_CTL) + 4096, MISCU + 8);
    p0_prep(p, lds, vcu, G);
    xcd_barrier(xbar);
    p1_cumsum(p, lds);
    __syncthreads();
    { pg8::Gemm g{(const bf16*)(ws + WS_XN), (const bf16*)(ws + WS_WIN), MTOK, NZ, DM, DM}; pg8::StaticOrder S; S.init(MTOK, NZ, G, bx);
      pg8::EpiInProj E{(bf16*)(ws + WS_Z), p.out, (const float*)(ws + WS_CS)};
      pg8::gemm_phase<pg8::EpiInProj, pg8::StaticOrder, true, true>(lds, g, S, E); }
    xcd_barrier(xbar);
    { volatile LAS int* MISC = (volatile LAS int*)(lds + MISC_OFF);
      for (;;) {
          if (tid_fresh() == 0) MISC[0] = (int)atomicAdd((unsigned*)(ws + WS_CTL), 1u);
          __syncthreads();
          int job = __builtin_amdgcn_readfirstlane(MISC[0]);
          __syncthreads();
#ifndef DUP_KIND
#define DUP_KIND 0
#endif
          constexpr int NDUP = DUP_KIND == 1 ? 2560 : DUP_KIND == 2 ? 1024 : 0;
          if (job >= NJOBS + NDUP) break;
          if (job >= NJOBS) { const int d = job - NJOBS;
              if (DUP_KIND == 2) { const Params q = fresh_params(p); bf16* Z = (bf16*)(q.ws + WS_Z); attn_body::attn_unit<8>((d & 127) >> 3, d & 7, 7 - (d >> 7), (const attn_body::bf16*)(Z + 2048), (const attn_body::bf16*)(Z + 2560), (const attn_body::bf16*)(Z + 3072), (attn_body::bf16*)((bf16*)(q.ws + WS_MIX) + 512), (const float*)(q.ws + WS_CB), (char*)lds_raw); }
              __syncthreads(); continue; }
          const Params q = fresh_params(p);
          unsigned char* qws = q.ws; unsigned* cnt = (unsigned*)(qws + WS_CTL);
          bf16* Z = (bf16*)(qws + WS_Z); bf16* MIX = (bf16*)(qws + WS_MIX); bf16* XN = (bf16*)(qws + WS_XN);
          int fp = -1;
          if (job < Q_FSC) { fs_chunk_job(lds, p, job >> 4, job & 15); job_signal(cnt + 64 + 64 * (job >> 4)); }
          else if ((job -= Q_FSC) < Q_RETS) { ret_job(lds, p, true, job >> 2, job & 3); job_signal(cnt + 1216); }
          else if ((job -= Q_RETS) < Q_RETP) ret_job(lds, p, false, job >> 2, job & 3);
          else if ((job -= Q_RETP) < Q_FSM) { gate_wait(cnt + 64 + 64 * (job >> 3), 16); fs_combine_job(p, job >> 3, job & 7); job_signal(cnt + 1216); }
          else if ((job -= Q_FSM) < Q_P3S) { gate_wait(cnt + 1216, Q_RETS + Q_FSM);
              pg8::Gemm g{MIX, (const bf16*)(qws + WS_WO), MTOK, DM, DM, DM}; pg8::OneUnit S{MP / 256 + job / 4, job % 4};
              pg8::EpiResid E{q.xp, q.xs, q.out + O_Y, XN, (float*)(qws + WS_SS1), nullptr};
              pg8::gemm_phase<pg8::EpiResid, pg8::OneUnit, true, true>(lds, g, S, E); job_signal(cnt + 1280); }
          else if ((job -= Q_P3S) < Q_FP1) fp = job;
          else if ((job -= Q_FP1) < Q_P4S) { gate_wait(cnt + 1280, Q_P3S);
              pg8::Gemm g{XN, (const bf16*)(qws + WS_WGU), MTOK, NGU, DM, DM}; pg8::OneUnit S{MP / 256 + job / 22, job % 22};
              pg8::EpiGateUp E{(bf16*)(qws + WS_HS) - (size_t)MP * DFF, (const float*)(qws + WS_SS1)};
              pg8::gemm_phase<pg8::EpiGateUp, pg8::OneUnit, true, true>(lds, g, S, E); job_signal(cnt + 1344); }
          else if ((job -= Q_P4S) < Q_FP2) fp = Q_FP1 + job;
          else if ((job -= Q_FP2) < Q_P5S) { gate_wait(cnt + 1344, Q_P4S);
              const int kq = job & 3, un = job >> 2, koff = (kq == 0 ? 0 : kq == 1 ? 768 : kq == 2 ? 1408 : 2176), klen = (kq & 1) ? 640 : 768;
              pg8::Gemm g{(const bf16*)(qws + WS_HS) - (size_t)MP * DFF + koff, (const bf16*)(qws + WS_WD) + koff, MTOK, DM, klen, DFF}; pg8::OneUnit S{MP / 256 + un / 4, un % 4};
              pg8::EpiAtomic E{q.out + O_Y};
              pg8::gemm_phase<pg8::EpiAtomic, pg8::OneUnit, true, true>(lds, g, S, E); }
          else fp = Q_FP1 + Q_FP2 + (job - Q_P5S);
          if (fp >= 0) { const int qb = (TSEQ / 256 - 1) - (fp >> 7), bh = fp & 127;
              attn_body::attn_unit<8>(bh >> 3, bh & 7, qb, (const attn_body::bf16*)(Z + 2048), (const attn_body::bf16*)(Z + 2560), (const attn_body::bf16*)(Z + 3072),
                                      (attn_body::bf16*)(MIX + 512), (const float*)(qws + WS_CB), (char*)lds_raw); }
          __syncthreads();
      } }
    xcd_barrier(xbar);
#ifndef REP_G
#define REP_G 1
#endif
    { pg8::Gemm g{(const bf16*)(ws + WS_MIX), (const bf16*)(ws + WS_WO), MP, DM, DM, DM}; pg8::StaticOrder S; S.init(MP, DM, G, bx);
      pg8::EpiResid E{p.xp, p.xs, nullptr, (bf16*)(ws + WS_XN), (float*)(ws + WS_SS1), nullptr};
      pg8::gemm_phase<pg8::EpiResid, pg8::StaticOrder, true, true>(lds, g, S, E);
    xcd_barrier(xbar); }
    { pg8::Gemm g{(const bf16*)(ws + WS_XN), (const bf16*)(ws + WS_WGU), MP, NGU, DM, DM}; pg8::StaticOrder S; S.init(MP, NGU, G, bx);
      pg8::EpiGateUp E{(bf16*)(ws + WS_H), (const float*)(ws + WS_SS1)};
      pg8::gemm_phase<pg8::EpiGateUp, pg8::StaticOrder, true, true>(lds, g, S, E);
    xcd_barrier(xbar); }
    { pg8::Gemm g{(const bf16*)(ws + WS_H), (const bf16*)(ws + WS_WD), MP, DM, DFF, DFF}; pg8::StaticOrder S; S.init(MP, DM, G, bx);
      pg8::EpiResid E{nullptr, nullptr, p.out + O_Y, nullptr, nullptr, (const bf16*)(ws + WS_XN)};
      pg8::gemm_phase<pg8::EpiResid, pg8::StaticOrder, true, true>(lds, g, S, E);
    xcd_barrier(xbar); }
    p6_final(p, vcu, G);
}

extern "C" void kernel_launch(void* const* d_in, const int* in_sizes, int n_in, void* d_out, int out_size, void* d_ws, size_t ws_size, hipStream_t stream) {
    static int grid = 0;
    if (grid == 0) {
        if (n_in != 16 || out_size != (int)O_END || ws_size < WS_END2) { fprintf(stderr, "kernel_launch: unexpected shapes (n_in %d, out %d, ws %zu); nothing launched\n", n_in, out_size, ws_size); grid = -1; return; }
        int dev = 0, cus = 0, per_cu = 0;
        if (hipGetDevice(&dev) != hipSuccess || hipDeviceGetAttribute(&cus, hipDeviceAttributeMultiprocessorCount, dev) != hipSuccess) { grid = -1; return; }
        if (hipFuncSetAttribute((const void*)hybrid_fwd, hipFuncAttributeMaxDynamicSharedMemorySize, LDS_BYTES) != hipSuccess) { fprintf(stderr, "kernel_launch: hipFuncSetAttribute failed\n"); grid = -1; return; }
        if (hipOccupancyMaxActiveBlocksPerMultiprocessor(&per_cu, (const void*)hybrid_fwd, NTHR, LDS_BYTES) != hipSuccess || per_cu < 1) { fprintf(stderr, "kernel_launch: occupancy query says %d blocks per CU\n", per_cu); per_cu = 1; }
        (void)hipGetLastError();
        grid = cus * per_cu;
    }
    if (grid < 0) return;
    Params p{};
    p.xp = (const float*)d_in[0]; p.xs = (const float*)d_in[1]; p.ck = (const float*)d_in[2]; p.cv = (const float*)d_in[3]; p.clf = (const float*)d_in[4]; p.sr = (const float*)d_in[5];
    p.win = (const float*)d_in[6]; p.bfg = (const float*)d_in[7]; p.gn = (const float*)d_in[8]; p.wout = (const float*)d_in[9]; p.gmix = (const float*)d_in[10]; p.gffn = (const float*)d_in[11];
    p.wg = (const float*)d_in[12]; p.wu = (const float*)d_in[13]; p.wd = (const float*)d_in[14]; p.gfin = (const float*)d_in[15];
    p.out = (float*)d_out; p.ws = (unsigned char*)d_ws;
    void* args[] = {&p};
    (void)hipMemsetAsync((char*)d_ws + WS_CTL + 4096 * 4, 0, XCD_BAR_WORDS * 4, stream);
    const hipError_t e = hipLaunchCooperativeKernel((const void*)hybrid_fwd, dim3(grid), dim3(NTHR), args, LDS_BYTES, stream);
    if (e != hipSuccess) fprintf(stderr, "kernel_launch: cooperative launch failed: %s (grid %d)\n", hipGetErrorString(e), grid);
}
```

```cpp
#include <hip/hip_runtime.h>
#include <hip/hip_cooperative_groups.h>
#include <hip/hip_bf16.h>
#include <cstdio>
#include <cstdint>
#include <cmath>
namespace cg = cooperative_groups;

constexpr int DM = 1024, NB = 16, TSEQ = 2048, MP = NB * TSEQ, NSMP = 64, MS = NB * NSMP, MTOK = MP + MS, PAST = 4096;
constexpr int DIN = 3592, NZ = 3584, DFF = 2816, NGU = 2 * DFF;
constexpr size_t O_Y = 0, O_SRP = (size_t)MTOK * DM, O_FKP = O_SRP + 1048576, O_FVP = O_FKP + 16777216, O_LFP = O_FVP + 16777216, O_SRS = O_LFP + 262144,
                 O_FKS = O_SRS + 1048576, O_FVS = O_FKS + 524288, O_LFS = O_FVS + 524288, O_END = O_LFS + 8192;
constexpr size_t MiB = 1u << 20;
constexpr size_t WS_CTL = 0, WS_SS1 = 64 * 1024, WS_SS2 = 256 * 1024, CTL_BYTES = 512 * 1024;
constexpr size_t WS_CS = 1 * MiB, WS_CB = 3 * MiB, WS_WIN = 4 * MiB, WS_WO = 11 * MiB, WS_WGU = 13 * MiB, WS_WD = 24 * MiB;
constexpr size_t WS_XN = 32 * MiB, WS_MIX = 98 * MiB, WS_Z = 164 * MiB, WS_H = WS_Z, WS_END = 395 * MiB;
constexpr float C2F = 0.125f * 1.4426950408889634f;

struct Params {
    const float *xp, *xs, *ck, *cv, *clf, *sr, *win, *bfg, *gn, *wout, *gmix, *gffn, *wg, *wu, *wd, *gfin;
    float* out; unsigned char* ws;
};

__device__ __forceinline__ int tid_fresh() { int t = threadIdx.x; asm volatile("" : "+v"(t)); return t; }

__device__ __forceinline__ Params fresh_params(const Params& p) {
    Params q = p;
    asm volatile("" : "+s"(q.out), "+s"(q.ws), "+s"(q.ck), "+s"(q.cv), "+s"(q.clf), "+s"(q.sr), "+s"(q.gn));
    return q;
}

namespace pg8 {
#define PG8_LAS __attribute__((address_space(3)))
typedef unsigned short bf16_t;
typedef short bf16x8 __attribute__((ext_vector_type(8)));
typedef float f32x4 __attribute__((ext_vector_type(4)));
typedef unsigned u32x4 __attribute__((ext_vector_type(4)));
constexpr int BM = 256, BK = 64, HALF = 128, HTB = HALF * BK * 2  , STAGE_BYTES = 8 * HTB, NXCD = 8, WGM = 8;

__host__ __device__ __forceinline__ int lds_byte(int r, int c) { const int st = (r >> 4) * 2 + (c >> 5), rr = r & 15, cc = c & 31, ob = rr * 64 + cc * 2; return st * 1024 + (ob ^ (((ob >> 9) & 1) << 5)); }
__host__ __device__ __forceinline__ void stage_rc(int b, int& R, int& C) { const int st = b / 1024, sb = b % 1024, swz = sb ^ (((sb >> 9) & 1) << 5); R = (st >> 1) * 16 + swz / 64; C = (st & 1) * 32 + (swz % 64) / 2; }
__host__ __device__ __forceinline__ int perm32(int rho) { const int n = rho >> 4, i = rho & 15; return 8 * (i >> 2) + 4 * n + (i & 3); }

struct Unit { int pm, pn; };
struct Gemm { const bf16_t* A; const bf16_t* Bt; int M, N, K, ld; };

struct StaticOrder {
    int nM, nN, nwg, G, c;
    __host__ __device__ void init(int M, int N, int G_, int c_) { nM = M / BM; nN = N / BM; nwg = nM * nN; G = G_; c = c_; }
    __host__ __device__ bool next(int i, Unit& u) const {
        const long L = (long)i * G + c; if (L >= nwg) return false;
        int wgid = (int)L; { const int q = nwg / NXCD, r = nwg % NXCD, xcd = wgid % NXCD, off = wgid / NXCD; wgid = (xcd < r ? xcd * (q + 1) : r * (q + 1) + (xcd - r) * q) + off; }
        const int nig = WGM * nN, gid = wgid / nig, fm = gid * WGM, gsz = (nM - fm) < WGM ? (nM - fm) : WGM;
        u.pm = fm + ((wgid % nig) % gsz); u.pn = (wgid % nig) / gsz; return true;
    }
    __device__ __forceinline__ void a_ready(const Unit&) const {}
    __device__ __forceinline__ void done(const Unit&) const {}
};


struct OneUnit { int pm, pn;
    __device__ __forceinline__ bool next(int i, Unit& u) const { if (i) return false; u.pm = pm; u.pn = pn; return true; }
    __device__ __forceinline__ void a_ready(const Unit&) const {}
    __device__ __forceinline__ void done(const Unit&) const {}
};
typedef float f32x2 __attribute__((ext_vector_type(2)));
typedef __bf16 bf16x2_t __attribute__((ext_vector_type(2)));
typedef unsigned u32x2 __attribute__((ext_vector_type(2)));
__device__ __forceinline__ unsigned cvt_pk_bf16(float lo, float hi) { f32x2 v = {lo, hi}; bf16x2_t b = __builtin_convertvector(v, bf16x2_t); return __builtin_bit_cast(unsigned, b); }
__device__ __forceinline__ float silu_f(float x) { return x * __builtin_amdgcn_rcpf(1.f + __builtin_amdgcn_exp2f(x * -1.4426950408889634f)); }

struct EpiInProj {
    static constexpr bool PERM = true, AFTER_DRAIN = false;
    bf16_t* Z; float* out; const float* cs;
    __device__ __forceinline__ void operator()(const f32x4 (&acc)[2][2][4][2], const Unit& u, int wr, int wc, int fr, int fq) const {
        const int pn = u.pn, row0 = u.pm * BM + wr * 64 + fr; const bool prompt = u.pm < (MP / BM);
        if (pn < 4) {
            const float sc = pn < 2 ? 0.08838834764831845f : 1.f; const int d0 = 16 * wc + 4 * fq;
#pragma unroll
            for (int ai = 0; ai < 2; ++ai)
#pragma unroll
                for (int m = 0; m < 4; ++m) { const int row = row0 + ai * HALF + m * 16; const int tix = prompt ? (row & (TSEQ - 1)) : TSEQ + ((row - MP) & (NSMP - 1));
                    const float* cr = cs + (size_t)tix * 128 + 2 * d0; const f32x4 c01 = *(const f32x4*)cr, c23 = *(const f32x4*)(cr + 4);
                    bf16_t* zrow = Z + (size_t)row * NZ + pn * BM + d0;
#pragma unroll
                    for (int bj = 0; bj < 2; ++bj) { const f32x4 v0 = acc[ai][bj][m][0], v1 = acc[ai][bj][m][1];
                        const float a0 = (v0[0] * c01[0] - v0[1] * c01[1]) * sc, b0 = (v0[0] * c01[1] + v0[1] * c01[0]) * sc;
                        const float a1 = (v0[2] * c01[2] - v0[3] * c01[3]) * sc, b1 = (v0[2] * c01[3] + v0[3] * c01[2]) * sc;
                        const float a2 = (v1[0] * c23[0] - v1[1] * c23[1]) * sc, b2 = (v1[0] * c23[1] + v1[1] * c23[0]) * sc;
                        const float a3 = (v1[2] * c23[2] - v1[3] * c23[3]) * sc, b3 = (v1[2] * c23[3] + v1[3] * c23[2]) * sc;
                        u32x2 w1, w2; w1.x = cvt_pk_bf16(a0, a1); w1.y = cvt_pk_bf16(a2, a3); w2.x = cvt_pk_bf16(b0, b1); w2.y = cvt_pk_bf16(b2, b3);
                        *(u32x2*)(zrow + bj * HALF) = w1; *(u32x2*)(zrow + bj * HALF + 64) = w2; } }
        } else {
            const float sc = (pn == 8 || pn == 9) ? C2F : 1.f; const int cw = wc * 32 + 8 * fq;
            float* fo = nullptr; size_t fstride = 512;
            if (pn >= 10) { const bool isv = pn >= 12; const int cb = (pn - (isv ? 12 : 10)) * BM + cw;
                fo = prompt ? out + (isv ? O_FVP : O_FKP) + (size_t)row0 * 512 + cb : out + (isv ? O_FVS : O_FKS) + (size_t)(row0 - MP) * 512 + cb; }
#pragma unroll
            for (int ai = 0; ai < 2; ++ai)
#pragma unroll
                for (int m = 0; m < 4; ++m) { bf16_t* rowp = Z + (size_t)(row0 + ai * HALF + m * 16) * NZ + pn * BM + cw; float* fr_ = fo + (size_t)(ai * HALF + m * 16) * fstride;
#pragma unroll
                    for (int bj = 0; bj < 2; ++bj) { const f32x4 v0 = acc[ai][bj][m][0] * sc, v1 = acc[ai][bj][m][1] * sc;
                        u32x4 w; w.x = cvt_pk_bf16(v0[0], v0[1]); w.y = cvt_pk_bf16(v0[2], v0[3]); w.z = cvt_pk_bf16(v1[0], v1[1]); w.w = cvt_pk_bf16(v1[2], v1[3]);
                        *(u32x4*)(rowp + bj * HALF) = w;
                        if (fo) { __builtin_nontemporal_store(v0, (f32x4*)(fr_ + bj * HALF)); __builtin_nontemporal_store(v1, (f32x4*)(fr_ + bj * HALF + 4)); } } }
        }
    }
};
struct EpiResid {
    static constexpr bool PERM = false, AFTER_DRAIN = false;
    const float* xp; const float* xs; float* Y; bf16_t* Yb; float* ss; const bf16_t* Xb;
    __device__ __forceinline__ void operator()(const f32x4 (&acc)[2][2][4][2], const Unit& u, int wr, int wc, int fr, int fq) const {
        const int row0 = u.pm * BM + wr * 64 + fr, col0 = u.pn * BM + wc * 32 + 4 * fq; const bool prompt = u.pm < (MP / BM);
#pragma unroll
        for (int ai = 0; ai < 2; ++ai)
#pragma unroll
            for (int m = 0; m < 4; ++m) { const int row = row0 + ai * HALF + m * 16; const size_t off = (size_t)row * DM + col0; float* yr = Y ? Y + off : nullptr;
                const float* br = xp ? (prompt ? xp + off : xs + ((size_t)(row - MP) * DM + col0)) : (const float*)yr; float s = 0.f;
#pragma unroll
                for (int bj = 0; bj < 2; ++bj)
#pragma unroll
                    for (int n = 0; n < 2; ++n) { const int co = bj * HALF + n * 16; f32x4 bs;
                        if (Xb) { const u32x2 w = *(const u32x2*)(Xb + off + co); bs = (f32x4){__uint_as_float(w.x << 16), __uint_as_float(w.x & 0xffff0000u), __uint_as_float(w.y << 16), __uint_as_float(w.y & 0xffff0000u)}; }
                        else if (br) bs = *(const f32x4*)(br + co); else bs = (f32x4){0.f, 0.f, 0.f, 0.f};
                        const f32x4 v = acc[ai][bj][m][n] + bs; if (Y) *(f32x4*)(yr + co) = v;
                        s += (v[0] * v[0] + v[1] * v[1]) + (v[2] * v[2] + v[3] * v[3]);
                        if (Yb) { u32x2 w; w.x = cvt_pk_bf16(v[0], v[1]); w.y = cvt_pk_bf16(v[2], v[3]); *(u32x2*)(Yb + off + co) = w; } }
                if (ss) { s += __shfl_xor(s, 16); s += __shfl_xor(s, 32); }
                if (ss && fq == 0) atomicAdd(ss + row, s); }
    }
};
struct EpiGateUp {
    static constexpr bool PERM = true, AFTER_DRAIN = false;
    bf16_t* H; const float* ss;
    __device__ __forceinline__ void operator()(const f32x4 (&acc)[2][2][4][2], const Unit& u, int wr, int wc, int fr, int fq) const {
        const int row0 = u.pm * BM + wr * 64 + fr, f0 = u.pn * 128 + wc * 16 + 4 * fq;
#pragma unroll
        for (int ai = 0; ai < 2; ++ai)
#pragma unroll
            for (int m = 0; m < 4; ++m) { const int row = row0 + ai * HALF + m * 16; const float r = 1.0f / sqrtf(ss[row] * (1.0f / DM) + 1e-6f);
#pragma unroll
                for (int bj = 0; bj < 2; ++bj) { const f32x4 v0 = acc[ai][bj][m][0] * r, v1 = acc[ai][bj][m][1] * r;
                    u32x2 w; w.x = cvt_pk_bf16(silu_f(v0[0]) * v0[1], silu_f(v0[2]) * v0[3]); w.y = cvt_pk_bf16(silu_f(v1[0]) * v1[1], silu_f(v1[2]) * v1[3]);
                    *(u32x2*)(H + (size_t)row * DFF + f0 + bj * 64) = w; } }
    }
};

struct EpiAtomic {
    static constexpr bool PERM = false, AFTER_DRAIN = false;
    float* Y;
    __device__ __forceinline__ void operator()(const f32x4 (&acc)[2][2][4][2], const Unit& u, int wr, int wc, int fr, int fq) const {
        const int row0 = u.pm * BM + wr * 64 + fr, col0 = u.pn * BM + wc * 32 + 4 * fq;
#pragma unroll
        for (int ai = 0; ai < 2; ++ai)
#pragma unroll
            for (int m = 0; m < 4; ++m) { float* yr = Y + (size_t)(row0 + ai * HALF + m * 16) * DM + col0;
#pragma unroll
                for (int bj = 0; bj < 2; ++bj)
#pragma unroll
                    for (int n = 0; n < 2; ++n) { const f32x4 v = acc[ai][bj][m][n]; float* y = yr + bj * HALF + n * 16;
#pragma unroll
                        for (int e = 0; e < 4; ++e) __hip_atomic_fetch_add(y + e, v[e], __ATOMIC_RELAXED, __HIP_MEMORY_SCOPE_AGENT); } }
    }
};

template <class Epi, class Sched, bool ALIGN_EPI = false, bool SP2 = false>
__device__ __forceinline__ void gemm_phase(PG8_LAS unsigned char* lds, const Gemm g, const Sched& S, const Epi& E) {
    const int tid = tid_fresh(), wid = __builtin_amdgcn_readfirstlane(tid >> 6), lane = tid & 63, wr = wid >> 2, wc = wid & 3, fr = lane & 15, fq = lane >> 4;
    const int K = g.ld, nt = g.K / BK;
    unsigned voffA[2], voffB[2];
#pragma unroll
    for (int i = 0; i < 2; ++i) { int R, C; stage_rc(tid * 16 + i * 8192, R, C); const int Rb = Epi::PERM ? ((R & ~31) + perm32(R & 31)) : R;
        voffA[i] = (unsigned)(R * K + C) * 2u; voffB[i] = (unsigned)(Rb * K + C) * 2u; }
    const size_t kstep = (size_t)(BK * 2);
    const size_t hstep = (size_t)HALF * K * 2;
    const size_t tstep = 2 * hstep;
    const unsigned ldsw = (unsigned)wid * 1024u;
    const int aoff = lds_byte(wr * 64 + fr, fq * 8), boff = lds_byte(wc * 32 + fr, fq * 8);
#define PG8_SA(b, h) (((b) * 2 + (h)) * HTB)
#define PG8_SB(b, h) ((4 + (b) * 2 + (h)) * HTB)
#define PG8_STAGE(bufoff, gbase, voff) do { _Pragma("unroll") for (int _i = 0; _i < 2; ++_i) \
        __builtin_amdgcn_global_load_lds((const unsigned*)((const char*)(gbase) + (voff)[_i]), (PG8_LAS unsigned*)(lds + (bufoff) + ldsw + _i * 8192), 16, 0, 0); } while (0)
#define PG8_LDA(dst, b, h) do { _Pragma("unroll") for (int m = 0; m < 4; ++m) _Pragma("unroll") for (int k = 0; k < 2; ++k) dst[m][k] = *(const PG8_LAS bf16x8*)(lds + PG8_SA(b, h) + aoff + m * 2048 + k * 1024); } while (0)
#define PG8_LDB(dst, b, h) do { _Pragma("unroll") for (int n = 0; n < 2; ++n) _Pragma("unroll") for (int k = 0; k < 2; ++k) dst[n][k] = *(const PG8_LAS bf16x8*)(lds + PG8_SB(b, h) + boff + n * 2048 + k * 1024); } while (0)
#define PG8_MMA(ai, bj, At, Bt) do { __builtin_amdgcn_s_setprio(1); _Pragma("unroll") for (int m = 0; m < 4; ++m) _Pragma("unroll") for (int n = 0; n < 2; ++n) _Pragma("unroll") for (int k = 0; k < 2; ++k) \
        acc[ai][bj][m][n] = __builtin_amdgcn_mfma_f32_16x16x32_bf16(Bt[n][k], At[m][k], acc[ai][bj][m][n], 0, 0, 0); __builtin_amdgcn_s_setprio(0); } while (0)
#define PG8_WAIT_V(n) asm volatile("s_waitcnt vmcnt(" #n ")" ::: "memory")
#define PG8_WAIT_L(n) asm volatile("s_waitcnt lgkmcnt(" #n ")" ::: "memory")
#define PG8_BAR __builtin_amdgcn_s_barrier()
#define PG8_SCHED __builtin_amdgcn_sched_barrier(0)
    Unit cur, nxt; int ui = 0;
    if (!S.next(0, cur)) return;
    f32x4 acc[2][2][4][2];
#pragma unroll
    for (int a = 0; a < 2; ++a)
#pragma unroll
        for (int b = 0; b < 2; ++b)
#pragma unroll
            for (int m = 0; m < 4; ++m)
#pragma unroll
                for (int n = 0; n < 2; ++n) acc[a][b][m][n] = (f32x4){0.f, 0.f, 0.f, 0.f};
    bf16x8 At[4][2], B0[2][2], B1[2][2];
    const char* cA = (const char*)g.A + (size_t)cur.pm * tstep; const char* cB = (const char*)g.Bt + (size_t)cur.pn * tstep;
    S.a_ready(cur);
    if constexpr (SP2) {
        PG8_STAGE(PG8_SB(0, 0), cB, voffB); PG8_STAGE(PG8_SB(0, 1), cB + hstep, voffB); PG8_STAGE(PG8_SA(0, 0), cA, voffA); PG8_STAGE(PG8_SA(0, 1), cA + hstep, voffA);
        if (wr == 1) PG8_BAR;
        PG8_WAIT_V(2); PG8_BAR;
        PG8_STAGE(PG8_SB(1, 0), cB + kstep, voffB); PG8_STAGE(PG8_SA(1, 0), cA + kstep, voffA); PG8_STAGE(PG8_SB(1, 1), cB + hstep + kstep, voffB);
        PG8_WAIT_V(6); PG8_BAR;
    } else {
        PG8_STAGE(PG8_SB(0, 0), cB, voffB); PG8_STAGE(PG8_SA(0, 0), cA, voffA); PG8_STAGE(PG8_SB(0, 1), cB + hstep, voffB); PG8_STAGE(PG8_SA(0, 1), cA + hstep, voffA);
        if (wr == 1) PG8_BAR;
        PG8_WAIT_V(4); PG8_BAR;
        PG8_STAGE(PG8_SB(1, 0), cB + kstep, voffB); PG8_STAGE(PG8_SA(1, 0), cA + kstep, voffA); PG8_STAGE(PG8_SB(1, 1), cB + hstep + kstep, voffB);
        PG8_WAIT_V(6); PG8_BAR;
    }
    for (;;) {
        const bool has_next = S.next(ui + 1, nxt);
        const char* nA = has_next ? (const char*)g.A + (size_t)nxt.pm * tstep : cA; const char* nB = has_next ? (const char*)g.Bt + (size_t)nxt.pn * tstep : cB;
        for (int t = 0; t < nt; t += 2) {
            const bool last = (t == nt - 2);
            const char* a1 = cA + (size_t)(t + 1) * kstep;
            const char* a2 = last ? nA : cA + (size_t)(t + 2) * kstep; const char* b2 = last ? nB : cB + (size_t)(t + 2) * kstep;
            const char* a3 = a2 + kstep; const char* b3 = b2 + kstep;
            if (last && has_next) S.a_ready(nxt);
            if constexpr (SP2) {
            PG8_LDB(B0, 0, 0); PG8_LDB(B1, 0, 1); PG8_SCHED; PG8_LDA(At, 0, 0); PG8_STAGE(PG8_SA(1, 1), a1 + hstep, voffA);
            PG8_WAIT_V(8); PG8_WAIT_L(0); PG8_BAR; PG8_MMA(0, 0, At, B0); PG8_MMA(0, 1, At, B1); PG8_BAR; PG8_SCHED;
            PG8_LDA(At, 0, 1); PG8_STAGE(PG8_SB(0, 0), b2, voffB); PG8_STAGE(PG8_SB(0, 1), b2 + hstep, voffB); PG8_STAGE(PG8_SA(0, 0), a2, voffA);
            PG8_WAIT_V(8); PG8_WAIT_L(0); PG8_BAR; PG8_MMA(1, 0, At, B0); PG8_MMA(1, 1, At, B1); PG8_BAR; PG8_SCHED;
            PG8_LDB(B0, 1, 0); PG8_LDB(B1, 1, 1); PG8_SCHED; PG8_LDA(At, 1, 0); PG8_STAGE(PG8_SA(0, 1), a2 + hstep, voffA);
            PG8_WAIT_V(8); PG8_WAIT_L(0); PG8_BAR; PG8_MMA(0, 0, At, B0); PG8_MMA(0, 1, At, B1); PG8_BAR; PG8_SCHED;
            PG8_LDA(At, 1, 1); PG8_STAGE(PG8_SB(1, 0), b3, voffB); PG8_STAGE(PG8_SB(1, 1), b3 + hstep, voffB); PG8_STAGE(PG8_SA(1, 0), a3, voffA);
            PG8_WAIT_V(8); PG8_WAIT_L(0); PG8_BAR; PG8_MMA(1, 0, At, B0); PG8_MMA(1, 1, At, B1); PG8_BAR; PG8_SCHED;
            } else {
            PG8_LDB(B0, 0, 0); PG8_SCHED; PG8_LDA(At, 0, 0); PG8_STAGE(PG8_SA(1, 1), a1 + hstep, voffA);
            PG8_WAIT_L(8); PG8_BAR; PG8_WAIT_L(0); PG8_MMA(0, 0, At, B0); PG8_BAR; PG8_SCHED;
            PG8_LDB(B1, 0, 1); PG8_STAGE(PG8_SB(0, 0), b2, voffB);
            PG8_BAR; PG8_WAIT_L(0); PG8_MMA(0, 1, At, B1); PG8_BAR;
            PG8_LDA(At, 0, 1); PG8_STAGE(PG8_SA(0, 0), a2, voffA);
            PG8_BAR; PG8_WAIT_L(0); PG8_MMA(1, 0, At, B0); PG8_BAR; PG8_SCHED;
            PG8_STAGE(PG8_SB(0, 1), b2 + hstep, voffB);
            PG8_WAIT_V(6); PG8_BAR; PG8_MMA(1, 1, At, B1); PG8_BAR;
            PG8_LDB(B0, 1, 0); PG8_SCHED; PG8_LDA(At, 1, 0); PG8_STAGE(PG8_SA(0, 1), a2 + hstep, voffA);
            PG8_WAIT_L(8); PG8_BAR; PG8_WAIT_L(0); PG8_MMA(0, 0, At, B0); PG8_BAR; PG8_SCHED;
            PG8_LDB(B1, 1, 1); PG8_STAGE(PG8_SB(1, 0), b3, voffB);
            PG8_BAR; PG8_WAIT_L(0); PG8_MMA(0, 1, At, B1); PG8_BAR;
            PG8_LDA(At, 1, 1); PG8_STAGE(PG8_SA(1, 0), a3, voffA);
            PG8_BAR; PG8_WAIT_L(0); PG8_MMA(1, 0, At, B0); PG8_BAR; PG8_SCHED;
            PG8_STAGE(PG8_SB(1, 1), b3 + hstep, voffB);
            PG8_WAIT_V(6); PG8_BAR; PG8_MMA(1, 1, At, B1); PG8_BAR;
            }
        }
        if constexpr (ALIGN_EPI) { if (wr == 0) PG8_BAR; }
        if constexpr (!Epi::AFTER_DRAIN) { E(acc, cur, wr, wc, fr, fq); S.done(cur); }
        if (!has_next) break;
#pragma unroll
        for (int a = 0; a < 2; ++a)
#pragma unroll
            for (int b = 0; b < 2; ++b)
#pragma unroll
                for (int m = 0; m < 4; ++m)
#pragma unroll
                    for (int n = 0; n < 2; ++n) acc[a][b][m][n] = (f32x4){0.f, 0.f, 0.f, 0.f};
        cur = nxt; cA = nA; cB = nB; ++ui;
        if constexpr (ALIGN_EPI) { if (wr == 1) PG8_BAR; }
    }
    PG8_WAIT_V(0);
    if constexpr (!ALIGN_EPI) { if (wr == 0) PG8_BAR; }
    PG8_BAR;
    if constexpr (Epi::AFTER_DRAIN) { E.fused(acc, cur, wr, wc, fr, fq, lds, wid, lane); S.done(cur); }
#undef PG8_SA
#undef PG8_SB
#undef PG8_STAGE
#undef PG8_LDA
#undef PG8_LDB
#undef PG8_MMA
#undef PG8_WAIT_V
#undef PG8_WAIT_L
#undef PG8_BAR
#undef PG8_SCHED
}
}
#include <hip/hip_bf16.h>
#include <cmath>
namespace attn_body {
using bf16=__hip_bfloat16;
using bf16x8=__attribute__((ext_vector_type(8)))short;
using s16x4=__attribute__((ext_vector_type(4)))short;
using f32x16=__attribute__((ext_vector_type(16)))float;
using u32x4=__attribute__((ext_vector_type(4)))unsigned;
using f32x4b=__attribute__((ext_vector_type(4)))float;
constexpr int BATCH=16,NHEAD=8,SEQ=2048,D=64,PQ=3584,PO=1024;
constexpr int NW=8,QBLK=32,QB=QBLK*NW,KVBLK=64,NQB=SEQ/QB;
constexpr int ATTN_UNIT_ROWS=QB;
__device__ __forceinline__ int crow(int r,int hi){return (r&3)+8*(r>>2)+4*hi;}
#define SBAR() __builtin_amdgcn_sched_barrier(0)
__device__ __forceinline__ void cmask(f32x16&p0,f32x16&p1,int jb,int qrel,int hi){
  const float NEG=-INFINITY; int kb=64*jb+4*hi;
  #pragma unroll
  for(int r=0;r<16;++r){int kv=kb+(r&3)+8*(r>>2); if(kv>qrel)p0[r]=NEG; if(kv+32>qrel)p1[r]=NEG;}
}

constexpr int NSLOT=3, SLOTB=8192;
constexpr int LDS_K=0, LDS_V=NSLOT*SLOTB, LDS_WS=2*NSLOT*SLOTB, LDS_OST=LDS_WS+NW*64*4, LDS_BIAS=LDS_OST+NW*4096, LDS_BYTES=LDS_BIAS+SEQ*4;
constexpr float C2=0.125f*1.4426950408889634f;
__device__ __forceinline__ void glds16(const void*gsrc,unsigned lds_dst){unsigned keep;
  asm volatile("s_mov_b32 %0, m0\n\ts_mov_b32 m0, %2\n\ts_nop 0\n\tglobal_load_lds_dwordx4 %1, off\n\ts_mov_b32 m0, %0":"=&s"(keep):"v"(gsrc),"s"(lds_dst):"memory");}
__device__ __forceinline__ float max3f(float a,float b,float c){float r;asm("v_max3_f32 %0, %1, %2, %3":"=v"(r):"v"(a),"v"(b),"v"(c));return r;}
__device__ __forceinline__ float max2f(float a,float b){float r;asm("v_max_f32_e32 %0, %1, %2":"=v"(r):"v"(a),"v"(b));return r;}
__device__ __forceinline__ float fadd_s(float a,float b){float r;asm("v_add_f32_e32 %0, %1, %2":"=v"(r):"v"(a),"v"(b));return r;}
__device__ __forceinline__ float fsub_s(float a,float b){float r;asm("v_sub_f32_e32 %0, %1, %2":"=v"(r):"v"(a),"v"(b));return r;}
typedef float f32x2_t __attribute__((ext_vector_type(2))); typedef __bf16 bf16x2_t __attribute__((ext_vector_type(2)));
__device__ __forceinline__ unsigned cvtpk_s(float lo,float hi){f32x2_t v={lo,hi};bf16x2_t b=__builtin_convertvector(v,bf16x2_t);return __builtin_bit_cast(unsigned,b);}
#define WAIT_BAR(N) asm volatile("s_waitcnt vmcnt(" #N ") lgkmcnt(0)\n\ts_barrier":::"memory")

__device__ __forceinline__ void qkt(f32x16&p0,f32x16&p1,const char*Kslot,const bf16x8*qr,const f32x16&negm,int r32,int hi){
  const char*kb=Kslot+hi*1024+r32*16;
  #pragma unroll
  for(int d0=0;d0<4;++d0){
    const bf16x8 b0=*reinterpret_cast<const bf16x8*>(kb+d0*2048);
    const bf16x8 b1=*reinterpret_cast<const bf16x8*>(kb+d0*2048+512);
    if(d0==0){p0=__builtin_amdgcn_mfma_f32_32x32x16_bf16(b0,qr[0],negm,0,0,0);p1=__builtin_amdgcn_mfma_f32_32x32x16_bf16(b1,qr[0],negm,0,0,0);}
    else{p0=__builtin_amdgcn_mfma_f32_32x32x16_bf16(b0,qr[d0],p0,0,0,0);p1=__builtin_amdgcn_mfma_f32_32x32x16_bf16(b1,qr[d0],p1,0,0,0);}}
}
typedef __attribute__((address_space(3))) const char* lds_cptr;
typedef short v4i16_t __attribute__((ext_vector_type(4)));
__device__ __forceinline__ void kload8(bf16x8*kf,lds_cptr kp){
  kf[0]=*(const __attribute__((address_space(3))) bf16x8*)(kp);      kf[1]=*(const __attribute__((address_space(3))) bf16x8*)(kp+512);
  kf[2]=*(const __attribute__((address_space(3))) bf16x8*)(kp+2048); kf[3]=*(const __attribute__((address_space(3))) bf16x8*)(kp+2560);
  kf[4]=*(const __attribute__((address_space(3))) bf16x8*)(kp+4096); kf[5]=*(const __attribute__((address_space(3))) bf16x8*)(kp+4608);
  kf[6]=*(const __attribute__((address_space(3))) bf16x8*)(kp+6144); kf[7]=*(const __attribute__((address_space(3))) bf16x8*)(kp+6656);
}
__device__ __forceinline__ void kload2(bf16x8*kf,lds_cptr kp,int j){ kf[2*j]=*(const __attribute__((address_space(3))) bf16x8*)(kp+j*2048); kf[2*j+1]=*(const __attribute__((address_space(3))) bf16x8*)(kp+j*2048+512); }
__device__ __forceinline__ s16x4 vtr(lds_cptr p){ return __builtin_bit_cast(s16x4,__builtin_amdgcn_ds_read_tr16_b64_v4i16((__attribute__((address_space(3))) v4i16_t*)p)); }
__device__ __forceinline__ float rowmax(const f32x16&p0,const f32x16&p1){
  float a=max3f(p0[0],p0[1],p1[0]),b=max3f(p0[2],p0[3],p1[1]);a=max3f(a,p1[2],p1[3]);
  #pragma unroll
  for(int r=4;r<16;r+=4){a=max3f(a,p0[r],p0[r+1]);b=max3f(b,p0[r+2],p0[r+3]);a=max3f(a,p1[r],p1[r+1]);b=max3f(b,p1[r+2],p1[r+3]);}
  const float m=max2f(a,b);
  auto rr=__builtin_amdgcn_permlane32_swap(__float_as_uint(m),__float_as_uint(m),false,false);
  return max2f(__uint_as_float(rr[0]),__uint_as_float(rr[1]));
}
__device__ __forceinline__ void pv(f32x16*o,int vb,bf16x8 pa0,bf16x8 pa1,bf16x8 pa2,bf16x8 pa3){
  #pragma unroll
  for(int d0=0;d0<2;++d0){s16x4 lo[4],hi[4];
    #pragma unroll
    for(int ks=0;ks<4;++ks){
      asm volatile("ds_read_b64_tr_b16 %0,%1 offset:%c2":"=&v"(lo[ks]):"v"(vb),"i"(d0*4096+ks*1024):"memory");
      asm volatile("ds_read_b64_tr_b16 %0,%1 offset:%c2":"=&v"(hi[ks]):"v"(vb),"i"(d0*4096+ks*1024+512):"memory");}
    asm volatile("s_waitcnt lgkmcnt(0)":::"memory");SBAR();
    #define PK(k) (bf16x8){lo[k][0],lo[k][1],lo[k][2],lo[k][3],hi[k][0],hi[k][1],hi[k][2],hi[k][3]}
    o[d0]=__builtin_amdgcn_mfma_f32_32x32x16_bf16(pa0,PK(0),o[d0],0,0,0);
    o[d0]=__builtin_amdgcn_mfma_f32_32x32x16_bf16(pa1,PK(1),o[d0],0,0,0);
    o[d0]=__builtin_amdgcn_mfma_f32_32x32x16_bf16(pa2,PK(2),o[d0],0,0,0);
    o[d0]=__builtin_amdgcn_mfma_f32_32x32x16_bf16(pa3,PK(3),o[d0],0,0,0);
    #undef PK
  }
}

#ifndef ATTN_STORE16
#define ATTN_STORE16(p,v) (*(u32x4*)(p)=(v))
#endif
template<int THRL> __device__ __forceinline__ void attn_unit(int b,int h,int qb,const bf16*Q,const bf16*__restrict__ K,const bf16*__restrict__ V,bf16*O,const float*__restrict__ CB,char*shm){
  const int tid=tid_fresh(),lane=tid&63,r32=lane&31,hi=lane>>5; const int wid=__builtin_amdgcn_readfirstlane(tid>>6);
  const long rowbase=(long)b*SEQ; const int q0=qb*QB;
  const bf16*Qw=Q+(rowbase+q0+wid*QBLK)*PQ+h*D;
  const bf16*Kh=K+rowbase*PQ+h*D,*Vh=V+rowbase*PQ+h*D;
  const unsigned lds0=(unsigned)(uintptr_t)shm;
  float*wsf=(float*)(shm+LDS_WS)+wid*64;
  const bf16*ksrc=Kh+(long)lane*PQ+wid*8;
  const bf16*vsrc=Vh+(long)(16*(wid&3)+(lane>>2))*PQ+(wid>>2)*32+(lane&3)*8;
  const unsigned kdst=lds0+LDS_K+wid*1024, vdst=lds0+LDS_V+wid*1024;
  #define DMA_K(t,slot) glds16(ksrc+(long)(t)*KVBLK*PQ,(unsigned)__builtin_amdgcn_readfirstlane(kdst+(slot)))
  #define DMA_V(t,slot) glds16(vsrc+(long)(t)*KVBLK*PQ,(unsigned)__builtin_amdgcn_readfirstlane(vdst+(slot)))
  const int vb0=(int)(lds0+LDS_V)+((lane>>4)&1)*32+(lane&3)*8+(4*hi+((lane&15)>>2))*64;
  const char*Kbase=shm+LDS_K; bf16x8 kf[8];
  const lds_cptr shm3=(lds_cptr)shm; const lds_cptr kp0=shm3+LDS_K+hi*1024+r32*16; const lds_cptr vp0=shm3+LDS_V+((lane>>4)&1)*32+(lane&3)*8+(4*hi+((lane&15)>>2))*64;
  const int NT=(q0+QB)/KVBLK;
  { const float*cb=CB+(long)(b*NHEAD+h)*SEQ; float*bl=(float*)(shm+LDS_BIAS); for(int i=tid;i<NT*KVBLK;i+=NW*64)bl[i]=cb[i]*(-1.4426950408889634f); }
  const lds_cptr bp0=(lds_cptr)shm+LDS_BIAS+hi*16;
  #define KBIAS(P0,P1,t) do{ const lds_cptr bp_=bp0+(t)*256; _Pragma("unroll") for(int g_=0;g_<4;++g_){ const f32x4b a_=*(const __attribute__((address_space(3))) f32x4b*)(bp_+g_*32); const f32x4b c_=*(const __attribute__((address_space(3))) f32x4b*)(bp_+128+g_*32); \
      P0[4*g_]+=a_[0];P0[4*g_+1]+=a_[1];P0[4*g_+2]+=a_[2];P0[4*g_+3]+=a_[3]; P1[4*g_]+=c_[0];P1[4*g_+1]+=c_[1];P1[4*g_+2]+=c_[2];P1[4*g_+3]+=c_[3]; } }while(0)
  DMA_K(0,0);DMA_V(0,0);DMA_K(1,SLOTB);
  bf16x8 qr[4];
  #pragma unroll
  for(int d0=0;d0<4;++d0)qr[d0]=*reinterpret_cast<const bf16x8*>(&Qw[(long)r32*PQ+d0*16+hi*8]);
  float mhat=0.f,l_reg=0.f;f32x16 o[2];o[0]=f32x16{};o[1]=f32x16{};f32x16 negm=f32x16{};asm volatile("":"+v"(negm));
  const int qrel=wid*QBLK+r32;
  #define CMASK(P0,P1,t) do{int jb_=(t)-(NT-4); if(jb_>=0)cmask(P0,P1,jb_,qrel,hi);}while(0)
  bool resc=false;
  #define START(P0,P1) do{ const float rm=rowmax(P0,P1); resc=false; \
    { const float dl=rm; mhat=fadd_s(mhat,dl); \
      _Pragma("unroll") for(int r=0;r<16;++r){P0[r]=fsub_s(P0[r],dl);P1[r]=fsub_s(P1[r],dl);} \
      _Pragma("unroll") for(int r=0;r<16;++r)negm[r]=-mhat; asm volatile("":"+v"(negm)); } \
    _Pragma("unroll") for(int r=0;r<16;++r)P0[r]=__builtin_amdgcn_exp2f(P0[r]); }while(0)
  #define RESC() do{ if(resc){ asm volatile("s_waitcnt lgkmcnt(0)":::"memory"); \
      _Pragma("unroll") for(int d_=0;d_<2;++d_) _Pragma("unroll") for(int r=0;r<16;++r)o[d_][r]*=wsf[crow(r,hi)]; } }while(0)
  f32x16 pA0,pA1,pB0,pB1;
  int sl_prev=0,sl_cur=0,sl_next=SLOTB;
  #define ROT() do{sl_prev=sl_cur;sl_cur=sl_next;sl_next=(sl_next==(NSLOT-1)*SLOTB)?0:sl_next+SLOTB;}while(0)
  DMA_K(2,2*SLOTB);
  WAIT_BAR(3);
  qkt(pA0,pA1,Kbase,qr,negm,r32,hi);KBIAS(pA0,pA1,0);asm volatile("s_nop 15\n\ts_nop 7":"+v"(pA0),"+v"(pA1));CMASK(pA0,pA1,0);
  START(pA0,pA1);
  _Pragma("unroll") for(int r=0;r<16;++r)pA1[r]=__builtin_amdgcn_exp2f(pA1[r]);
  WAIT_BAR(0);
  DMA_K(3,0);DMA_V(1,SLOTB);
  ROT();
  kload8(kf,kp0+sl_cur);
  WAIT_BAR(2);
  s16x4 vlo[8],vhi[8]; u32x4 pw0,pw1,pw2,pw3;
  #define PKW(P,B) cvtpk_s(P[B],P[B+1])
  #define PAF(k) __builtin_bit_cast(bf16x8,pw##k)
  #define VFR(i) (bf16x8){vlo[i][0],vlo[i][1],vlo[i][2],vlo[i][3],vhi[i][0],vhi[i][1],vhi[i][2],vhi[i][3]}
  #define PIN(x) asm volatile("":"+v"(x))
  #define MX3(a,b,c) __builtin_fmaxf(__builtin_fmaxf((a),(b)),(c))
  #define GAPA(MF,A0,A1,A2,A3,W0,W1,PW) do{ MF; sacc+=A0; sacc+=A1; sacc+=A2; sacc+=A3; PIN(sacc); W0; W1; PIN(PW); SBAR(); }while(0)
  #define EX(v) __builtin_amdgcn_exp2f(v)
  #define GAPB(MF,X,B) do{ MF; X[B]=EX(X[B]); X[B+1]=EX(X[B+1]); X[B+2]=EX(X[B+2]); X[B+3]=EX(X[B+3]); PIN(X); SBAR(); }while(0)
  #define VRD(i) do{ vlo[i]=vtr(vp_+(((i)>>2)*4096+((i)&3)*1024)); vhi[i]=vtr(vp_+(((i)>>2)*4096+((i)&3)*1024+512)); }while(0)
  #define KRD(G,j) do{ if(G){ kload2(kf,kp0+sl_next,j); SBAR(); } }while(0)
  #define STEP(C0,C1,P0,P1,t,GK,GV,GL) do{ SBAR(); \
    const lds_cptr vp_=vp0+sl_prev; \
    VRD(0); SBAR(); float sacc=(P0[0]+P0[1]); \
    GAPA(C0=__builtin_amdgcn_mfma_f32_32x32x16_bf16(kf[0],qr[0],negm,0,0,0), P0[2],P0[3],P0[4],P0[5],     pw0[0]=PKW(P0,0), pw0[1]=PKW(P0,2), pw0); \
    VRD(4); SBAR(); GAPA(C1=__builtin_amdgcn_mfma_f32_32x32x16_bf16(kf[1],qr[0],negm,0,0,0), P0[6],P0[7],P0[8],P0[9],     pw0[2]=PKW(P0,4), pw0[3]=PKW(P0,6), pw0); \
    VRD(1); SBAR(); GAPA(C0=__builtin_amdgcn_mfma_f32_32x32x16_bf16(kf[2],qr[1],C0,0,0,0),   P0[10],P0[11],P0[12],P0[13], pw1[0]=PKW(P0,8), pw1[1]=PKW(P0,10), pw1); \
    VRD(5); SBAR(); GAPA(C1=__builtin_amdgcn_mfma_f32_32x32x16_bf16(kf[3],qr[1],C1,0,0,0),   P0[14],P0[15],P1[0],P1[1],   pw1[2]=PKW(P0,12),pw1[3]=PKW(P0,14), pw1); \
    VRD(2); SBAR(); GAPA(C0=__builtin_amdgcn_mfma_f32_32x32x16_bf16(kf[4],qr[2],C0,0,0,0),   P1[2],P1[3],P1[4],P1[5],     pw2[0]=PKW(P1,0), pw2[1]=PKW(P1,2), pw2); \
    VRD(6); SBAR(); GAPA(C1=__builtin_amdgcn_mfma_f32_32x32x16_bf16(kf[5],qr[2],C1,0,0,0),   P1[6],P1[7],P1[8],P1[9],     pw2[2]=PKW(P1,4), pw2[3]=PKW(P1,6), pw2); \
    VRD(3); SBAR(); GAPA(C0=__builtin_amdgcn_mfma_f32_32x32x16_bf16(kf[6],qr[3],C0,0,0,0),   P1[10],P1[11],P1[12],P1[13], pw3[0]=PKW(P1,8), pw3[1]=PKW(P1,10), pw3); \
    VRD(7); SBAR(); GAPA(C1=__builtin_amdgcn_mfma_f32_32x32x16_bf16(kf[7],qr[3],C1,0,0,0),   P1[14],P1[15],0.f,0.f,       pw3[2]=PKW(P1,12),pw3[3]=PKW(P1,14), pw3); \
    l_reg+=sacc; \
    if(GK){DMA_K((t)+3,sl_cur);} if(GV){DMA_V((t)+1,sl_next);} \
    KBIAS(C0,C1,t); CMASK(C0,C1,t); \
    { float a=MX3(C0[0],C0[1],C1[0]),b=MX3(C0[2],C0[3],C1[1]); a=MX3(a,C1[2],C1[3]); \
      _Pragma("unroll") for(int r=4;r<16;r+=4){a=MX3(a,C0[r],C0[r+1]);b=MX3(b,C0[r+2],C0[r+3]);a=MX3(a,C1[r],C1[r+1]);b=MX3(b,C1[r+2],C1[r+3]);} \
      float rm=__builtin_fmaxf(a,b); { auto rr=__builtin_amdgcn_permlane32_swap(__float_as_uint(rm),__float_as_uint(rm),false,false); rm=__builtin_fmaxf(__uint_as_float(rr[0]),__uint_as_float(rr[1])); } \
      resc=false; \
      if(__builtin_expect(__any(rm>(float)THRL),0)){ const float dl=__builtin_fmaxf(rm,0.f); mhat+=dl; \
        _Pragma("unroll") for(int r=0;r<16;++r){C0[r]-=dl;C1[r]-=dl;} \
        _Pragma("unroll") for(int r=0;r<16;++r)negm[r]=-mhat; asm volatile("":"+v"(negm)); \
        const float f=__builtin_amdgcn_exp2f(-dl); l_reg*=f; if(hi==0)wsf[r32]=f; resc=true; } } \
    SBAR(); \
    GAPB(o[0]=__builtin_amdgcn_mfma_f32_32x32x16_bf16(PAF(0),VFR(0),o[0],0,0,0), C0,0); \
    GAPB(o[1]=__builtin_amdgcn_mfma_f32_32x32x16_bf16(PAF(0),VFR(4),o[1],0,0,0), C0,4); \
    KRD(GL,0); GAPB(o[0]=__builtin_amdgcn_mfma_f32_32x32x16_bf16(PAF(1),VFR(1),o[0],0,0,0), C0,8); \
    KRD(GL,1); GAPB(o[1]=__builtin_amdgcn_mfma_f32_32x32x16_bf16(PAF(1),VFR(5),o[1],0,0,0), C0,12); \
    KRD(GL,2); GAPB(o[0]=__builtin_amdgcn_mfma_f32_32x32x16_bf16(PAF(2),VFR(2),o[0],0,0,0), C1,0); \
    KRD(GL,3); GAPB(o[1]=__builtin_amdgcn_mfma_f32_32x32x16_bf16(PAF(2),VFR(6),o[1],0,0,0), C1,4); \
    GAPB(o[0]=__builtin_amdgcn_mfma_f32_32x32x16_bf16(PAF(3),VFR(3),o[0],0,0,0), C1,8); \
    GAPB(o[1]=__builtin_amdgcn_mfma_f32_32x32x16_bf16(PAF(3),VFR(7),o[1],0,0,0), C1,12); \
    }while(0)
  int t=1;
  #undef CMASK
  #define CMASK(P0,P1,t) do{}while(0)
  for(;t+5<NT;t+=2){
    STEP(pB0,pB1,pA0,pA1,t,true,true,true);     WAIT_BAR(2); RESC(); ROT();
    STEP(pA0,pA1,pB0,pB1,t+1,true,true,true);   WAIT_BAR(2); RESC(); ROT();
  }
  #undef CMASK
  #define CMASK(P0,P1,t) do{int jb_=(t)-(NT-4); if(jb_>=0)cmask(P0,P1,jb_,qrel,hi);}while(0)
  #define ENDW(tt) do{ if((tt)+3<NT){WAIT_BAR(2);} else if((tt)+2<NT){WAIT_BAR(1);} else {WAIT_BAR(0);} }while(0)
  for(;t+1<NT;t+=2){
    STEP(pB0,pB1,pA0,pA1,t,(t+3<NT),(t+1<NT),(t+1<NT));       ENDW(t);   RESC(); ROT();
    STEP(pA0,pA1,pB0,pB1,t+1,(t+4<NT),(t+2<NT),(t+2<NT));     ENDW(t+1); RESC(); ROT();
  }
  STEP(pB0,pB1,pA0,pA1,NT-1,false,false,false); RESC();
  { float sacc=pB0[0]+pB0[1]; _Pragma("unroll") for(int r=2;r<16;++r)sacc+=pB0[r]; _Pragma("unroll") for(int r=0;r<16;++r)sacc+=pB1[r]; l_reg+=sacc;
    pw0=(u32x4){PKW(pB0,0),PKW(pB0,2),PKW(pB0,4),PKW(pB0,6)};pw1=(u32x4){PKW(pB0,8),PKW(pB0,10),PKW(pB0,12),PKW(pB0,14)};pw2=(u32x4){PKW(pB1,0),PKW(pB1,2),PKW(pB1,4),PKW(pB1,6)};pw3=(u32x4){PKW(pB1,8),PKW(pB1,10),PKW(pB1,12),PKW(pB1,14)};
    SBAR(); pv(o,vb0+sl_cur,PAF(0),PAF(1),PAF(2),PAF(3)); }
  #undef PKW
  #undef PAF
  #undef VFR
  #undef PIN
  #undef MX3
  #undef GAPA
  #undef GAPB
  #undef EX
  #undef VRD
  #undef KRD
  #undef STEP
  #undef ENDW
  {auto rr=__builtin_amdgcn_permlane32_swap(__float_as_uint(l_reg),__float_as_uint(l_reg),false,false);l_reg=__uint_as_float(rr[0])+__uint_as_float(rr[1]);}
  if(hi==0)wsf[32+r32]=l_reg;asm volatile("s_waitcnt lgkmcnt(0)":::"memory");
  float rli[16];
  #pragma unroll
  for(int r=0;r<16;++r)rli[r]=__builtin_amdgcn_rcpf(wsf[32+crow(r,hi)]);
  bf16*Ow=O+(rowbase+q0+wid*QBLK)*PO+h*D;
  { bf16*stg=(bf16*)(shm+LDS_OST)+wid*2048;
    #pragma unroll
    for(int r=0;r<16;++r){const int orow=crow(r,hi);
      #pragma unroll
      for(int d0=0;d0<2;++d0)stg[orow*64+d0*32+r32]=__float2bfloat16(o[d0][r]*rli[r]);}
    asm volatile("s_waitcnt lgkmcnt(0)":::"memory");
    #pragma unroll
    for(int i=0;i<4;++i){const int row=i*8+(lane>>3),ch=lane&7; const u32x4 v=*(const u32x4*)(stg+row*64+ch*8); ATTN_STORE16(Ow+(long)row*PO+ch*8,v);} }
  asm volatile("s_waitcnt lgkmcnt(0)\n\ts_barrier":::"memory");
  #undef KBIAS
  #undef DMA_K
  #undef DMA_V
  #undef CMASK
  #undef START
  #undef RESC
  #undef ROT
}
constexpr int ATTN_LDS_BYTES=LDS_BYTES;
#undef SBAR
#undef WAIT_BAR
}
#define LAS __attribute__((address_space(3)))
typedef unsigned short bf16;
typedef unsigned u32x4 __attribute__((ext_vector_type(4)));
typedef unsigned u32x2 __attribute__((ext_vector_type(2)));
typedef float f32x4 __attribute__((ext_vector_type(4)));
typedef float f32x2 __attribute__((ext_vector_type(2)));
typedef float f32x16 __attribute__((ext_vector_type(16)));
typedef short bf16x8 __attribute__((ext_vector_type(8)));
#define RLX_AGENT __ATOMIC_RELAXED, __HIP_MEMORY_SCOPE_AGENT
constexpr int NWAVES = 8, NTHR = 512;
constexpr int LDS_BYTES = 147456, MISC_OFF = 131072 + 8192;
constexpr float LOG2E = 1.4426950408889634f;
__device__ __forceinline__ unsigned pk2(float lo, float hi) { return pg8::cvt_pk_bf16(lo, hi); }
__device__ __forceinline__ float bf2f(unsigned u16) { return __uint_as_float(u16 << 16); }
__device__ __forceinline__ int crow(int r, int hi) { return (r & 3) + 8 * (r >> 2) + 4 * hi; }
__device__ __forceinline__ float wave_sum(float v) {
#pragma unroll
    for (int o = 1; o < 64; o <<= 1) v += __shfl_xor(v, o);
    return v;
}
__device__ __forceinline__ void sincos_cw(float x, float& s, float& c) {
    const float k = rintf(x * 0.636619772367581343f);
    float r = fmaf(k, -1.5703125f, x); r = fmaf(k, -4.837512969970703125e-4f, r); r = fmaf(k, -7.54978995489188216e-8f, r);
    const float z = r * r;
    const float sp = r + r * z * (-1.6666654611e-1f + z * (8.3321608736e-3f + z * -1.9515295891e-4f));
    const float cp = 1.0f - 0.5f * z + z * z * (4.166664568298827e-2f + z * (-1.388731625493765e-3f + z * 2.443315711809948e-5f));
    const int q = ((int)k) & 3;
    s = (q == 0) ? sp : (q == 1) ? cp : (q == 2) ? -sp : -cp;
    c = (q == 0) ? cp : (q == 1) ? -sp : (q == 2) ? -cp : sp;
}
__device__ __forceinline__ float block_scan(float v, float& tot, LAS float* scr, int lane, int wid) {
#pragma unroll
    for (int o = 1; o < 64; o <<= 1) { const float n = __shfl_up(v, o); if (lane >= o) v += n; }
    if (lane == 63) scr[wid] = v;
    __syncthreads();
    float off = 0.f; tot = 0.f;
#pragma unroll
    for (int w = 0; w < NWAVES; ++w) { const float x = scr[w]; if (w < wid) off += x; tot += x; }
    __syncthreads();
    return v + off;
}

template <int MODE> __device__ __forceinline__ int rowmap(int n) {
    if (MODE == 1) return n < 1024 ? ((n & ~127) | ((n & 63) << 1) | ((n >> 6) & 1)) : n;
    if (MODE == 2) return 2 * n;
    if (MODE == 3) return 2 * n + 1;
    return n;
}
template <int MODE> __device__ __forceinline__ void p0_transpose_item(const float* W, int ldw, int K, int N, const float* ks, bf16* WT, LAS float* scr, int item, int lane) {
    const int nblk = N / 32, kb = item / nblk, nb = item % nblk, k0 = 64 * kb, n0 = 32 * nb;
#pragma unroll
    for (int i = 0; i < 32; ++i) { const int kk = 2 * i + (lane >> 5); float w = W[(size_t)(k0 + kk) * ldw + n0 + (lane & 31)]; if (ks) w *= ks[k0 + kk]; scr[kk * 33 + (lane & 31)] = w; }
    asm volatile("s_waitcnt lgkmcnt(0)" ::: "memory");
    const int c = lane & 7;
#pragma unroll
    for (int j = 0; j < 4; ++j) { const int n = (lane >> 3) + 8 * j; const LAS float* s = scr + (8 * c) * 33 + n;
        u32x4 o; o.x = pk2(s[0 * 33], s[1 * 33]); o.y = pk2(s[2 * 33], s[3 * 33]); o.z = pk2(s[4 * 33], s[5 * 33]); o.w = pk2(s[6 * 33], s[7 * 33]);
        *(u32x4*)(WT + (size_t)rowmap<MODE>(n0 + n) * K + k0 + 8 * c) = o; }
    asm volatile("s_waitcnt lgkmcnt(0)" ::: "memory");
}
__device__ __forceinline__ void p0_prep(const Params& p, LAS unsigned char* lds, int vcu, int G) {
    const int tid = tid_fresh(), lane = tid & 63, wid = __builtin_amdgcn_readfirstlane(tid >> 6);
    unsigned char* ws = p.ws;
    for (int i = blockIdx.x * NTHR + tid; i < (int)(CTL_BYTES / 4); i += G * NTHR) if (i < 4096 || i >= 4096 + 3456) ((unsigned*)(ws + WS_CTL))[i] = 0u;
    { float* cs = (float*)(ws + WS_CS);
      for (int i = blockIdx.x * NTHR + tid; i < (TSEQ + NSMP) * 64; i += G * NTHR) { const int tix = i >> 6, d = i & 63; const float pos = (float)(tix < TSEQ ? tix : PAST + tix - TSEQ);
          const float inv = exp2f((float)d * (-13.287712379549449f / 64.0f)); float s, c; sincos_cw(pos * inv, s, c); cs[2 * i] = c; cs[2 * i + 1] = s; } }
    LAS float* scr = (LAS float*)(lds + wid * 16384);
    const int gw = vcu * NWAVES + wid, NGW = G * NWAVES;
    constexpr int I_IN = (DM / 64) * (NZ / 32), I_O = (DM / 64) * (DM / 32), I_G = (DM / 64) * (DFF / 32), I_D = (DFF / 64) * (DM / 32);
#ifndef REP_P0T
#define REP_P0T 1
#endif
    for (int rept = 0; rept < REP_P0T; ++rept)
    for (int it = gw; it < I_IN + I_O + 2 * I_G + I_D; it += NGW) {
        int r = it;
        if (r < I_IN) { p0_transpose_item<1>(p.win, DIN, DM, NZ, nullptr, (bf16*)(ws + WS_WIN), scr, r, lane); continue; } r -= I_IN;
        if (r < I_O) { p0_transpose_item<0>(p.wout, DM, DM, DM, nullptr, (bf16*)(ws + WS_WO), scr, r, lane); continue; } r -= I_O;
        if (r < I_G) { p0_transpose_item<2>(p.wg, DFF, DM, DFF, p.gffn, (bf16*)(ws + WS_WGU), scr, r, lane); continue; } r -= I_G;
        if (r < I_G) { p0_transpose_item<3>(p.wu, DFF, DM, DFF, p.gffn, (bf16*)(ws + WS_WGU), scr, r, lane); continue; } r -= I_G;
        p0_transpose_item<0>(p.wd, DM, DFF, DM, nullptr, (bf16*)(ws + WS_WD), scr, r, lane);
    }
    __syncthreads();
    LAS f32x4* wl = (LAS f32x4*)lds;
    for (int i = tid; i < 2048; i += NTHR) { const int ln = i & 63, q = i >> 6, half = q & 1, e = (q >> 1) & 3, j = q >> 3;
        wl[i] = *(const f32x4*)(p.win + (size_t)(4 * ln + 256 * j + e) * DIN + NZ + 4 * half); }
    __syncthreads();
    f32x4 gm[4];
#pragma unroll
    for (int j = 0; j < 4; ++j) gm[j] = *(const f32x4*)(p.gmix + 4 * lane + 256 * j);
    bf16* XN = (bf16*)(ws + WS_XN);
    constexpr int NQUAD = MTOK / 4;
#ifndef REP_P0R
#define REP_P0R 1
#endif
    for (int repr_ = 0; repr_ < REP_P0R; ++repr_)
    for (int qd = gw; qd < NQUAD; qd += NGW) {
        const int m0 = 4 * qd; const float* xr = (m0 < MP) ? p.xp + (size_t)m0 * DM : p.xs + (size_t)(m0 - MP) * DM;
        f32x4 v[4][4];
#pragma unroll
        for (int rr = 0; rr < 4; ++rr)
#pragma unroll
            for (int j = 0; j < 4; ++j) v[rr][j] = *(const f32x4*)(xr + (size_t)rr * DM + 4 * lane + 256 * j);
        asm volatile("" ::: "memory");
        float ss[4]; f32x4 a0[4], a1[4];
#pragma unroll
        for (int rr = 0; rr < 4; ++rr) { ss[rr] = 0.f; a0[rr] = (f32x4){0.f, 0.f, 0.f, 0.f}; a1[rr] = a0[rr]; }
#pragma unroll
        for (int j = 0; j < 4; ++j) {
#pragma unroll
            for (int rr = 0; rr < 4; ++rr) { ss[rr] += (v[rr][j][0] * v[rr][j][0] + v[rr][j][1] * v[rr][j][1]) + (v[rr][j][2] * v[rr][j][2] + v[rr][j][3] * v[rr][j][3]); v[rr][j] = v[rr][j] * gm[j]; }
#pragma unroll
            for (int e = 0; e < 4; ++e) { const f32x4 w0 = wl[((j * 4 + e) * 2) * 64 + lane], w1 = wl[((j * 4 + e) * 2 + 1) * 64 + lane];
#pragma unroll
                for (int rr = 0; rr < 4; ++rr) { a0[rr] += w0 * v[rr][j][e]; a1[rr] += w1 * v[rr][j][e]; } } }
        const int b5 = lane >> 5, b4 = (lane >> 4) & 1, b3 = (lane >> 3) & 1;
#pragma unroll
        for (int rr = 0; rr < 4; ++rr) {
            const float r = 1.0f / sqrtf(wave_sum(ss[rr]) * (1.0f / DM) + 1e-6f);
            float t4[4], t2[2];
#pragma unroll
            for (int i = 0; i < 4; ++i) { const float mine = b5 ? a1[rr][i] : a0[rr][i], send = b5 ? a0[rr][i] : a1[rr][i]; t4[i] = mine + __shfl_xor(send, 32); }
#pragma unroll
            for (int i = 0; i < 2; ++i) { const float mine = b4 ? t4[2 + i] : t4[i], send = b4 ? t4[i] : t4[2 + i]; t2[i] = mine + __shfl_xor(send, 16); }
            float t1; { const float mine = b3 ? t2[1] : t2[0], send = b3 ? t2[0] : t2[1]; t1 = mine + __shfl_xor(send, 8); }
            t1 += __shfl_xor(t1, 4); t1 += __shfl_xor(t1, 2); t1 += __shfl_xor(t1, 1);
            const int m = m0 + rr;
#pragma unroll
            for (int j = 0; j < 4; ++j) { u32x2 w; const f32x4 xa = v[rr][j] * r; w.x = pk2(xa[0], xa[1]); w.y = pk2(xa[2], xa[3]); *(u32x2*)(XN + (size_t)m * DM + 4 * lane + 256 * j) = w; }
            if ((lane & 7) == 0) { const int idx = lane >> 3; const float t = t1 * r + p.bfg[idx]; const float lf = fminf(t, 0.f) - log1pf(expf(-fabsf(t)));
                float* o = (m < MP) ? p.out + O_LFP + (size_t)m * 8 : p.out + O_LFS + (size_t)(m - MP) * 8; o[idx] = lf; }
        }
    }
}
__device__ __forceinline__ void p1_cumsum(const Params& p, LAS unsigned char* lds) {
    const int tid = tid_fresh(), lane = tid & 63, wid = __builtin_amdgcn_readfirstlane(tid >> 6);
    const int bh = blockIdx.x; if (bh >= NB * 8) return;
    const int b = bh >> 3, h = bh & 7; const float* lf = p.out + O_LFP + (size_t)b * TSEQ * 8 + h;
    float c[4]; float run = 0.f;
#pragma unroll
    for (int e = 0; e < 4; ++e) { run += lf[(size_t)(4 * tid + e) * 8]; c[e] = run; }
    float tot; const float inc = block_scan(run, tot, (LAS float*)lds, lane, wid); const float exc = inc - run;
    float* cb = (float*)(p.ws + WS_CB) + (size_t)bh * TSEQ + 4 * tid;
    *(f32x4*)cb = (f32x4){exc + c[0], exc + c[1], exc + c[2], exc + c[3]};
}
__device__ __forceinline__ void p6_final(const Params& p, int vcu, int G) {
    const int tid = tid_fresh(), lane = tid & 63, wid = __builtin_amdgcn_readfirstlane(tid >> 6);
    f32x4 gf[4];
#pragma unroll
    for (int j = 0; j < 4; ++j) gf[j] = *(const f32x4*)(p.gfin + 4 * lane + 256 * j);
    for (int m = 2 * (vcu * NWAVES + wid); m < MTOK; m += 2 * G * NWAVES) { float* y = p.out + O_Y + (size_t)m * DM + 4 * lane;
        f32x4 v[2][4]; float s0 = 0.f, s1 = 0.f;
#pragma unroll
        for (int j = 0; j < 4; ++j) { v[0][j] = *(const f32x4*)(y + 256 * j); v[1][j] = *(const f32x4*)(y + DM + 256 * j); }
#pragma unroll
        for (int j = 0; j < 4; ++j) { s0 += (v[0][j][0] * v[0][j][0] + v[0][j][1] * v[0][j][1]) + (v[0][j][2] * v[0][j][2] + v[0][j][3] * v[0][j][3]);
            s1 += (v[1][j][0] * v[1][j][0] + v[1][j][1] * v[1][j][1]) + (v[1][j][2] * v[1][j][2] + v[1][j][3] * v[1][j][3]); }
        const float r0 = 1.0f / sqrtf(wave_sum(s0) * (1.0f / DM) + 1e-6f), r1 = 1.0f / sqrtf(wave_sum(s1) * (1.0f / DM) + 1e-6f);
#pragma unroll
        for (int j = 0; j < 4; ++j) { __builtin_nontemporal_store(v[0][j] * r0 * gf[j], (f32x4*)(y + 256 * j)); __builtin_nontemporal_store(v[1][j] * r1 * gf[j], (f32x4*)(y + DM + 256 * j)); } }
}
#define XB_TMO      128
#define XB_XCNT(j)  (256  + 64 * (j))
#define XB_XSUB(j)  (1280 + 64 * (j))
#define XB_XGEN(j)  (2304 + 64 * (j))
#define XB_TOP      3328
#define XB_TOPGEN   3392
#define XCD_BAR_WORDS 3456
#define XB_SPIN_CAP (1u << 18)

__device__ __forceinline__ unsigned xb_ld(unsigned* p)              { return __hip_atomic_load(p, __ATOMIC_RELAXED, __HIP_MEMORY_SCOPE_AGENT); }
__device__ __forceinline__ unsigned xb_add(unsigned* p, unsigned v) { return __hip_atomic_fetch_add(p, v, __ATOMIC_RELAXED, __HIP_MEMORY_SCOPE_AGENT); }
__device__ __forceinline__ unsigned xb_xcc_id() { return (unsigned)__builtin_amdgcn_s_getreg((3 << 11) | 20) & 0xFu; }
#define XB_SPIN(cond, bar) do { unsigned _sp = 0; while (cond) { __builtin_amdgcn_s_sleep(1); \
    if ((++_sp & 255u) == 0u) { if (xb_ld(&(bar)[XB_TMO])) break; if (_sp > XB_SPIN_CAP) { atomicAdd(&(bar)[XB_TMO], 1u); break; } } } } while (0)

struct XcdBarrier {
    unsigned* bar; unsigned x;
    volatile LAS unsigned* st;
};

__device__ __forceinline__ XcdBarrier xcd_barrier_post(unsigned* bar, volatile LAS unsigned* st) {
    XcdBarrier b; b.bar = bar; b.x = xb_xcc_id(); b.st = st;
    if (threadIdx.x == 0) (void)xb_add(&bar[XB_XCNT(b.x)], 1u);
    return b;
}
__device__ __forceinline__ void xcd_barrier_complete(unsigned* bar, unsigned x, unsigned& nloc, unsigned& nx) {
    const unsigned G = gridDim.x * gridDim.y * gridDim.z;
    unsigned sum, cnt, mine, sp = 0u;
    for (;;) {
        sum = 0u; cnt = 0u; mine = 0u;
#pragma unroll
        for (unsigned j = 0; j < 16; ++j) { const unsigned c = xb_ld(&bar[XB_XCNT(j)]); sum += c; cnt += (c > 0u) ? 1u : 0u; mine = (j == x) ? c : mine; }
        if (sum == G) break;
        __builtin_amdgcn_s_sleep(1);
        if ((++sp & 255u) == 0u) { if (xb_ld(&bar[XB_TMO])) break; if (sp > XB_SPIN_CAP) { atomicAdd(&bar[XB_TMO], 1u); break; } }
    }
    nloc = mine > 0u ? mine : 1u; nx = cnt > 0u ? cnt : 1u;
}

__device__ __forceinline__ void xcd_barrier(const XcdBarrier& b) {
    asm volatile("s_waitcnt vmcnt(0)" ::: "memory");
    __syncthreads();
    if (threadIdx.x == 0) {
        unsigned* bar = b.bar;
        __builtin_amdgcn_s_waitcnt(0);
        unsigned nloc = b.st[0], nx = b.st[1];
        if (nloc == 0u) { xcd_barrier_complete(bar, b.x, nloc, nx); b.st[0] = nloc; b.st[1] = nx; }
        const unsigned old = xb_add(&bar[XB_XSUB(b.x)], 1u);
        const unsigned gen = old / nloc;
        if (old + 1u == (gen + 1u) * nloc) {
            __builtin_amdgcn_fence(__ATOMIC_RELEASE, "agent");
            asm volatile("s_waitcnt vmcnt(0)" ::: "memory");
            const unsigned og = xb_add(&bar[XB_TOP], 1u);
            const unsigned tg = og / nx;
            if (og + 1u == (tg + 1u) * nx) xb_add(&bar[XB_TOPGEN], 1u);
            else XB_SPIN(xb_ld(&bar[XB_TOPGEN]) == tg, bar);
            __builtin_amdgcn_fence(__ATOMIC_ACQUIRE, "agent");
            xb_add(&bar[XB_XGEN(b.x)], 1u);
            asm volatile("s_waitcnt vmcnt(0)" ::: "memory");
        } else {
            XB_SPIN(xb_ld(&bar[XB_XGEN(b.x)]) == gen, bar);
            __builtin_amdgcn_fence(__ATOMIC_ACQUIRE, "agent");
            asm volatile("s_waitcnt vmcnt(0)" ::: "memory");
        }
    }
    __syncthreads();
}
#ifndef RJ_SKIP
#define RJ_SKIP 0
#endif
#define MFMA32(a, b, c) __builtin_amdgcn_mfma_f32_32x32x16_bf16((a), (b), (c), 0, 0, 0)
__device__ __forceinline__ void ret_job(LAS unsigned char* lds, const Params& p_, const bool sample, const int b, const int h) {
    const Params p = fresh_params(p_);
    const int tid = tid_fresh(), lane = tid & 63, wid = __builtin_amdgcn_readfirstlane(tid >> 6), r32 = lane & 31, hi = lane >> 5;
    constexpr int PQK = 272, PT = 144;
    LAS unsigned char* Qr = lds; LAS unsigned char* Kr = lds + 17408; LAS unsigned char* Kdt = lds + 34816; LAS unsigned char* Vt = lds + 53248;
    LAS unsigned char* St = lds + 71680; LAS unsigned char* Am = lds + 106496; LAS f32x2* stats = (LAS f32x2*)(lds + 115712);
    const float lg2 = h == 0 ? -0.045803689613124746f : h == 1 ? -0.022720076500083907f : h == 2 ? -0.011315313227834146f : -0.005646563141142062f;
    const float cdec = __builtin_amdgcn_exp2f(lg2 * 64.0f);
    const int nch = sample ? 1 : TSEQ / 64; const size_t row0 = sample ? (size_t)MP + b * NSMP : (size_t)b * TSEQ;
    const bf16* Z = (const bf16*)(p.ws + WS_Z); bf16* MIX = (bf16*)(p.ws + WS_MIX);
    const int dkb = wid & 3, dvh = wid >> 2;
    f32x16 S0, S1;
    if (sample) { const float* sp = p.sr + (size_t)(b * 4 + h) * 16384 + 64 * dvh + r32;
#pragma unroll
        for (int r = 0; r < 16; ++r) { const int dk = 32 * dkb + crow(r, hi); S0[r] = sp[dk * 128]; S1[r] = sp[dk * 128 + 32]; } }
    else {
#pragma unroll
        for (int r = 0; r < 16; ++r) { S0[r] = 0.f; S1[r] = 0.f; } }
    u32x4 pq0, pq1, pk0, pk1, pv0, pv1; u32x2 pg[4];
#define RJ_LOAD(c_) do { const bf16* zr = Z + (row0 + (size_t)(c_) * 64 + 2 * (tid & 31)) * NZ + h * 128 + (tid >> 5) * 8; \
        pq0 = *(const u32x4*)zr; pq1 = *(const u32x4*)(zr + NZ); pk0 = *(const u32x4*)(zr + 512); pk1 = *(const u32x4*)(zr + NZ + 512); pv0 = *(const u32x4*)(zr + 1024); pv1 = *(const u32x4*)(zr + NZ + 1024); } while (0)
    RJ_LOAD(0);
    f32x4 gnv[4];
#pragma unroll
    for (int g = 0; g < 4; ++g) gnv[g] = *(const f32x4*)(p.gn + h * 128 + 32 * (wid >> 1) + 8 * g + 4 * hi);
    for (int c = 0; c < nch; ++c) {
        const size_t r0 = row0 + (size_t)c * 64;
#if !(RJ_SKIP & 1)
        { const int jp = tid & 31, ch = tid >> 5;
            *(LAS u32x4*)(Qr + (2 * jp) * PQK + ch * 16) = pq0; *(LAS u32x4*)(Qr + (2 * jp + 1) * PQK + ch * 16) = pq1;
            *(LAS u32x4*)(Kr + (2 * jp) * PQK + ch * 16) = pk0; *(LAS u32x4*)(Kr + (2 * jp + 1) * PQK + ch * 16) = pk1;
            const float kd0 = __builtin_amdgcn_exp2f(lg2 * (float)(63 - 2 * jp)), kd1 = __builtin_amdgcn_exp2f(lg2 * (float)(62 - 2 * jp));
#pragma unroll
            for (int e = 0; e < 8; ++e) { const unsigned a0 = pk0[e >> 1], a1 = pk1[e >> 1], b0 = pv0[e >> 1], b1 = pv1[e >> 1];
                const float f0 = (e & 1) ? __uint_as_float(a0 & 0xffff0000u) : __uint_as_float(a0 << 16), f1 = (e & 1) ? __uint_as_float(a1 & 0xffff0000u) : __uint_as_float(a1 << 16);
                *(LAS unsigned*)(Kdt + (ch * 8 + e) * PT + jp * 4) = pk2(f0 * kd0, f1 * kd1);
                *(LAS unsigned*)(Vt + (ch * 8 + e) * PT + jp * 4) = (e & 1) ? ((b0 >> 16) | (b1 & 0xffff0000u)) : ((b0 & 0xffffu) | (b1 << 16)); } }
#pragma unroll
        for (int g = 0; g < 4; ++g) { const int dk0 = 32 * dkb + 8 * g + 4 * hi;
            u32x2 w0, w1; w0.x = pk2(S0[4 * g], S0[4 * g + 1]); w0.y = pk2(S0[4 * g + 2], S0[4 * g + 3]); w1.x = pk2(S1[4 * g], S1[4 * g + 1]); w1.y = pk2(S1[4 * g + 2], S1[4 * g + 3]);
            *(LAS u32x2*)(St + (64 * dvh + r32) * PQK + dk0 * 2) = w0; *(LAS u32x2*)(St + (64 * dvh + 32 + r32) * PQK + dk0 * 2) = w1; }
        if (c + 1 < nch) RJ_LOAD(c + 1);
        { const bf16* grow = Z + (r0 + 32 * (wid & 1) + r32) * NZ + 1536 + h * 128 + 32 * (wid >> 1) + 4 * hi;
#pragma unroll
          for (int g = 0; g < 4; ++g) pg[g] = *(const u32x2*)(grow + 8 * g); }
#endif
        __syncthreads();
#if !(RJ_SKIP & 2)
        if (wid < 4) { const int jb = wid >> 1, ib = wid & 1; f32x16 a;
#pragma unroll
            for (int r = 0; r < 16; ++r) a[r] = 0.f;
#pragma unroll 2
            for (int ks = 0; ks < 8; ++ks) { const bf16x8 kf = *(const LAS bf16x8*)(Kr + (32 * jb + r32) * PQK + (16 * ks + 8 * hi) * 2), qf = *(const LAS bf16x8*)(Qr + (32 * ib + r32) * PQK + (16 * ks + 8 * hi) * 2);
                a = MFMA32(kf, qf, a); }
            const int i = 32 * ib + r32;
#pragma unroll
            for (int g = 0; g < 4; ++g) { const int j0 = 32 * jb + 8 * g + 4 * hi; float t[4];
#pragma unroll
                for (int e = 0; e < 4; ++e) t[e] = a[4 * g + e] * __builtin_amdgcn_exp2f(lg2 * fabsf((float)(i - (j0 + e))));
                u32x2 w; w.x = pk2(t[0], t[1]); w.y = pk2(t[2], t[3]); *(LAS u32x2*)(Am + i * PT + j0 * 2) = w; } }
#endif
        __syncthreads();
#if !(RJ_SKIP & 4)
        { const int dvb = wid >> 1, ib = wid & 1; f32x16 oi, ox;
#pragma unroll
            for (int r = 0; r < 16; ++r) { oi[r] = 0.f; ox[r] = 0.f; }
#pragma unroll
            for (int ks = 0; ks < 4; ++ks) { const bf16x8 vf = *(const LAS bf16x8*)(Vt + (32 * dvb + r32) * PT + (16 * ks + 8 * hi) * 2), af = *(const LAS bf16x8*)(Am + (32 * ib + r32) * PT + (16 * ks + 8 * hi) * 2);
                oi = MFMA32(vf, af, oi); }
#pragma unroll 2
            for (int ks = 0; ks < 8; ++ks) { const bf16x8 sf = *(const LAS bf16x8*)(St + (32 * dvb + r32) * PQK + (16 * ks + 8 * hi) * 2), qf = *(const LAS bf16x8*)(Qr + (32 * ib + r32) * PQK + (16 * ks + 8 * hi) * 2);
                ox = MFMA32(sf, qf, ox); }
            const int i = 32 * ib + r32; const float qd = __builtin_amdgcn_exp2f(lg2 * (float)(i + 1)); float s1 = 0.f, s2 = 0.f;
#pragma unroll
            for (int r = 0; r < 16; ++r) { oi[r] += ox[r] * qd; s1 += oi[r]; s2 += oi[r] * oi[r]; }
            s1 += __shfl_xor(s1, 32); s2 += __shfl_xor(s2, 32);
            if (hi == 0) stats[i * 4 + dvb] = (f32x2){s1, s2};
            __syncthreads();
            float m1 = 0.f, m2 = 0.f;
#pragma unroll
            for (int t = 0; t < 4; ++t) { const f32x2 st = stats[i * 4 + t]; m1 += st.x; m2 += st.y; }
            const float mu = m1 * (1.0f / 128.0f), var = fmaxf(m2 * (1.0f / 128.0f) - mu * mu, 0.f), rstd = 1.0f / sqrtf(var + 1e-5f);
            bf16* mrow = MIX + (r0 + i) * DM + h * 128;
#pragma unroll
            for (int g = 0; g < 4; ++g) { const int dv0 = 32 * dvb + 8 * g + 4 * hi; const u32x2 gw = pg[g]; const f32x4 gn = gnv[g];
                const float g0 = bf2f(gw.x & 0xffffu), g1 = bf2f(gw.x >> 16), g2 = bf2f(gw.y & 0xffffu), g3 = bf2f(gw.y >> 16);
                const float y0 = (oi[4 * g] - mu) * rstd * gn[0] * pg8::silu_f(g0), y1 = (oi[4 * g + 1] - mu) * rstd * gn[1] * pg8::silu_f(g1);
                const float y2 = (oi[4 * g + 2] - mu) * rstd * gn[2] * pg8::silu_f(g2), y3 = (oi[4 * g + 3] - mu) * rstd * gn[3] * pg8::silu_f(g3);
                u32x2 w; w.x = pk2(y0, y1); w.y = pk2(y2, y3); *(u32x2*)(mrow + dv0) = w; } }
#endif
#if !(RJ_SKIP & 8)
#pragma unroll
        for (int r = 0; r < 16; ++r) { S0[r] *= cdec; S1[r] *= cdec; }
#pragma unroll
        for (int ks = 0; ks < 4; ++ks) { const bf16x8 kdf = *(const LAS bf16x8*)(Kdt + (32 * dkb + r32) * PT + (16 * ks + 8 * hi) * 2);
            const bf16x8 v0 = *(const LAS bf16x8*)(Vt + (64 * dvh + r32) * PT + (16 * ks + 8 * hi) * 2), v1 = *(const LAS bf16x8*)(Vt + (64 * dvh + 32 + r32) * PT + (16 * ks + 8 * hi) * 2);
            S0 = MFMA32(kdf, v0, S0); S1 = MFMA32(kdf, v1, S1); }
#endif
        __syncthreads();
    }
#undef RJ_LOAD
    { float* so = p.out + (sample ? O_SRS : O_SRP) + (size_t)(b * 4 + h) * 16384 + 64 * dvh + r32;
#pragma unroll
        for (int r = 0; r < 16; ++r) { const int dk = 32 * dkb + crow(r, hi); so[dk * 128] = S0[r]; so[dk * 128 + 32] = S1[r]; } }
}

constexpr size_t WS_PART = WS_END + 6 * MiB;
constexpr int PART_STRIDE = 4224;
__device__ __forceinline__ void fs_chunk_job(LAS unsigned char* lds, const Params& p_, const int b, const int c) {
    const Params p = fresh_params(p_);
    const int tid = tid_fresh(), lane = tid & 63, wid = __builtin_amdgcn_readfirstlane(tid >> 6), r32 = lane & 31, hi = lane >> 5;
    const int h = wid;
    LAS float* ab = (LAS float*)(lds + wid * 1280);
    LAS float* red = (LAS float*)(lds + 10240);
    LAS unsigned char* vtw = lds + 12288 + wid * 5120;
    { const float* clf = p.clf + (size_t)b * PAST * 8; float acc = 0.f;
      for (int j = 256 * (c + 1) + (tid >> 3); j < PAST; j += 64) acc += clf[(size_t)j * 8 + (tid & 7)];
      acc += __shfl_xor(acc, 8); acc += __shfl_xor(acc, 16); acc += __shfl_xor(acc, 32);
      if (lane < 8) red[wid * 8 + lane] = acc;
      __syncthreads();
      float Sh = 0.f;
#pragma unroll
      for (int w = 0; w < NWAVES; ++w) Sh += red[w * 8 + h];
      float v[4]; float tt = 0.f;
#pragma unroll
      for (int e = 0; e < 4; ++e) { v[e] = clf[(size_t)(256 * c + 4 * lane + e) * 8 + h]; tt += v[e]; }
      float inc = tt;
#pragma unroll
      for (int o = 1; o < 64; o <<= 1) { const float n = __shfl_up(inc, o); if (lane >= o) inc += n; }
      const float tot = __shfl(inc, 63); float suf = Sh + (tot - inc);
#pragma unroll
      for (int e = 3; e >= 0; --e) { ab[4 * lane + e] = suf * LOG2E; suf += v[e]; }
      if (c == 15) { float x = p.out[O_LFS + (size_t)(b * NSMP + lane) * 8 + h];
#pragma unroll
          for (int o = 1; o < 64; o <<= 1) { const float n = __shfl_up(x, o); if (lane >= o) x += n; }
          ab[256 + lane] = -x * LOG2E; } }
    const bf16* Zq = (const bf16*)(p.ws + WS_Z) + ((size_t)MP + b * NSMP) * NZ + 2048 + h * 64;
    bf16x8 qr[2][4];
#pragma unroll
    for (int qb = 0; qb < 2; ++qb)
#pragma unroll
        for (int d0 = 0; d0 < 4; ++d0) qr[qb][d0] = *(const bf16x8*)(Zq + (size_t)(32 * qb + r32) * NZ + 16 * d0 + 8 * hi);
    f32x16 o[2][2]; float mrun[2] = {-1e30f, -1e30f}, lrun[2] = {0.f, 0.f};
#pragma unroll
    for (int a = 0; a < 2; ++a)
#pragma unroll
        for (int cc = 0; cc < 2; ++cc)
#pragma unroll
            for (int r = 0; r < 16; ++r) o[a][cc][r] = 0.f;
    const size_t hoff = (size_t)h * 64;
    const float* ckb = p.ck + ((size_t)b * PAST + 256 * c) * 512 + hoff; const float* cvb = p.cv + ((size_t)b * PAST + 256 * c) * 512 + hoff;
    const float* nkb = p.out + O_FKS + (size_t)b * NSMP * 512 + hoff; const float* nvb = p.out + O_FVS + (size_t)b * NSMP * 512 + hoff;
    const int nstep = (c == 15) ? 10 : 8;
    f32x4 kraw[8], vraw[8];
#define FS_LOAD(s_) do { const int s__ = (s_); const float* kp = s__ < 8 ? ckb + (size_t)s__ * 32 * 512 : nkb + (size_t)(s__ - 8) * 32 * 512; \
        const float* vp = s__ < 8 ? cvb + (size_t)s__ * 32 * 512 : nvb + (size_t)(s__ - 8) * 32 * 512; \
        _Pragma("unroll") for (int d0 = 0; d0 < 4; ++d0) { kraw[2 * d0] = *(const f32x4*)(kp + r32 * 512 + 16 * d0 + 8 * hi); kraw[2 * d0 + 1] = *(const f32x4*)(kp + r32 * 512 + 16 * d0 + 8 * hi + 4); } \
        _Pragma("unroll") for (int i = 0; i < 4; ++i) { const int pr = 4 * i + (lane >> 4); vraw[2 * i] = *(const f32x4*)(vp + (2 * pr) * 512 + 4 * (lane & 15)); vraw[2 * i + 1] = *(const f32x4*)(vp + (2 * pr + 1) * 512 + 4 * (lane & 15)); } } while (0)
    FS_LOAD(0);
    for (int s = 0; s < nstep; ++s) {
        bf16x8 kf[4];
#pragma unroll
        for (int d0 = 0; d0 < 4; ++d0) { u32x4 w; w.x = pk2(kraw[2 * d0][0], kraw[2 * d0][1]); w.y = pk2(kraw[2 * d0][2], kraw[2 * d0][3]); w.z = pk2(kraw[2 * d0 + 1][0], kraw[2 * d0 + 1][1]); w.w = pk2(kraw[2 * d0 + 1][2], kraw[2 * d0 + 1][3]);
            kf[d0] = __builtin_bit_cast(bf16x8, w); }
#pragma unroll
        for (int i = 0; i < 4; ++i) { const int kap = 2 * (4 * i + (lane >> 4)); const int pos = (kap & ~12) | ((kap & 4) << 1) | ((kap & 8) >> 1);
#pragma unroll
            for (int e = 0; e < 4; ++e) *(LAS unsigned*)(vtw + (4 * (lane & 15) + e) * 80 + pos * 2) = pk2(vraw[2 * i][e], vraw[2 * i + 1][e]); }
        if (s + 1 < nstep) FS_LOAD(s + 1);
        f32x16 sc[2];
#pragma unroll
        for (int qb = 0; qb < 2; ++qb) {
#pragma unroll
            for (int r = 0; r < 16; ++r) sc[qb][r] = 0.f;
#pragma unroll
            for (int d0 = 0; d0 < 4; ++d0) sc[qb] = MFMA32(kf[d0], qr[qb][d0], sc[qb]); }
        const int key0 = 32 * s;
#pragma unroll
        for (int g = 0; g < 4; ++g) { const f32x4 bv = *(const LAS f32x4*)(ab + key0 + 8 * g + 4 * hi);
#pragma unroll
            for (int e = 0; e < 4; ++e) { sc[0][4 * g + e] += bv[e]; sc[1][4 * g + e] += bv[e]; } }
        if (s >= 8) {
#pragma unroll
            for (int qb = 0; qb < 2; ++qb)
#pragma unroll
                for (int r = 0; r < 16; ++r) { const int kn = key0 - 256 + crow(r, hi); if (kn > 32 * qb + r32) sc[qb][r] = -INFINITY; } }
        bf16x8 pf[2][2];
#pragma unroll
        for (int qb = 0; qb < 2; ++qb) { float rm = sc[qb][0];
#pragma unroll
            for (int r = 1; r < 16; ++r) rm = fmaxf(rm, sc[qb][r]);
            rm = fmaxf(rm, __shfl_xor(rm, 32));
            const float mn = fmaxf(mrun[qb], rm), alpha = __builtin_amdgcn_exp2f(mrun[qb] - mn); mrun[qb] = mn; float ps = 0.f;
#pragma unroll
            for (int r = 0; r < 16; ++r) { const float e_ = __builtin_amdgcn_exp2f(sc[qb][r] - mn); sc[qb][r] = e_; ps += e_; }
            lrun[qb] = lrun[qb] * alpha + ps;
#pragma unroll
            for (int r = 0; r < 16; ++r) { o[qb][0][r] *= alpha; o[qb][1][r] *= alpha; }
#pragma unroll
            for (int ks = 0; ks < 2; ++ks) { u32x4 w; w.x = pk2(sc[qb][8 * ks], sc[qb][8 * ks + 1]); w.y = pk2(sc[qb][8 * ks + 2], sc[qb][8 * ks + 3]); w.z = pk2(sc[qb][8 * ks + 4], sc[qb][8 * ks + 5]); w.w = pk2(sc[qb][8 * ks + 6], sc[qb][8 * ks + 7]);
                pf[qb][ks] = __builtin_bit_cast(bf16x8, w); } }
#pragma unroll
        for (int db = 0; db < 2; ++db)
#pragma unroll
            for (int ks = 0; ks < 2; ++ks) { const bf16x8 vf = *(const LAS bf16x8*)(vtw + (32 * db + r32) * 80 + (16 * ks + 8 * hi) * 2);
                o[0][db] = MFMA32(vf, pf[0][ks], o[0][db]); o[1][db] = MFMA32(vf, pf[1][ks], o[1][db]); }
    }
#undef FS_LOAD
    lrun[0] += __shfl_xor(lrun[0], 32); lrun[1] += __shfl_xor(lrun[1], 32);
    float* part = (float*)(p.ws + WS_PART) + (size_t)((b * 8 + h) * 16 + c) * PART_STRIDE;
#pragma unroll
    for (int qb = 0; qb < 2; ++qb) { const int q = 32 * qb + r32;
        if (hi == 0) { part[4096 + q] = mrun[qb]; part[4160 + q] = lrun[qb]; }
#pragma unroll
        for (int db = 0; db < 2; ++db)
#pragma unroll
            for (int g = 0; g < 4; ++g) *(f32x4*)(part + q * 64 + 32 * db + 8 * g + 4 * hi) = (f32x4){o[qb][db][4 * g], o[qb][db][4 * g + 1], o[qb][db][4 * g + 2], o[qb][db][4 * g + 3]}; }
}
__device__ __forceinline__ void fs_combine_job(const Params& p_, const int b, const int h) {
    const Params p = fresh_params(p_);
    const int tid = tid_fresh(), q = tid >> 3, dg = tid & 7;
    const float* part = (const float*)(p.ws + WS_PART) + (size_t)((b * 8 + h) * 16) * PART_STRIDE;
    float M = -3e38f;
#pragma unroll
    for (int c = 0; c < 16; ++c) M = fmaxf(M, part[(size_t)c * PART_STRIDE + 4096 + q]);
    float L = 0.f; f32x4 a0 = {0.f, 0.f, 0.f, 0.f}, a1 = a0;
#pragma unroll
    for (int c = 0; c < 16; ++c) { const float* pc = part + (size_t)c * PART_STRIDE; const float wg = __builtin_amdgcn_exp2f(pc[4096 + q] - M); L += wg * pc[4160 + q];
        a0 += *(const f32x4*)(pc + q * 64 + 8 * dg) * wg; a1 += *(const f32x4*)(pc + q * 64 + 8 * dg + 4) * wg; }
    const float inv = 1.0f / L; u32x4 w; w.x = pk2(a0[0] * inv, a0[1] * inv); w.y = pk2(a0[2] * inv, a0[3] * inv); w.z = pk2(a1[0] * inv, a1[1] * inv); w.w = pk2(a1[2] * inv, a1[3] * inv);
    *(u32x4*)((bf16*)(p.ws + WS_MIX) + ((size_t)MP + b * NSMP + q) * DM + 512 + h * 64 + 8 * dg) = w;
}
constexpr int NFP = NB * 8 * (TSEQ / 256);
constexpr int Q_FSC = NB * 16, Q_RETS = NB * 4, Q_RETP = NB * 4, Q_FSM = NB * 8, Q_P3S = 16, Q_FP1 = 300, Q_P4S = 4 * 22, Q_FP2 = 300, Q_P5S = 64;
constexpr int Q_FP3 = NFP - Q_FP1 - Q_FP2;
constexpr int NJOBS = Q_FSC + Q_RETS + Q_RETP + Q_FSM + Q_P3S + Q_FP1 + Q_P4S + Q_FP2 + Q_P5S + Q_FP3;
constexpr size_t WS_HS = WS_END;
constexpr size_t WS_END2 = WS_PART + (size_t)NB * 8 * 16 * PART_STRIDE * 4;
__device__ __forceinline__ void gate_wait(unsigned* c, unsigned target) {
    if (tid_fresh() == 0) { unsigned sp = 0; while (__hip_atomic_load(c, RLX_AGENT) < target && ++sp < (1u << 22)) __builtin_amdgcn_s_sleep(4);
        __builtin_amdgcn_fence(__ATOMIC_ACQUIRE, "agent"); asm volatile("s_waitcnt vmcnt(0)" ::: "memory"); }
    __syncthreads();
}
__device__ __forceinline__ void job_signal(unsigned* c) {
    asm volatile("s_waitcnt vmcnt(0)" ::: "memory");
    __syncthreads();
    if (tid_fresh() == 0) { __builtin_amdgcn_fence(__ATOMIC_RELEASE, "agent"); asm volatile("s_waitcnt vmcnt(0)" ::: "memory"); __hip_atomic_fetch_add(c, 1u, RLX_AGENT); }
}
__global__ void __launch_bounds__(NTHR, 2) hybrid_fwd(Params p) {
    extern __shared__ __attribute__((aligned(16))) unsigned char lds_raw[];
    LAS unsigned char* lds = (LAS unsigned char*)lds_raw;
    cg::grid_group grid = cg::this_grid();
    const int G = gridDim.x, bx = blockIdx.x, vcu = (G % 8 == 0) ? (bx % 8) * (G / 8) + bx / 8 : bx;
    unsigned char* ws = p.ws;
    volatile LAS unsigned* MISCU = (volatile LAS unsigned*)(lds + MISC_OFF);
    if (threadIdx.x < 32) MISCU[threadIdx.x] = 0u;
    __syncthreads();
    if (p.ws == nullptr) grid.sync();
    const XcdBarrier xbar = xcd_barrier_post((unsigned*)(ws + WS_CTL) + 4096, MISCU + 8);
    p0_prep(p, lds, vcu, G);
    xcd_barrier(xbar);
    p1_cumsum(p, lds);
    __syncthreads();
    { pg8::Gemm g{(const bf16*)(ws + WS_XN), (const bf16*)(ws + WS_WIN), MTOK, NZ, DM, DM}; pg8::StaticOrder S; S.init(MTOK, NZ, G, bx);
      pg8::EpiInProj E{(bf16*)(ws + WS_Z), p.out, (const float*)(ws + WS_CS)};
      pg8::gemm_phase<pg8::EpiInProj, pg8::StaticOrder, true, true>(lds, g, S, E); }
    xcd_barrier(xbar);
    { volatile LAS int* MISC = (volatile LAS int*)(lds + MISC_OFF);
      for (;;) {
          if (tid_fresh() == 0) MISC[0] = (int)atomicAdd((unsigned*)(ws + WS_CTL), 1u);
          __syncthreads();
          int job = __builtin_amdgcn_readfirstlane(MISC[0]);
          __syncthreads();
#ifndef DUP_KIND
#define DUP_KIND 0
#endif
          constexpr int NDUP = DUP_KIND == 1 ? 2560 : DUP_KIND == 2 ? 1024 : 0;
          if (job >= NJOBS + NDUP) break;
          if (job >= NJOBS) { const int d = job - NJOBS;
              if (DUP_KIND == 2) { const Params q = fresh_params(p); bf16* Z = (bf16*)(q.ws + WS_Z); attn_body::attn_unit<8>((d & 127) >> 3, d & 7, 7 - (d >> 7), (const attn_body::bf16*)(Z + 2048), (const attn_body::bf16*)(Z + 2560), (const attn_body::bf16*)(Z + 3072), (attn_body::bf16*)((bf16*)(q.ws + WS_MIX) + 512), (const float*)(q.ws + WS_CB), (char*)lds_raw); }
              __syncthreads(); continue; }
          const Params q = fresh_params(p);
          unsigned char* qws = q.ws; unsigned* cnt = (unsigned*)(qws + WS_CTL);
          bf16* Z = (bf16*)(qws + WS_Z); bf16* MIX = (bf16*)(qws + WS_MIX); bf16* XN = (bf16*)(qws + WS_XN);
          int fp = -1;
          if (job < Q_FSC) { fs_chunk_job(lds, p, job >> 4, job & 15); job_signal(cnt + 64 + 64 * (job >> 4)); }
          else if ((job -= Q_FSC) < Q_RETS) { ret_job(lds, p, true, job >> 2, job & 3); job_signal(cnt + 1216); }
          else if ((job -= Q_RETS) < Q_RETP) ret_job(lds, p, false, job >> 2, job & 3);
          else if ((job -= Q_RETP) < Q_FSM) { gate_wait(cnt + 64 + 64 * (job >> 3), 16); fs_combine_job(p, job >> 3, job & 7); job_signal(cnt + 1216); }
          else if ((job -= Q_FSM) < Q_P3S) { gate_wait(cnt + 1216, Q_RETS + Q_FSM);
              pg8::Gemm g{MIX, (const bf16*)(qws + WS_WO), MTOK, DM, DM, DM}; pg8::OneUnit S{MP / 256 + job / 4, job % 4};
              pg8::EpiResid E{q.xp, q.xs, q.out + O_Y, XN, (float*)(qws + WS_SS1), nullptr};
              pg8::gemm_phase<pg8::EpiResid, pg8::OneUnit, true, true>(lds, g, S, E); job_signal(cnt + 1280); }
          else if ((job -= Q_P3S) < Q_FP1) fp = job;
          else if ((job -= Q_FP1) < Q_P4S) { gate_wait(cnt + 1280, Q_P3S);
              pg8::Gemm g{XN, (const bf16*)(qws + WS_WGU), MTOK, NGU, DM, DM}; pg8::OneUnit S{MP / 256 + job / 22, job % 22};
              pg8::EpiGateUp E{(bf16*)(qws + WS_HS) - (size_t)MP * DFF, (const float*)(qws + WS_SS1)};
              pg8::gemm_phase<pg8::EpiGateUp, pg8::OneUnit, true, true>(lds, g, S, E); job_signal(cnt + 1344); }
          else if ((job -= Q_P4S) < Q_FP2) fp = Q_FP1 + job;
          else if ((job -= Q_FP2) < Q_P5S) { gate_wait(cnt + 1344, Q_P4S);
              const int kq = job & 3, un = job >> 2, koff = (kq == 0 ? 0 : kq == 1 ? 768 : kq == 2 ? 1408 : 2176), klen = (kq & 1) ? 640 : 768;
              pg8::Gemm g{(const bf16*)(qws + WS_HS) - (size_t)MP * DFF + koff, (const bf16*)(qws + WS_WD) + koff, MTOK, DM, klen, DFF}; pg8::OneUnit S{MP / 256 + un / 4, un % 4};
              pg8::EpiAtomic E{q.out + O_Y};
              pg8::gemm_phase<pg8::EpiAtomic, pg8::OneUnit, true, true>(lds, g, S, E); }
          else fp = Q_FP1 + Q_FP2 + (job - Q_P5S);
          if (fp >= 0) { const int qb = (TSEQ / 256 - 1) - (fp >> 7), bh = fp & 127;
              attn_body::attn_unit<16>(bh >> 3, bh & 7, qb, (const attn_body::bf16*)(Z + 2048), (const attn_body::bf16*)(Z + 2560), (const attn_body::bf16*)(Z + 3072),
                                      (attn_body::bf16*)(MIX + 512), (const float*)(qws + WS_CB), (char*)lds_raw); }
          __syncthreads();
      } }
    xcd_barrier(xbar);
#ifndef REP_G
#define REP_G 1
#endif
    { pg8::Gemm g{(const bf16*)(ws + WS_MIX), (const bf16*)(ws + WS_WO), MP, DM, DM, DM}; pg8::StaticOrder S; S.init(MP, DM, G, bx);
      pg8::EpiResid E{p.xp, p.xs, nullptr, (bf16*)(ws + WS_XN), (float*)(ws + WS_SS1), nullptr};
      pg8::gemm_phase<pg8::EpiResid, pg8::StaticOrder, true, true>(lds, g, S, E);
    xcd_barrier(xbar); }
    { pg8::Gemm g{(const bf16*)(ws + WS_XN), (const bf16*)(ws + WS_WGU), MP, NGU, DM, DM}; pg8::StaticOrder S; S.init(MP, NGU, G, bx);
      pg8::EpiGateUp E{(bf16*)(ws + WS_H), (const float*)(ws + WS_SS1)};
      pg8::gemm_phase<pg8::EpiGateUp, pg8::StaticOrder, true, true>(lds, g, S, E);
    xcd_barrier(xbar); }
    { pg8::Gemm g{(const bf16*)(ws + WS_H), (const bf16*)(ws + WS_WD), MP, DM, DFF, DFF}; pg8::StaticOrder S; S.init(MP, DM, G, bx);
      pg8::EpiResid E{nullptr, nullptr, p.out + O_Y, nullptr, nullptr, (const bf16*)(ws + WS_XN)};
      pg8::gemm_phase<pg8::EpiResid, pg8::StaticOrder, true, true>(lds, g, S, E);
    xcd_barrier(xbar); }
    p6_final(p, vcu, G);
}

extern "C" void kernel_launch(void* const* d_in, const int* in_sizes, int n_in, void* d_out, int out_size, void* d_ws, size_t ws_size, hipStream_t stream) {
    static int grid = 0;
    if (grid == 0) {
        if (n_in != 16 || out_size != (int)O_END || ws_size < WS_END2) { fprintf(stderr, "kernel_launch: unexpected shapes (n_in %d, out %d, ws %zu); nothing launched\n", n_in, out_size, ws_size); grid = -1; return; }
        int dev = 0, cus = 0, per_cu = 0;
        if (hipGetDevice(&dev) != hipSuccess || hipDeviceGetAttribute(&cus, hipDeviceAttributeMultiprocessorCount, dev) != hipSuccess) { grid = -1; return; }
        if (hipFuncSetAttribute((const void*)hybrid_fwd, hipFuncAttributeMaxDynamicSharedMemorySize, LDS_BYTES) != hipSuccess) { fprintf(stderr, "kernel_launch: hipFuncSetAttribute failed\n"); grid = -1; return; }
        if (hipOccupancyMaxActiveBlocksPerMultiprocessor(&per_cu, (const void*)hybrid_fwd, NTHR, LDS_BYTES) != hipSuccess || per_cu < 1) { fprintf(stderr, "kernel_launch: occupancy query says %d blocks per CU\n", per_cu); per_cu = 1; }
        (void)hipGetLastError();
        grid = cus * per_cu;
    }
    if (grid < 0) return;
    Params p{};
    p.xp = (const float*)d_in[0]; p.xs = (const float*)d_in[1]; p.ck = (const float*)d_in[2]; p.cv = (const float*)d_in[3]; p.clf = (const float*)d_in[4]; p.sr = (const float*)d_in[5];
    p.win = (const float*)d_in[6]; p.bfg = (const float*)d_in[7]; p.gn = (const float*)d_in[8]; p.wout = (const float*)d_in[9]; p.gmix = (const float*)d_in[10]; p.gffn = (const float*)d_in[11];
    p.wg = (const float*)d_in[12]; p.wu = (const float*)d_in[13]; p.wd = (const float*)d_in[14]; p.gfin = (const float*)d_in[15];
    p.out = (float*)d_out; p.ws = (unsigned char*)d_ws;
    void* args[] = {&p};
    (void)hipMemsetAsync((char*)d_ws + WS_CTL + 4096 * 4, 0, XCD_BAR_WORDS * 4, stream);
    const hipError_t e = hipLaunchCooperativeKernel((const void*)hybrid_fwd, dim3(grid), dim3(NTHR), args, LDS_BYTES, stream);
    if (e != hipSuccess) fprintf(stderr, "kernel_launch: cooperative launch failed: %s (grid %d)\n", hipGetErrorString(e), grid);
}
```

```cpp
#include <hip/hip_runtime.h>
#include <hip/hip_cooperative_groups.h>
#include <hip/hip_bf16.h>
#include <cstdio>
#include <cstdint>
#include <cmath>
namespace cg = cooperative_groups;

constexpr int DM = 1024, NB = 16, TSEQ = 2048, MP = NB * TSEQ, NSMP = 64, MS = NB * NSMP, MTOK = MP + MS, PAST = 4096;
constexpr int DIN = 3592, NZ = 3584, DFF = 2816, NGU = 2 * DFF;
constexpr size_t O_Y = 0, O_SRP = (size_t)MTOK * DM, O_FKP = O_SRP + 1048576, O_FVP = O_FKP + 16777216, O_LFP = O_FVP + 16777216, O_SRS = O_LFP + 262144,
                 O_FKS = O_SRS + 1048576, O_FVS = O_FKS + 524288, O_LFS = O_FVS + 524288, O_END = O_LFS + 8192;
constexpr size_t MiB = 1u << 20;
constexpr size_t WS_CTL = 0, WS_SS1 = 64 * 1024, WS_SS2 = 256 * 1024, CTL_BYTES = 512 * 1024;
constexpr size_t WS_CS = 1 * MiB, WS_CB = 3 * MiB, WS_WIN = 4 * MiB, WS_WO = 11 * MiB, WS_WGU = 13 * MiB, WS_WD = 24 * MiB;
constexpr size_t WS_XN = 32 * MiB, WS_MIX = 98 * MiB, WS_Z = 164 * MiB, WS_H = WS_Z, WS_END = 395 * MiB;
constexpr float C2F = 0.125f * 1.4426950408889634f;

struct Params {
    const float *xp, *xs, *ck, *cv, *clf, *sr, *win, *bfg, *gn, *wout, *gmix, *gffn, *wg, *wu, *wd, *gfin;
    float* out; unsigned char* ws;
};

__device__ __forceinline__ int tid_fresh() { int t = threadIdx.x; asm volatile("" : "+v"(t)); return t; }

__device__ __forceinline__ Params fresh_params(const Params& p) {
    Params q = p;
    asm volatile("" : "+s"(q.out), "+s"(q.ws), "+s"(q.ck), "+s"(q.cv), "+s"(q.clf), "+s"(q.sr), "+s"(q.gn));
    return q;
}

namespace pg8 {
#define PG8_LAS __attribute__((address_space(3)))
typedef unsigned short bf16_t;
typedef short bf16x8 __attribute__((ext_vector_type(8)));
typedef float f32x4 __attribute__((ext_vector_type(4)));
typedef unsigned u32x4 __attribute__((ext_vector_type(4)));
constexpr int BM = 256, BK = 64, HALF = 128, HTB = HALF * BK * 2  , STAGE_BYTES = 8 * HTB, NXCD = 8, WGM = 8;

__host__ __device__ __forceinline__ int lds_byte(int r, int c) { const int st = (r >> 4) * 2 + (c >> 5), rr = r & 15, cc = c & 31, ob = rr * 64 + cc * 2; return st * 1024 + (ob ^ (((ob >> 9) & 1) << 5)); }
__host__ __device__ __forceinline__ void stage_rc(int b, int& R, int& C) { const int st = b / 1024, sb = b % 1024, swz = sb ^ (((sb >> 9) & 1) << 5); R = (st >> 1) * 16 + swz / 64; C = (st & 1) * 32 + (swz % 64) / 2; }
__host__ __device__ __forceinline__ int perm32(int rho) { const int n = rho >> 4, i = rho & 15; return 8 * (i >> 2) + 4 * n + (i & 3); }

struct Unit { int pm, pn; };
struct Gemm { const bf16_t* A; const bf16_t* Bt; int M, N, K, ld; };

struct StaticOrder {
    int nM, nN, nwg, G, c;
    __host__ __device__ void init(int M, int N, int G_, int c_) { nM = M / BM; nN = N / BM; nwg = nM * nN; G = G_; c = c_; }
    __host__ __device__ bool next(int i, Unit& u) const {
        const long L = (long)i * G + c; if (L >= nwg) return false;
        int wgid = (int)L; { const int q = nwg / NXCD, r = nwg % NXCD, xcd = wgid % NXCD, off = wgid / NXCD; wgid = (xcd < r ? xcd * (q + 1) : r * (q + 1) + (xcd - r) * q) + off; }
        const int nig = WGM * nN, gid = wgid / nig, fm = gid * WGM, gsz = (nM - fm) < WGM ? (nM - fm) : WGM;
        u.pm = fm + ((wgid % nig) % gsz); u.pn = (wgid % nig) / gsz; return true;
    }
    __device__ __forceinline__ void a_ready(const Unit&) const {}
    __device__ __forceinline__ void done(const Unit&) const {}
};


struct OneUnit { int pm, pn;
    __device__ __forceinline__ bool next(int i, Unit& u) const { if (i) return false; u.pm = pm; u.pn = pn; return true; }
    __device__ __forceinline__ void a_ready(const Unit&) const {}
    __device__ __forceinline__ void done(const Unit&) const {}
};
typedef float f32x2 __attribute__((ext_vector_type(2)));
typedef __bf16 bf16x2_t __attribute__((ext_vector_type(2)));
typedef unsigned u32x2 __attribute__((ext_vector_type(2)));
__device__ __forceinline__ unsigned cvt_pk_bf16(float lo, float hi) { f32x2 v = {lo, hi}; bf16x2_t b = __builtin_convertvector(v, bf16x2_t); return __builtin_bit_cast(unsigned, b); }
__device__ __forceinline__ float silu_f(float x) { return x * __builtin_amdgcn_rcpf(1.f + __builtin_amdgcn_exp2f(x * -1.4426950408889634f)); }

struct EpiInProj {
    static constexpr bool PERM = true, AFTER_DRAIN = false; static constexpr int NPRE = 0;
    bf16_t* Z; float* out; const float* cs;
    __device__ __forceinline__ void operator()(const f32x4 (&acc)[2][2][4][2], const Unit& u, int wr, int wc, int fr, int fq) const {
        const int pn = u.pn, row0 = u.pm * BM + wr * 64 + fr; const bool prompt = u.pm < (MP / BM);
        if (pn < 4) {
            const float sc = pn < 2 ? 0.08838834764831845f : 1.f; const int d0 = 16 * wc + 4 * fq;
#pragma unroll
            for (int ai = 0; ai < 2; ++ai)
#pragma unroll
                for (int m = 0; m < 4; ++m) { const int row = row0 + ai * HALF + m * 16; const int tix = prompt ? (row & (TSEQ - 1)) : TSEQ + ((row - MP) & (NSMP - 1));
                    const float* cr = cs + (size_t)tix * 128 + 2 * d0; const f32x4 c01 = *(const f32x4*)cr, c23 = *(const f32x4*)(cr + 4);
                    bf16_t* zrow = Z + (size_t)row * NZ + pn * BM + d0;
#pragma unroll
                    for (int bj = 0; bj < 2; ++bj) { const f32x4 v0 = acc[ai][bj][m][0], v1 = acc[ai][bj][m][1];
                        const float a0 = (v0[0] * c01[0] - v0[1] * c01[1]) * sc, b0 = (v0[0] * c01[1] + v0[1] * c01[0]) * sc;
                        const float a1 = (v0[2] * c01[2] - v0[3] * c01[3]) * sc, b1 = (v0[2] * c01[3] + v0[3] * c01[2]) * sc;
                        const float a2 = (v1[0] * c23[0] - v1[1] * c23[1]) * sc, b2 = (v1[0] * c23[1] + v1[1] * c23[0]) * sc;
                        const float a3 = (v1[2] * c23[2] - v1[3] * c23[3]) * sc, b3 = (v1[2] * c23[3] + v1[3] * c23[2]) * sc;
                        u32x2 w1, w2; w1.x = cvt_pk_bf16(a0, a1); w1.y = cvt_pk_bf16(a2, a3); w2.x = cvt_pk_bf16(b0, b1); w2.y = cvt_pk_bf16(b2, b3);
                        *(u32x2*)(zrow + bj * HALF) = w1; *(u32x2*)(zrow + bj * HALF + 64) = w2; } }
        } else {
            const float sc = (pn == 8 || pn == 9) ? C2F : 1.f; const int cw = wc * 32 + 8 * fq;
            float* fo = nullptr; size_t fstride = 512;
            if (pn >= 10) { const bool isv = pn >= 12; const int cb = (pn - (isv ? 12 : 10)) * BM + cw;
                fo = prompt ? out + (isv ? O_FVP : O_FKP) + (size_t)row0 * 512 + cb : out + (isv ? O_FVS : O_FKS) + (size_t)(row0 - MP) * 512 + cb; }
#pragma unroll
            for (int ai = 0; ai < 2; ++ai)
#pragma unroll
                for (int m = 0; m < 4; ++m) { bf16_t* rowp = Z + (size_t)(row0 + ai * HALF + m * 16) * NZ + pn * BM + cw; float* fr_ = fo + (size_t)(ai * HALF + m * 16) * fstride;
#pragma unroll
                    for (int bj = 0; bj < 2; ++bj) { const f32x4 v0 = acc[ai][bj][m][0] * sc, v1 = acc[ai][bj][m][1] * sc;
                        u32x4 w; w.x = cvt_pk_bf16(v0[0], v0[1]); w.y = cvt_pk_bf16(v0[2], v0[3]); w.z = cvt_pk_bf16(v1[0], v1[1]); w.w = cvt_pk_bf16(v1[2], v1[3]);
                        *(u32x4*)(rowp + bj * HALF) = w;
                        if (fo) { __builtin_nontemporal_store(v0, (f32x4*)(fr_ + bj * HALF)); __builtin_nontemporal_store(v1, (f32x4*)(fr_ + bj * HALF + 4)); } } }
        }
    }
};
struct EpiResid {
    static constexpr bool PERM = false, AFTER_DRAIN = false; static constexpr int NPRE = 0;
    const float* xp; const float* xs; float* Y; bf16_t* Yb; float* ss; const bf16_t* Xb;
    __device__ __forceinline__ void operator()(const f32x4 (&acc)[2][2][4][2], const Unit& u, int wr, int wc, int fr, int fq) const {
        const int row0 = u.pm * BM + wr * 64 + fr, col0 = u.pn * BM + wc * 32 + 4 * fq; const bool prompt = u.pm < (MP / BM);
#pragma unroll
        for (int ai = 0; ai < 2; ++ai)
#pragma unroll
            for (int m = 0; m < 4; ++m) { const int row = row0 + ai * HALF + m * 16; const size_t off = (size_t)row * DM + col0; float* yr = Y ? Y + off : nullptr;
                const float* br = xp ? (prompt ? xp + off : xs + ((size_t)(row - MP) * DM + col0)) : (const float*)yr; float s = 0.f;
#pragma unroll
                for (int bj = 0; bj < 2; ++bj)
#pragma unroll
                    for (int n = 0; n < 2; ++n) { const int co = bj * HALF + n * 16; f32x4 bs;
                        if (Xb) { const u32x2 w = *(const u32x2*)(Xb + off + co); bs = (f32x4){__uint_as_float(w.x << 16), __uint_as_float(w.x & 0xffff0000u), __uint_as_float(w.y << 16), __uint_as_float(w.y & 0xffff0000u)}; }
                        else if (br) bs = *(const f32x4*)(br + co); else bs = (f32x4){0.f, 0.f, 0.f, 0.f};
                        const f32x4 v = acc[ai][bj][m][n] + bs; if (Y) *(f32x4*)(yr + co) = v;
                        s += (v[0] * v[0] + v[1] * v[1]) + (v[2] * v[2] + v[3] * v[3]);
                        if (Yb) { u32x2 w; w.x = cvt_pk_bf16(v[0], v[1]); w.y = cvt_pk_bf16(v[2], v[3]); *(u32x2*)(Yb + off + co) = w; } }
                if (ss) { s += __shfl_xor(s, 16); s += __shfl_xor(s, 32); }
                if (ss && fq == 0) atomicAdd(ss + row, s); }
    }
};
struct EpiGateUp {
    static constexpr bool PERM = true, AFTER_DRAIN = false; static constexpr int NPRE = 8;
    bf16_t* H; const float* ss;
    __device__ __forceinline__ void pre(float (&px)[8], const Unit& u, int wr, int fr) const {
        const int row0 = u.pm * BM + wr * 64 + fr;
#pragma unroll
        for (int ai = 0; ai < 2; ++ai)
#pragma unroll
            for (int m = 0; m < 4; ++m) px[ai * 4 + m] = ss[row0 + ai * HALF + m * 16];
    }
    __device__ __forceinline__ void operator()(const f32x4 (&acc)[2][2][4][2], const Unit& u, int wr, int wc, int fr, int fq, const float (&px)[8]) const {
        const int row0 = u.pm * BM + wr * 64 + fr, f0 = u.pn * 128 + wc * 16 + 4 * fq;
#pragma unroll
        for (int ai = 0; ai < 2; ++ai)
#pragma unroll
            for (int m = 0; m < 4; ++m) { const int row = row0 + ai * HALF + m * 16; const float r = 1.0f / sqrtf(px[ai * 4 + m] * (1.0f / DM) + 1e-6f);
#pragma unroll
                for (int bj = 0; bj < 2; ++bj) { const f32x4 v0 = acc[ai][bj][m][0] * r, v1 = acc[ai][bj][m][1] * r;
                    u32x2 w; w.x = cvt_pk_bf16(silu_f(v0[0]) * v0[1], silu_f(v0[2]) * v0[3]); w.y = cvt_pk_bf16(silu_f(v1[0]) * v1[1], silu_f(v1[2]) * v1[3]);
                    *(u32x2*)(H + (size_t)row * DFF + f0 + bj * 64) = w; } }
    }
};
struct EpiAtomic {
    static constexpr bool PERM = false, AFTER_DRAIN = false; static constexpr int NPRE = 0;
    float* Y;
    __device__ __forceinline__ void operator()(const f32x4 (&acc)[2][2][4][2], const Unit& u, int wr, int wc, int fr, int fq) const {
        const int row0 = u.pm * BM + wr * 64 + fr, col0 = u.pn * BM + wc * 32 + 4 * fq;
#pragma unroll
        for (int ai = 0; ai < 2; ++ai)
#pragma unroll
            for (int m = 0; m < 4; ++m) { float* yr = Y + (size_t)(row0 + ai * HALF + m * 16) * DM + col0;
#pragma unroll
                for (int bj = 0; bj < 2; ++bj)
#pragma unroll
                    for (int n = 0; n < 2; ++n) { const f32x4 v = acc[ai][bj][m][n]; float* y = yr + bj * HALF + n * 16;
#pragma unroll
                        for (int e = 0; e < 4; ++e) __hip_atomic_fetch_add(y + e, v[e], __ATOMIC_RELAXED, __HIP_MEMORY_SCOPE_AGENT); } }
    }
};

template <class Epi, class Sched, bool ALIGN_EPI = false, bool SP2 = false>
__device__ __forceinline__ void gemm_phase(PG8_LAS unsigned char* lds, const Gemm g, const Sched& S, const Epi& E) {
    const int tid = tid_fresh(), wid = __builtin_amdgcn_readfirstlane(tid >> 6), lane = tid & 63, wr = wid >> 2, wc = wid & 3, fr = lane & 15, fq = lane >> 4;
    const int K = g.ld, nt = g.K / BK;
    unsigned voffA[2], voffB[2];
#pragma unroll
    for (int i = 0; i < 2; ++i) { int R, C; stage_rc(tid * 16 + i * 8192, R, C); const int Rb = Epi::PERM ? ((R & ~31) + perm32(R & 31)) : R;
        voffA[i] = (unsigned)(R * K + C) * 2u; voffB[i] = (unsigned)(Rb * K + C) * 2u; }
    const size_t kstep = (size_t)(BK * 2);
    const size_t hstep = (size_t)HALF * K * 2;
    const size_t tstep = 2 * hstep;
    const unsigned ldsw = (unsigned)wid * 1024u;
    const int aoff = lds_byte(wr * 64 + fr, fq * 8), boff = lds_byte(wc * 32 + fr, fq * 8);
#define PG8_SA(b, h) (((b) * 2 + (h)) * HTB)
#define PG8_SB(b, h) ((4 + (b) * 2 + (h)) * HTB)
#define PG8_STAGE(bufoff, gbase, voff) do { _Pragma("unroll") for (int _i = 0; _i < 2; ++_i) \
        __builtin_amdgcn_global_load_lds((const unsigned*)((const char*)(gbase) + (voff)[_i]), (PG8_LAS unsigned*)(lds + (bufoff) + ldsw + _i * 8192), 16, 0, 0); } while (0)
#define PG8_LDA(dst, b, h) do { _Pragma("unroll") for (int m = 0; m < 4; ++m) _Pragma("unroll") for (int k = 0; k < 2; ++k) dst[m][k] = *(const PG8_LAS bf16x8*)(lds + PG8_SA(b, h) + aoff + m * 2048 + k * 1024); } while (0)
#define PG8_LDB(dst, b, h) do { _Pragma("unroll") for (int n = 0; n < 2; ++n) _Pragma("unroll") for (int k = 0; k < 2; ++k) dst[n][k] = *(const PG8_LAS bf16x8*)(lds + PG8_SB(b, h) + boff + n * 2048 + k * 1024); } while (0)
#define PG8_MMA(ai, bj, At, Bt) do { __builtin_amdgcn_s_setprio(1); _Pragma("unroll") for (int m = 0; m < 4; ++m) _Pragma("unroll") for (int n = 0; n < 2; ++n) _Pragma("unroll") for (int k = 0; k < 2; ++k) \
        acc[ai][bj][m][n] = __builtin_amdgcn_mfma_f32_16x16x32_bf16(Bt[n][k], At[m][k], acc[ai][bj][m][n], 0, 0, 0); __builtin_amdgcn_s_setprio(0); } while (0)
#define PG8_WAIT_V(n) asm volatile("s_waitcnt vmcnt(" #n ")" ::: "memory")
#define PG8_WAIT_L(n) asm volatile("s_waitcnt lgkmcnt(" #n ")" ::: "memory")
#define PG8_BAR __builtin_amdgcn_s_barrier()
#define PG8_SCHED __builtin_amdgcn_sched_barrier(0)
    Unit cur, nxt; int ui = 0;
    if (!S.next(0, cur)) return;
    float prex[8]; if constexpr (Epi::NPRE > 0) E.pre(prex, cur, wr, fr);
    f32x4 acc[2][2][4][2];
#pragma unroll
    for (int a = 0; a < 2; ++a)
#pragma unroll
        for (int b = 0; b < 2; ++b)
#pragma unroll
            for (int m = 0; m < 4; ++m)
#pragma unroll
                for (int n = 0; n < 2; ++n) acc[a][b][m][n] = (f32x4){0.f, 0.f, 0.f, 0.f};
    bf16x8 At[4][2], B0[2][2], B1[2][2];
    const char* cA = (const char*)g.A + (size_t)cur.pm * tstep; const char* cB = (const char*)g.Bt + (size_t)cur.pn * tstep;
    S.a_ready(cur);
    if constexpr (SP2) {
        PG8_STAGE(PG8_SB(0, 0), cB, voffB); PG8_STAGE(PG8_SB(0, 1), cB + hstep, voffB); PG8_STAGE(PG8_SA(0, 0), cA, voffA); PG8_STAGE(PG8_SA(0, 1), cA + hstep, voffA);
        if (wr == 1) PG8_BAR;
        PG8_WAIT_V(2); PG8_BAR;
        PG8_STAGE(PG8_SB(1, 0), cB + kstep, voffB); PG8_STAGE(PG8_SA(1, 0), cA + kstep, voffA); PG8_STAGE(PG8_SB(1, 1), cB + hstep + kstep, voffB);
        PG8_WAIT_V(6); PG8_BAR;
    } else {
        PG8_STAGE(PG8_SB(0, 0), cB, voffB); PG8_STAGE(PG8_SA(0, 0), cA, voffA); PG8_STAGE(PG8_SB(0, 1), cB + hstep, voffB); PG8_STAGE(PG8_SA(0, 1), cA + hstep, voffA);
        if (wr == 1) PG8_BAR;
        PG8_WAIT_V(4); PG8_BAR;
        PG8_STAGE(PG8_SB(1, 0), cB + kstep, voffB); PG8_STAGE(PG8_SA(1, 0), cA + kstep, voffA); PG8_STAGE(PG8_SB(1, 1), cB + hstep + kstep, voffB);
        PG8_WAIT_V(6); PG8_BAR;
    }
    for (;;) {
        const bool has_next = S.next(ui + 1, nxt);
        const char* nA = has_next ? (const char*)g.A + (size_t)nxt.pm * tstep : cA; const char* nB = has_next ? (const char*)g.Bt + (size_t)nxt.pn * tstep : cB;
        for (int t = 0; t < nt; t += 2) {
            const bool last = (t == nt - 2);
            const char* a1 = cA + (size_t)(t + 1) * kstep;
            const char* a2 = last ? nA : cA + (size_t)(t + 2) * kstep; const char* b2 = last ? nB : cB + (size_t)(t + 2) * kstep;
            const char* a3 = a2 + kstep; const char* b3 = b2 + kstep;
            if (last && has_next) S.a_ready(nxt);
            if constexpr (SP2) {
            PG8_LDB(B0, 0, 0); PG8_LDB(B1, 0, 1); PG8_SCHED; PG8_LDA(At, 0, 0); PG8_STAGE(PG8_SA(1, 1), a1 + hstep, voffA);
            PG8_WAIT_V(8); PG8_WAIT_L(0); PG8_BAR; PG8_MMA(0, 0, At, B0); PG8_MMA(0, 1, At, B1); PG8_BAR; PG8_SCHED;
            PG8_LDA(At, 0, 1); PG8_STAGE(PG8_SB(0, 0), b2, voffB); PG8_STAGE(PG8_SB(0, 1), b2 + hstep, voffB); PG8_STAGE(PG8_SA(0, 0), a2, voffA);
            PG8_WAIT_V(8); PG8_WAIT_L(0); PG8_BAR; PG8_MMA(1, 0, At, B0); PG8_MMA(1, 1, At, B1); PG8_BAR; PG8_SCHED;
            PG8_LDB(B0, 1, 0); PG8_LDB(B1, 1, 1); PG8_SCHED; PG8_LDA(At, 1, 0); PG8_STAGE(PG8_SA(0, 1), a2 + hstep, voffA);
            PG8_WAIT_V(8); PG8_WAIT_L(0); PG8_BAR; PG8_MMA(0, 0, At, B0); PG8_MMA(0, 1, At, B1); PG8_BAR; PG8_SCHED;
            PG8_LDA(At, 1, 1); PG8_STAGE(PG8_SB(1, 0), b3, voffB); PG8_STAGE(PG8_SB(1, 1), b3 + hstep, voffB); PG8_STAGE(PG8_SA(1, 0), a3, voffA);
            PG8_WAIT_V(8); PG8_WAIT_L(0); PG8_BAR; PG8_MMA(1, 0, At, B0); PG8_MMA(1, 1, At, B1); PG8_BAR; PG8_SCHED;
            } else {
            PG8_LDB(B0, 0, 0); PG8_SCHED; PG8_LDA(At, 0, 0); PG8_STAGE(PG8_SA(1, 1), a1 + hstep, voffA);
            PG8_WAIT_L(8); PG8_BAR; PG8_WAIT_L(0); PG8_MMA(0, 0, At, B0); PG8_BAR; PG8_SCHED;
            PG8_LDB(B1, 0, 1); PG8_STAGE(PG8_SB(0, 0), b2, voffB);
            PG8_BAR; PG8_WAIT_L(0); PG8_MMA(0, 1, At, B1); PG8_BAR;
            PG8_LDA(At, 0, 1); PG8_STAGE(PG8_SA(0, 0), a2, voffA);
            PG8_BAR; PG8_WAIT_L(0); PG8_MMA(1, 0, At, B0); PG8_BAR; PG8_SCHED;
            PG8_STAGE(PG8_SB(0, 1), b2 + hstep, voffB);
            PG8_WAIT_V(6); PG8_BAR; PG8_MMA(1, 1, At, B1); PG8_BAR;
            PG8_LDB(B0, 1, 0); PG8_SCHED; PG8_LDA(At, 1, 0); PG8_STAGE(PG8_SA(0, 1), a2 + hstep, voffA);
            PG8_WAIT_L(8); PG8_BAR; PG8_WAIT_L(0); PG8_MMA(0, 0, At, B0); PG8_BAR; PG8_SCHED;
            PG8_LDB(B1, 1, 1); PG8_STAGE(PG8_SB(1, 0), b3, voffB);
            PG8_BAR; PG8_WAIT_L(0); PG8_MMA(0, 1, At, B1); PG8_BAR;
            PG8_LDA(At, 1, 1); PG8_STAGE(PG8_SA(1, 0), a3, voffA);
            PG8_BAR; PG8_WAIT_L(0); PG8_MMA(1, 0, At, B0); PG8_BAR; PG8_SCHED;
            PG8_STAGE(PG8_SB(1, 1), b3 + hstep, voffB);
            PG8_WAIT_V(6); PG8_BAR; PG8_MMA(1, 1, At, B1); PG8_BAR;
            }
        }
        if constexpr (ALIGN_EPI) { if (wr == 0) PG8_BAR; }
        if constexpr (!Epi::AFTER_DRAIN) { if constexpr (Epi::NPRE > 0) E(acc, cur, wr, wc, fr, fq, prex); else E(acc, cur, wr, wc, fr, fq); S.done(cur); }
        if (!has_next) break;
#pragma unroll
        for (int a = 0; a < 2; ++a)
#pragma unroll
            for (int b = 0; b < 2; ++b)
#pragma unroll
                for (int m = 0; m < 4; ++m)
#pragma unroll
                    for (int n = 0; n < 2; ++n) acc[a][b][m][n] = (f32x4){0.f, 0.f, 0.f, 0.f};
        cur = nxt; cA = nA; cB = nB; ++ui;
        if constexpr (Epi::NPRE > 0) E.pre(prex, cur, wr, fr);
        if constexpr (ALIGN_EPI) { if (wr == 1) PG8_BAR; }
    }
    PG8_WAIT_V(0);
    if constexpr (!ALIGN_EPI) { if (wr == 0) PG8_BAR; }
    PG8_BAR;
    if constexpr (Epi::AFTER_DRAIN) { E.fused(acc, cur, wr, wc, fr, fq, lds, wid, lane); S.done(cur); }
#undef PG8_SA
#undef PG8_SB
#undef PG8_STAGE
#undef PG8_LDA
#undef PG8_LDB
#undef PG8_MMA
#undef PG8_WAIT_V
#undef PG8_WAIT_L
#undef PG8_BAR
#undef PG8_SCHED
}
}
#include <hip/hip_bf16.h>
#include <cmath>
namespace attn_body {
using bf16=__hip_bfloat16;
using bf16x8=__attribute__((ext_vector_type(8)))short;
using s16x4=__attribute__((ext_vector_type(4)))short;
using f32x16=__attribute__((ext_vector_type(16)))float;
using u32x4=__attribute__((ext_vector_type(4)))unsigned;
using f32x4b=__attribute__((ext_vector_type(4)))float;
constexpr int BATCH=16,NHEAD=8,SEQ=2048,D=64,PQ=3584,PO=1024;
constexpr int NW=8,QBLK=32,QB=QBLK*NW,KVBLK=64,NQB=SEQ/QB;
constexpr int ATTN_UNIT_ROWS=QB;
__device__ __forceinline__ int crow(int r,int hi){return (r&3)+8*(r>>2)+4*hi;}
#define SBAR() __builtin_amdgcn_sched_barrier(0)
__device__ __forceinline__ void cmask(f32x16&p0,f32x16&p1,int jb,int qrel,int hi){
  const float NEG=-INFINITY; int kb=64*jb+4*hi;
  #pragma unroll
  for(int r=0;r<16;++r){int kv=kb+(r&3)+8*(r>>2); if(kv>qrel)p0[r]=NEG; if(kv+32>qrel)p1[r]=NEG;}
}

constexpr int NSLOT=3, SLOTB=8192;
constexpr int LDS_K=0, LDS_V=NSLOT*SLOTB, LDS_WS=2*NSLOT*SLOTB, LDS_OST=LDS_WS+NW*64*4, LDS_BIAS=LDS_OST+NW*4096, LDS_BYTES=LDS_BIAS+SEQ*4;
constexpr float C2=0.125f*1.4426950408889634f;
__device__ __forceinline__ void glds16(const void*gsrc,unsigned lds_dst){unsigned keep;
  asm volatile("s_mov_b32 %0, m0\n\ts_mov_b32 m0, %2\n\ts_nop 0\n\tglobal_load_lds_dwordx4 %1, off\n\ts_mov_b32 m0, %0":"=&s"(keep):"v"(gsrc),"s"(lds_dst):"memory");}
__device__ __forceinline__ float max3f(float a,float b,float c){float r;asm("v_max3_f32 %0, %1, %2, %3":"=v"(r):"v"(a),"v"(b),"v"(c));return r;}
__device__ __forceinline__ float max2f(float a,float b){float r;asm("v_max_f32_e32 %0, %1, %2":"=v"(r):"v"(a),"v"(b));return r;}
__device__ __forceinline__ float fadd_s(float a,float b){float r;asm("v_add_f32_e32 %0, %1, %2":"=v"(r):"v"(a),"v"(b));return r;}
__device__ __forceinline__ float fsub_s(float a,float b){float r;asm("v_sub_f32_e32 %0, %1, %2":"=v"(r):"v"(a),"v"(b));return r;}
typedef float f32x2_t __attribute__((ext_vector_type(2))); typedef __bf16 bf16x2_t __attribute__((ext_vector_type(2)));
__device__ __forceinline__ unsigned cvtpk_s(float lo,float hi){f32x2_t v={lo,hi};bf16x2_t b=__builtin_convertvector(v,bf16x2_t);return __builtin_bit_cast(unsigned,b);}
#define WAIT_BAR(N) asm volatile("s_waitcnt vmcnt(" #N ") lgkmcnt(0)\n\ts_barrier":::"memory")

__device__ __forceinline__ void qkt(f32x16&p0,f32x16&p1,const char*Kslot,const bf16x8*qr,const f32x16&negm,int r32,int hi){
  const char*kb=Kslot+hi*1024+r32*16;
  #pragma unroll
  for(int d0=0;d0<4;++d0){
    const bf16x8 b0=*reinterpret_cast<const bf16x8*>(kb+d0*2048);
    const bf16x8 b1=*reinterpret_cast<const bf16x8*>(kb+d0*2048+512);
    if(d0==0){p0=__builtin_amdgcn_mfma_f32_32x32x16_bf16(b0,qr[0],negm,0,0,0);p1=__builtin_amdgcn_mfma_f32_32x32x16_bf16(b1,qr[0],negm,0,0,0);}
    else{p0=__builtin_amdgcn_mfma_f32_32x32x16_bf16(b0,qr[d0],p0,0,0,0);p1=__builtin_amdgcn_mfma_f32_32x32x16_bf16(b1,qr[d0],p1,0,0,0);}}
}
typedef __attribute__((address_space(3))) const char* lds_cptr;
typedef short v4i16_t __attribute__((ext_vector_type(4)));
__device__ __forceinline__ void kload8(bf16x8*kf,lds_cptr kp){
  kf[0]=*(const __attribute__((address_space(3))) bf16x8*)(kp);      kf[1]=*(const __attribute__((address_space(3))) bf16x8*)(kp+512);
  kf[2]=*(const __attribute__((address_space(3))) bf16x8*)(kp+2048); kf[3]=*(const __attribute__((address_space(3))) bf16x8*)(kp+2560);
  kf[4]=*(const __attribute__((address_space(3))) bf16x8*)(kp+4096); kf[5]=*(const __attribute__((address_space(3))) bf16x8*)(kp+4608);
  kf[6]=*(const __attribute__((address_space(3))) bf16x8*)(kp+6144); kf[7]=*(const __attribute__((address_space(3))) bf16x8*)(kp+6656);
}
__device__ __forceinline__ void kload2(bf16x8*kf,lds_cptr kp,int j){ kf[2*j]=*(const __attribute__((address_space(3))) bf16x8*)(kp+j*2048); kf[2*j+1]=*(const __attribute__((address_space(3))) bf16x8*)(kp+j*2048+512); }
__device__ __forceinline__ s16x4 vtr(lds_cptr p){ return __builtin_bit_cast(s16x4,__builtin_amdgcn_ds_read_tr16_b64_v4i16((__attribute__((address_space(3))) v4i16_t*)p)); }
__device__ __forceinline__ float rowmax(const f32x16&p0,const f32x16&p1){
  float a=max3f(p0[0],p0[1],p1[0]),b=max3f(p0[2],p0[3],p1[1]);a=max3f(a,p1[2],p1[3]);
  #pragma unroll
  for(int r=4;r<16;r+=4){a=max3f(a,p0[r],p0[r+1]);b=max3f(b,p0[r+2],p0[r+3]);a=max3f(a,p1[r],p1[r+1]);b=max3f(b,p1[r+2],p1[r+3]);}
  const float m=max2f(a,b);
  auto rr=__builtin_amdgcn_permlane32_swap(__float_as_uint(m),__float_as_uint(m),false,false);
  return max2f(__uint_as_float(rr[0]),__uint_as_float(rr[1]));
}
__device__ __forceinline__ void pv(f32x16*o,int vb,bf16x8 pa0,bf16x8 pa1,bf16x8 pa2,bf16x8 pa3){
  #pragma unroll
  for(int d0=0;d0<2;++d0){s16x4 lo[4],hi[4];
    #pragma unroll
    for(int ks=0;ks<4;++ks){
      asm volatile("ds_read_b64_tr_b16 %0,%1 offset:%c2":"=&v"(lo[ks]):"v"(vb),"i"(d0*4096+ks*1024):"memory");
      asm volatile("ds_read_b64_tr_b16 %0,%1 offset:%c2":"=&v"(hi[ks]):"v"(vb),"i"(d0*4096+ks*1024+512):"memory");}
    asm volatile("s_waitcnt lgkmcnt(0)":::"memory");SBAR();
    #define PK(k) (bf16x8){lo[k][0],lo[k][1],lo[k][2],lo[k][3],hi[k][0],hi[k][1],hi[k][2],hi[k][3]}
    o[d0]=__builtin_amdgcn_mfma_f32_32x32x16_bf16(pa0,PK(0),o[d0],0,0,0);
    o[d0]=__builtin_amdgcn_mfma_f32_32x32x16_bf16(pa1,PK(1),o[d0],0,0,0);
    o[d0]=__builtin_amdgcn_mfma_f32_32x32x16_bf16(pa2,PK(2),o[d0],0,0,0);
    o[d0]=__builtin_amdgcn_mfma_f32_32x32x16_bf16(pa3,PK(3),o[d0],0,0,0);
    #undef PK
  }
}

#ifndef ATTN_STORE16
#define ATTN_STORE16(p,v) (*(u32x4*)(p)=(v))
#endif
template<int THRL> __device__ __forceinline__ void attn_unit(int b,int h,int qb,const bf16*Q,const bf16*__restrict__ K,const bf16*__restrict__ V,bf16*O,const float*__restrict__ CB,char*shm){
  const int tid=tid_fresh(),lane=tid&63,r32=lane&31,hi=lane>>5; const int wid=__builtin_amdgcn_readfirstlane(tid>>6);
  const long rowbase=(long)b*SEQ; const int q0=qb*QB;
  const bf16*Qw=Q+(rowbase+q0+wid*QBLK)*PQ+h*D;
  const bf16*Kh=K+rowbase*PQ+h*D,*Vh=V+rowbase*PQ+h*D;
  const unsigned lds0=(unsigned)(uintptr_t)shm;
  float*wsf=(float*)(shm+LDS_WS)+wid*64;
  const bf16*ksrc=Kh+(long)lane*PQ+wid*8;
  const bf16*vsrc=Vh+(long)(16*(wid&3)+(lane>>2))*PQ+(wid>>2)*32+(lane&3)*8;
  const unsigned kdst=lds0+LDS_K+wid*1024, vdst=lds0+LDS_V+wid*1024;
  #define DMA_K(t,slot) glds16(ksrc+(long)(t)*KVBLK*PQ,(unsigned)__builtin_amdgcn_readfirstlane(kdst+(slot)))
  #define DMA_V(t,slot) glds16(vsrc+(long)(t)*KVBLK*PQ,(unsigned)__builtin_amdgcn_readfirstlane(vdst+(slot)))
  const int vb0=(int)(lds0+LDS_V)+((lane>>4)&1)*32+(lane&3)*8+(4*hi+((lane&15)>>2))*64;
  const char*Kbase=shm+LDS_K; bf16x8 kf[8];
  const lds_cptr shm3=(lds_cptr)shm; const lds_cptr kp0=shm3+LDS_K+hi*1024+r32*16; const lds_cptr vp0=shm3+LDS_V+((lane>>4)&1)*32+(lane&3)*8+(4*hi+((lane&15)>>2))*64;
  const int NT=(q0+QB)/KVBLK;
  { const float*cb=CB+(long)(b*NHEAD+h)*SEQ; float*bl=(float*)(shm+LDS_BIAS); for(int i=tid;i<NT*KVBLK;i+=NW*64)bl[i]=cb[i]*(-1.4426950408889634f); }
  const lds_cptr bp0=(lds_cptr)shm+LDS_BIAS+hi*16;
  #define KBIAS(P0,P1,t) do{ const lds_cptr bp_=bp0+(t)*256; _Pragma("unroll") for(int g_=0;g_<4;++g_){ const f32x4b a_=*(const __attribute__((address_space(3))) f32x4b*)(bp_+g_*32); const f32x4b c_=*(const __attribute__((address_space(3))) f32x4b*)(bp_+128+g_*32); \
      P0[4*g_]+=a_[0];P0[4*g_+1]+=a_[1];P0[4*g_+2]+=a_[2];P0[4*g_+3]+=a_[3]; P1[4*g_]+=c_[0];P1[4*g_+1]+=c_[1];P1[4*g_+2]+=c_[2];P1[4*g_+3]+=c_[3]; } }while(0)
  DMA_K(0,0);DMA_V(0,0);DMA_K(1,SLOTB);
  bf16x8 qr[4];
  #pragma unroll
  for(int d0=0;d0<4;++d0)qr[d0]=*reinterpret_cast<const bf16x8*>(&Qw[(long)r32*PQ+d0*16+hi*8]);
  float mhat=0.f,l_reg=0.f;f32x16 o[2];o[0]=f32x16{};o[1]=f32x16{};f32x16 negm=f32x16{};asm volatile("":"+v"(negm));
  const int qrel=wid*QBLK+r32;
  #define CMASK(P0,P1,t) do{int jb_=(t)-(NT-4); if(jb_>=0)cmask(P0,P1,jb_,qrel,hi);}while(0)
  bool resc=false;
  #define START(P0,P1) do{ const float rm=rowmax(P0,P1); resc=false; \
    { const float dl=rm; mhat=fadd_s(mhat,dl); \
      _Pragma("unroll") for(int r=0;r<16;++r){P0[r]=fsub_s(P0[r],dl);P1[r]=fsub_s(P1[r],dl);} \
      _Pragma("unroll") for(int r=0;r<16;++r)negm[r]=-mhat; asm volatile("":"+v"(negm)); } \
    _Pragma("unroll") for(int r=0;r<16;++r)P0[r]=__builtin_amdgcn_exp2f(P0[r]); }while(0)
  #define RESC() do{ if(resc){ asm volatile("s_waitcnt lgkmcnt(0)":::"memory"); \
      _Pragma("unroll") for(int d_=0;d_<2;++d_) _Pragma("unroll") for(int r=0;r<16;++r)o[d_][r]*=wsf[crow(r,hi)]; } }while(0)
  f32x16 pA0,pA1,pB0,pB1;
  int sl_prev=0,sl_cur=0,sl_next=SLOTB;
  #define ROT() do{sl_prev=sl_cur;sl_cur=sl_next;sl_next=(sl_next==(NSLOT-1)*SLOTB)?0:sl_next+SLOTB;}while(0)
  DMA_K(2,2*SLOTB);
  WAIT_BAR(3);
  qkt(pA0,pA1,Kbase,qr,negm,r32,hi);KBIAS(pA0,pA1,0);asm volatile("s_nop 15\n\ts_nop 7":"+v"(pA0),"+v"(pA1));CMASK(pA0,pA1,0);
  START(pA0,pA1);
  _Pragma("unroll") for(int r=0;r<16;++r)pA1[r]=__builtin_amdgcn_exp2f(pA1[r]);
  WAIT_BAR(0);
  DMA_K(3,0);DMA_V(1,SLOTB);
  ROT();
  kload8(kf,kp0+sl_cur);
  WAIT_BAR(2);
  s16x4 vlo[8],vhi[8]; u32x4 pw0,pw1,pw2,pw3;
  #define PKW(P,B) cvtpk_s(P[B],P[B+1])
  #define PAF(k) __builtin_bit_cast(bf16x8,pw##k)
  #define VFR(i) (bf16x8){vlo[i][0],vlo[i][1],vlo[i][2],vlo[i][3],vhi[i][0],vhi[i][1],vhi[i][2],vhi[i][3]}
  #define PIN(x) asm volatile("":"+v"(x))
  #define MX3(a,b,c) __builtin_fmaxf(__builtin_fmaxf((a),(b)),(c))
  #define GAPA(MF,A0,A1,A2,A3,W0,W1,PW) do{ MF; sacc+=A0; sacc+=A1; sacc+=A2; sacc+=A3; PIN(sacc); W0; W1; PIN(PW); SBAR(); }while(0)
  #define EX(v) __builtin_amdgcn_exp2f(v)
  #define GAPB(MF,X,B) do{ MF; X[B]=EX(X[B]); X[B+1]=EX(X[B+1]); X[B+2]=EX(X[B+2]); X[B+3]=EX(X[B+3]); PIN(X); SBAR(); }while(0)
  #define VRD(i) do{ vlo[i]=vtr(vp_+(((i)>>2)*4096+((i)&3)*1024)); vhi[i]=vtr(vp_+(((i)>>2)*4096+((i)&3)*1024+512)); }while(0)
  #define KRD(G,j) do{ if(G){ kload2(kf,kp0+sl_next,j); SBAR(); } }while(0)
  #define STEP(C0,C1,P0,P1,t,GK,GV,GL) do{ SBAR(); \
    const lds_cptr vp_=vp0+sl_prev; \
    VRD(0); SBAR(); float sacc=(P0[0]+P0[1]); \
    GAPA(C0=__builtin_amdgcn_mfma_f32_32x32x16_bf16(kf[0],qr[0],negm,0,0,0), P0[2],P0[3],P0[4],P0[5],     pw0[0]=PKW(P0,0), pw0[1]=PKW(P0,2), pw0); \
    VRD(4); SBAR(); GAPA(C1=__builtin_amdgcn_mfma_f32_32x32x16_bf16(kf[1],qr[0],negm,0,0,0), P0[6],P0[7],P0[8],P0[9],     pw0[2]=PKW(P0,4), pw0[3]=PKW(P0,6), pw0); \
    VRD(1); SBAR(); GAPA(C0=__builtin_amdgcn_mfma_f32_32x32x16_bf16(kf[2],qr[1],C0,0,0,0),   P0[10],P0[11],P0[12],P0[13], pw1[0]=PKW(P0,8), pw1[1]=PKW(P0,10), pw1); \
    VRD(5); SBAR(); GAPA(C1=__builtin_amdgcn_mfma_f32_32x32x16_bf16(kf[3],qr[1],C1,0,0,0),   P0[14],P0[15],P1[0],P1[1],   pw1[2]=PKW(P0,12),pw1[3]=PKW(P0,14), pw1); \
    VRD(2); SBAR(); GAPA(C0=__builtin_amdgcn_mfma_f32_32x32x16_bf16(kf[4],qr[2],C0,0,0,0),   P1[2],P1[3],P1[4],P1[5],     pw2[0]=PKW(P1,0), pw2[1]=PKW(P1,2), pw2); \
    VRD(6); SBAR(); GAPA(C1=__builtin_amdgcn_mfma_f32_32x32x16_bf16(kf[5],qr[2],C1,0,0,0),   P1[6],P1[7],P1[8],P1[9],     pw2[2]=PKW(P1,4), pw2[3]=PKW(P1,6), pw2); \
    VRD(3); SBAR(); GAPA(C0=__builtin_amdgcn_mfma_f32_32x32x16_bf16(kf[6],qr[3],C0,0,0,0),   P1[10],P1[11],P1[12],P1[13], pw3[0]=PKW(P1,8), pw3[1]=PKW(P1,10), pw3); \
    VRD(7); SBAR(); GAPA(C1=__builtin_amdgcn_mfma_f32_32x32x16_bf16(kf[7],qr[3],C1,0,0,0),   P1[14],P1[15],0.f,0.f,       pw3[2]=PKW(P1,12),pw3[3]=PKW(P1,14), pw3); \
    l_reg+=sacc; \
    if(GK){DMA_K((t)+3,sl_cur);} if(GV){DMA_V((t)+1,sl_next);} \
    KBIAS(C0,C1,t); CMASK(C0,C1,t); \
    { float a=MX3(C0[0],C0[1],C1[0]),b=MX3(C0[2],C0[3],C1[1]); a=MX3(a,C1[2],C1[3]); \
      _Pragma("unroll") for(int r=4;r<16;r+=4){a=MX3(a,C0[r],C0[r+1]);b=MX3(b,C0[r+2],C0[r+3]);a=MX3(a,C1[r],C1[r+1]);b=MX3(b,C1[r+2],C1[r+3]);} \
      float rm=__builtin_fmaxf(a,b); { auto rr=__builtin_amdgcn_permlane32_swap(__float_as_uint(rm),__float_as_uint(rm),false,false); rm=__builtin_fmaxf(__uint_as_float(rr[0]),__uint_as_float(rr[1])); } \
      resc=false; \
      if(__builtin_expect(__any(rm>(float)THRL),0)){ const float dl=__builtin_fmaxf(rm,0.f); mhat+=dl; \
        _Pragma("unroll") for(int r=0;r<16;++r){C0[r]-=dl;C1[r]-=dl;} \
        _Pragma("unroll") for(int r=0;r<16;++r)negm[r]=-mhat; asm volatile("":"+v"(negm)); \
        const float f=__builtin_amdgcn_exp2f(-dl); l_reg*=f; if(hi==0)wsf[r32]=f; resc=true; } } \
    SBAR(); \
    GAPB(o[0]=__builtin_amdgcn_mfma_f32_32x32x16_bf16(PAF(0),VFR(0),o[0],0,0,0), C0,0); \
    GAPB(o[1]=__builtin_amdgcn_mfma_f32_32x32x16_bf16(PAF(0),VFR(4),o[1],0,0,0), C0,4); \
    KRD(GL,0); GAPB(o[0]=__builtin_amdgcn_mfma_f32_32x32x16_bf16(PAF(1),VFR(1),o[0],0,0,0), C0,8); \
    KRD(GL,1); GAPB(o[1]=__builtin_amdgcn_mfma_f32_32x32x16_bf16(PAF(1),VFR(5),o[1],0,0,0), C0,12); \
    KRD(GL,2); GAPB(o[0]=__builtin_amdgcn_mfma_f32_32x32x16_bf16(PAF(2),VFR(2),o[0],0,0,0), C1,0); \
    KRD(GL,3); GAPB(o[1]=__builtin_amdgcn_mfma_f32_32x32x16_bf16(PAF(2),VFR(6),o[1],0,0,0), C1,4); \
    GAPB(o[0]=__builtin_amdgcn_mfma_f32_32x32x16_bf16(PAF(3),VFR(3),o[0],0,0,0), C1,8); \
    GAPB(o[1]=__builtin_amdgcn_mfma_f32_32x32x16_bf16(PAF(3),VFR(7),o[1],0,0,0), C1,12); \
    }while(0)
  int t=1;
  #undef CMASK
  #define CMASK(P0,P1,t) do{}while(0)
  for(;t+5<NT;t+=2){
    STEP(pB0,pB1,pA0,pA1,t,true,true,true);     WAIT_BAR(2); RESC(); ROT();
    STEP(pA0,pA1,pB0,pB1,t+1,true,true,true);   WAIT_BAR(2); RESC(); ROT();
  }
  #undef CMASK
  #define CMASK(P0,P1,t) do{int jb_=(t)-(NT-4); if(jb_>=0)cmask(P0,P1,jb_,qrel,hi);}while(0)
  #define ENDW(tt) do{ if((tt)+3<NT){WAIT_BAR(2);} else if((tt)+2<NT){WAIT_BAR(1);} else {WAIT_BAR(0);} }while(0)
  for(;t+1<NT;t+=2){
    STEP(pB0,pB1,pA0,pA1,t,(t+3<NT),(t+1<NT),(t+1<NT));       ENDW(t);   RESC(); ROT();
    STEP(pA0,pA1,pB0,pB1,t+1,(t+4<NT),(t+2<NT),(t+2<NT));     ENDW(t+1); RESC(); ROT();
  }
  STEP(pB0,pB1,pA0,pA1,NT-1,false,false,false); RESC();
  { float sacc=pB0[0]+pB0[1]; _Pragma("unroll") for(int r=2;r<16;++r)sacc+=pB0[r]; _Pragma("unroll") for(int r=0;r<16;++r)sacc+=pB1[r]; l_reg+=sacc;
    pw0=(u32x4){PKW(pB0,0),PKW(pB0,2),PKW(pB0,4),PKW(pB0,6)};pw1=(u32x4){PKW(pB0,8),PKW(pB0,10),PKW(pB0,12),PKW(pB0,14)};pw2=(u32x4){PKW(pB1,0),PKW(pB1,2),PKW(pB1,4),PKW(pB1,6)};pw3=(u32x4){PKW(pB1,8),PKW(pB1,10),PKW(pB1,12),PKW(pB1,14)};
    SBAR(); pv(o,vb0+sl_cur,PAF(0),PAF(1),PAF(2),PAF(3)); }
  #undef PKW
  #undef PAF
  #undef VFR
  #undef PIN
  #undef MX3
  #undef GAPA
  #undef GAPB
  #undef EX
  #undef VRD
  #undef KRD
  #undef STEP
  #undef ENDW
  {auto rr=__builtin_amdgcn_permlane32_swap(__float_as_uint(l_reg),__float_as_uint(l_reg),false,false);l_reg=__uint_as_float(rr[0])+__uint_as_float(rr[1]);}
  if(hi==0)wsf[32+r32]=l_reg;asm volatile("s_waitcnt lgkmcnt(0)":::"memory");
  float rli[16];
  #pragma unroll
  for(int r=0;r<16;++r)rli[r]=__builtin_amdgcn_rcpf(wsf[32+crow(r,hi)]);
  bf16*Ow=O+(rowbase+q0+wid*QBLK)*PO+h*D;
  { bf16*stg=(bf16*)(shm+LDS_OST)+wid*2048;
    #pragma unroll
    for(int r=0;r<16;++r){const int orow=crow(r,hi);
      #pragma unroll
      for(int d0=0;d0<2;++d0)stg[orow*64+d0*32+r32]=__float2bfloat16(o[d0][r]*rli[r]);}
    asm volatile("s_waitcnt lgkmcnt(0)":::"memory");
    #pragma unroll
    for(int i=0;i<4;++i){const int row=i*8+(lane>>3),ch=lane&7; const u32x4 v=*(const u32x4*)(stg+row*64+ch*8); ATTN_STORE16(Ow+(long)row*PO+ch*8,v);} }
  asm volatile("s_waitcnt lgkmcnt(0)\n\ts_barrier":::"memory");
  #undef KBIAS
  #undef DMA_K
  #undef DMA_V
  #undef CMASK
  #undef START
  #undef RESC
  #undef ROT
}
constexpr int ATTN_LDS_BYTES=LDS_BYTES;
#undef SBAR
#undef WAIT_BAR
}
#define LAS __attribute__((address_space(3)))
typedef unsigned short bf16;
typedef unsigned u32x4 __attribute__((ext_vector_type(4)));
typedef unsigned u32x2 __attribute__((ext_vector_type(2)));
typedef float f32x4 __attribute__((ext_vector_type(4)));
typedef float f32x2 __attribute__((ext_vector_type(2)));
typedef float f32x16 __attribute__((ext_vector_type(16)));
typedef short bf16x8 __attribute__((ext_vector_type(8)));
#define RLX_AGENT __ATOMIC_RELAXED, __HIP_MEMORY_SCOPE_AGENT
constexpr int NWAVES = 8, NTHR = 512;
constexpr int LDS_BYTES = 147456, MISC_OFF = 131072 + 8192;
constexpr float LOG2E = 1.4426950408889634f;
__device__ __forceinline__ unsigned pk2(float lo, float hi) { return pg8::cvt_pk_bf16(lo, hi); }
__device__ __forceinline__ float bf2f(unsigned u16) { return __uint_as_float(u16 << 16); }
__device__ __forceinline__ int crow(int r, int hi) { return (r & 3) + 8 * (r >> 2) + 4 * hi; }
__device__ __forceinline__ float wave_sum(float v) {
#pragma unroll
    for (int o = 1; o < 64; o <<= 1) v += __shfl_xor(v, o);
    return v;
}
__device__ __forceinline__ void sincos_cw(float x, float& s, float& c) {
    const float k = rintf(x * 0.636619772367581343f);
    float r = fmaf(k, -1.5703125f, x); r = fmaf(k, -4.837512969970703125e-4f, r); r = fmaf(k, -7.54978995489188216e-8f, r);
    const float z = r * r;
    const float sp = r + r * z * (-1.6666654611e-1f + z * (8.3321608736e-3f + z * -1.9515295891e-4f));
    const float cp = 1.0f - 0.5f * z + z * z * (4.166664568298827e-2f + z * (-1.388731625493765e-3f + z * 2.443315711809948e-5f));
    const int q = ((int)k) & 3;
    s = (q == 0) ? sp : (q == 1) ? cp : (q == 2) ? -sp : -cp;
    c = (q == 0) ? cp : (q == 1) ? -sp : (q == 2) ? -cp : sp;
}
__device__ __forceinline__ float block_scan(float v, float& tot, LAS float* scr, int lane, int wid) {
#pragma unroll
    for (int o = 1; o < 64; o <<= 1) { const float n = __shfl_up(v, o); if (lane >= o) v += n; }
    if (lane == 63) scr[wid] = v;
    __syncthreads();
    float off = 0.f; tot = 0.f;
#pragma unroll
    for (int w = 0; w < NWAVES; ++w) { const float x = scr[w]; if (w < wid) off += x; tot += x; }
    __syncthreads();
    return v + off;
}

template <int MODE> __device__ __forceinline__ int rowmap(int n) {
    if (MODE == 1) return n < 1024 ? ((n & ~127) | ((n & 63) << 1) | ((n >> 6) & 1)) : n;
    if (MODE == 2) return 2 * n;
    if (MODE == 3) return 2 * n + 1;
    return n;
}
template <int MODE> __device__ __forceinline__ void p0_transpose_item(const float* W, int ldw, int K, int N, const float* ks, bf16* WT, LAS float* scr, int item, int lane) {
    const int nblk = N / 32, kb = item / nblk, nb = item % nblk, k0 = 64 * kb, n0 = 32 * nb;
#pragma unroll
    for (int i = 0; i < 32; ++i) { const int kk = 2 * i + (lane >> 5); float w = W[(size_t)(k0 + kk) * ldw + n0 + (lane & 31)]; if (ks) w *= ks[k0 + kk]; scr[kk * 33 + (lane & 31)] = w; }
    asm volatile("s_waitcnt lgkmcnt(0)" ::: "memory");
    const int c = lane & 7;
#pragma unroll
    for (int j = 0; j < 4; ++j) { const int n = (lane >> 3) + 8 * j; const LAS float* s = scr + (8 * c) * 33 + n;
        u32x4 o; o.x = pk2(s[0 * 33], s[1 * 33]); o.y = pk2(s[2 * 33], s[3 * 33]); o.z = pk2(s[4 * 33], s[5 * 33]); o.w = pk2(s[6 * 33], s[7 * 33]);
        *(u32x4*)(WT + (size_t)rowmap<MODE>(n0 + n) * K + k0 + 8 * c) = o; }
    asm volatile("s_waitcnt lgkmcnt(0)" ::: "memory");
}
__device__ __forceinline__ void p0_prep(const Params& p, LAS unsigned char* lds, int vcu, int G) {
    const int tid = tid_fresh(), lane = tid & 63, wid = __builtin_amdgcn_readfirstlane(tid >> 6);
    unsigned char* ws = p.ws;
    for (int i = blockIdx.x * NTHR + tid; i < (int)(CTL_BYTES / 4); i += G * NTHR) if (i < 4096 || i >= 4096 + 3456) ((unsigned*)(ws + WS_CTL))[i] = 0u;
    { float* cs = (float*)(ws + WS_CS);
      for (int i = blockIdx.x * NTHR + tid; i < (TSEQ + NSMP) * 64; i += G * NTHR) { const int tix = i >> 6, d = i & 63; const float pos = (float)(tix < TSEQ ? tix : PAST + tix - TSEQ);
          const float inv = exp2f((float)d * (-13.287712379549449f / 64.0f)); float s, c; sincos_cw(pos * inv, s, c); cs[2 * i] = c; cs[2 * i + 1] = s; } }
    LAS float* scr = (LAS float*)(lds + wid * 16384);
    const int gw = vcu * NWAVES + wid, NGW = G * NWAVES;
    constexpr int I_IN = (DM / 64) * (NZ / 32), I_O = (DM / 64) * (DM / 32), I_G = (DM / 64) * (DFF / 32), I_D = (DFF / 64) * (DM / 32);
#ifndef REP_P0T
#define REP_P0T 1
#endif
    for (int rept = 0; rept < REP_P0T; ++rept)
    for (int it = gw; it < I_IN + I_O + 2 * I_G + I_D; it += NGW) {
        int r = it;
        if (r < I_IN) { p0_transpose_item<1>(p.win, DIN, DM, NZ, nullptr, (bf16*)(ws + WS_WIN), scr, r, lane); continue; } r -= I_IN;
        if (r < I_O) { p0_transpose_item<0>(p.wout, DM, DM, DM, nullptr, (bf16*)(ws + WS_WO), scr, r, lane); continue; } r -= I_O;
        if (r < I_G) { p0_transpose_item<2>(p.wg, DFF, DM, DFF, p.gffn, (bf16*)(ws + WS_WGU), scr, r, lane); continue; } r -= I_G;
        if (r < I_G) { p0_transpose_item<3>(p.wu, DFF, DM, DFF, p.gffn, (bf16*)(ws + WS_WGU), scr, r, lane); continue; } r -= I_G;
        p0_transpose_item<0>(p.wd, DM, DFF, DM, nullptr, (bf16*)(ws + WS_WD), scr, r, lane);
    }
    __syncthreads();
    LAS f32x4* wl = (LAS f32x4*)lds;
    for (int i = tid; i < 2048; i += NTHR) { const int ln = i & 63, q = i >> 6, half = q & 1, e = (q >> 1) & 3, j = q >> 3;
        wl[i] = *(const f32x4*)(p.win + (size_t)(4 * ln + 256 * j + e) * DIN + NZ + 4 * half); }
    __syncthreads();
    f32x4 gm[4];
#pragma unroll
    for (int j = 0; j < 4; ++j) gm[j] = *(const f32x4*)(p.gmix + 4 * lane + 256 * j);
    bf16* XN = (bf16*)(ws + WS_XN);
    constexpr int NQUAD = MTOK / 4;
#ifndef REP_P0R
#define REP_P0R 1
#endif
    for (int repr_ = 0; repr_ < REP_P0R; ++repr_)
    for (int qd = gw; qd < NQUAD; qd += NGW) {
        const int m0 = 4 * qd; const float* xr = (m0 < MP) ? p.xp + (size_t)m0 * DM : p.xs + (size_t)(m0 - MP) * DM;
        f32x4 v[4][4];
#pragma unroll
        for (int rr = 0; rr < 4; ++rr)
#pragma unroll
            for (int j = 0; j < 4; ++j) v[rr][j] = *(const f32x4*)(xr + (size_t)rr * DM + 4 * lane + 256 * j);
        asm volatile("" ::: "memory");
        float ss[4]; f32x4 a0[4], a1[4];
#pragma unroll
        for (int rr = 0; rr < 4; ++rr) { ss[rr] = 0.f; a0[rr] = (f32x4){0.f, 0.f, 0.f, 0.f}; a1[rr] = a0[rr]; }
#pragma unroll
        for (int j = 0; j < 4; ++j) {
#pragma unroll
            for (int rr = 0; rr < 4; ++rr) { ss[rr] += (v[rr][j][0] * v[rr][j][0] + v[rr][j][1] * v[rr][j][1]) + (v[rr][j][2] * v[rr][j][2] + v[rr][j][3] * v[rr][j][3]); v[rr][j] = v[rr][j] * gm[j]; }
#pragma unroll
            for (int e = 0; e < 4; ++e) { const f32x4 w0 = wl[((j * 4 + e) * 2) * 64 + lane], w1 = wl[((j * 4 + e) * 2 + 1) * 64 + lane];
#pragma unroll
                for (int rr = 0; rr < 4; ++rr) { a0[rr] += w0 * v[rr][j][e]; a1[rr] += w1 * v[rr][j][e]; } } }
        const int b5 = lane >> 5, b4 = (lane >> 4) & 1, b3 = (lane >> 3) & 1;
#pragma unroll
        for (int rr = 0; rr < 4; ++rr) {
            const float r = 1.0f / sqrtf(wave_sum(ss[rr]) * (1.0f / DM) + 1e-6f);
            float t4[4], t2[2];
#pragma unroll
            for (int i = 0; i < 4; ++i) { const float mine = b5 ? a1[rr][i] : a0[rr][i], send = b5 ? a0[rr][i] : a1[rr][i]; t4[i] = mine + __shfl_xor(send, 32); }
#pragma unroll
            for (int i = 0; i < 2; ++i) { const float mine = b4 ? t4[2 + i] : t4[i], send = b4 ? t4[i] : t4[2 + i]; t2[i] = mine + __shfl_xor(send, 16); }
            float t1; { const float mine = b3 ? t2[1] : t2[0], send = b3 ? t2[0] : t2[1]; t1 = mine + __shfl_xor(send, 8); }
            t1 += __shfl_xor(t1, 4); t1 += __shfl_xor(t1, 2); t1 += __shfl_xor(t1, 1);
            const int m = m0 + rr;
#pragma unroll
            for (int j = 0; j < 4; ++j) { u32x2 w; const f32x4 xa = v[rr][j] * r; w.x = pk2(xa[0], xa[1]); w.y = pk2(xa[2], xa[3]); *(u32x2*)(XN + (size_t)m * DM + 4 * lane + 256 * j) = w; }
            if ((lane & 7) == 0) { const int idx = lane >> 3; const float t = t1 * r + p.bfg[idx]; const float lf = fminf(t, 0.f) - log1pf(expf(-fabsf(t)));
                float* o = (m < MP) ? p.out + O_LFP + (size_t)m * 8 : p.out + O_LFS + (size_t)(m - MP) * 8; o[idx] = lf; }
        }
    }
}
__device__ __forceinline__ void p1_cumsum(const Params& p, LAS unsigned char* lds) {
    const int tid = tid_fresh(), lane = tid & 63, wid = __builtin_amdgcn_readfirstlane(tid >> 6);
    const int bh = blockIdx.x; if (bh >= NB * 8) return;
    const int b = bh >> 3, h = bh & 7; const float* lf = p.out + O_LFP + (size_t)b * TSEQ * 8 + h;
    float c[4]; float run = 0.f;
#pragma unroll
    for (int e = 0; e < 4; ++e) { run += lf[(size_t)(4 * tid + e) * 8]; c[e] = run; }
    float tot; const float inc = block_scan(run, tot, (LAS float*)lds, lane, wid); const float exc = inc - run;
    float* cb = (float*)(p.ws + WS_CB) + (size_t)bh * TSEQ + 4 * tid;
    *(f32x4*)cb = (f32x4){exc + c[0], exc + c[1], exc + c[2], exc + c[3]};
}
__device__ __forceinline__ void p6_final(const Params& p, int vcu, int G) {
    const int tid = tid_fresh(), lane = tid & 63, wid = __builtin_amdgcn_readfirstlane(tid >> 6);
    f32x4 gf[4];
#pragma unroll
    for (int j = 0; j < 4; ++j) gf[j] = *(const f32x4*)(p.gfin + 4 * lane + 256 * j);
    for (int m = 2 * (vcu * NWAVES + wid); m < MTOK; m += 2 * G * NWAVES) { float* y = p.out + O_Y + (size_t)m * DM + 4 * lane;
        f32x4 v[2][4]; float s0 = 0.f, s1 = 0.f;
#pragma unroll
        for (int j = 0; j < 4; ++j) { v[0][j] = *(const f32x4*)(y + 256 * j); v[1][j] = *(const f32x4*)(y + DM + 256 * j); }
#pragma unroll
        for (int j = 0; j < 4; ++j) { s0 += (v[0][j][0] * v[0][j][0] + v[0][j][1] * v[0][j][1]) + (v[0][j][2] * v[0][j][2] + v[0][j][3] * v[0][j][3]);
            s1 += (v[1][j][0] * v[1][j][0] + v[1][j][1] * v[1][j][1]) + (v[1][j][2] * v[1][j][2] + v[1][j][3] * v[1][j][3]); }
        const float r0 = 1.0f / sqrtf(wave_sum(s0) * (1.0f / DM) + 1e-6f), r1 = 1.0f / sqrtf(wave_sum(s1) * (1.0f / DM) + 1e-6f);
#pragma unroll
        for (int j = 0; j < 4; ++j) { __builtin_nontemporal_store(v[0][j] * r0 * gf[j], (f32x4*)(y + 256 * j)); __builtin_nontemporal_store(v[1][j] * r1 * gf[j], (f32x4*)(y + DM + 256 * j)); } }
}
#define XB_TMO      128
#define XB_XCNT(j)  (256  + 64 * (j))
#define XB_XSUB(j)  (1280 + 64 * (j))
#define XB_XGEN(j)  (2304 + 64 * (j))
#define XB_TOP      3328
#define XB_TOPGEN   3392
#define XCD_BAR_WORDS 3456
#define XB_SPIN_CAP (1u << 18)

__device__ __forceinline__ unsigned xb_ld(unsigned* p)              { return __hip_atomic_load(p, __ATOMIC_RELAXED, __HIP_MEMORY_SCOPE_AGENT); }
__device__ __forceinline__ unsigned xb_add(unsigned* p, unsigned v) { return __hip_atomic_fetch_add(p, v, __ATOMIC_RELAXED, __HIP_MEMORY_SCOPE_AGENT); }
__device__ __forceinline__ unsigned xb_xcc_id() { return (unsigned)__builtin_amdgcn_s_getreg((3 << 11) | 20) & 0xFu; }
#define XB_SPIN(cond, bar) do { unsigned _sp = 0; while (cond) { __builtin_amdgcn_s_sleep(1); \
    if ((++_sp & 255u) == 0u) { if (xb_ld(&(bar)[XB_TMO])) break; if (_sp > XB_SPIN_CAP) { atomicAdd(&(bar)[XB_TMO], 1u); break; } } } } while (0)

struct XcdBarrier {
    unsigned* bar; unsigned x;
    volatile LAS unsigned* st;
};

__device__ __forceinline__ XcdBarrier xcd_barrier_post(unsigned* bar, volatile LAS unsigned* st) {
    XcdBarrier b; b.bar = bar; b.x = xb_xcc_id(); b.st = st;
    if (threadIdx.x == 0) (void)xb_add(&bar[XB_XCNT(b.x)], 1u);
    return b;
}
__device__ __forceinline__ void xcd_barrier_complete(unsigned* bar, unsigned x, unsigned& nloc, unsigned& nx) {
    const unsigned G = gridDim.x * gridDim.y * gridDim.z;
    unsigned sum, cnt, mine, sp = 0u;
    for (;;) {
        sum = 0u; cnt = 0u; mine = 0u;
#pragma unroll
        for (unsigned j = 0; j < 16; ++j) { const unsigned c = xb_ld(&bar[XB_XCNT(j)]); sum += c; cnt += (c > 0u) ? 1u : 0u; mine = (j == x) ? c : mine; }
        if (sum == G) break;
        __builtin_amdgcn_s_sleep(1);
        if ((++sp & 255u) == 0u) { if (xb_ld(&bar[XB_TMO])) break; if (sp > XB_SPIN_CAP) { atomicAdd(&bar[XB_TMO], 1u); break; } }
    }
    nloc = mine > 0u ? mine : 1u; nx = cnt > 0u ? cnt : 1u;
}

__device__ __forceinline__ void xcd_barrier(const XcdBarrier& b) {
    asm volatile("s_waitcnt vmcnt(0)" ::: "memory");
    __syncthreads();
    if (threadIdx.x == 0) {
        unsigned* bar = b.bar;
        __builtin_amdgcn_s_waitcnt(0);
        unsigned nloc = b.st[0], nx = b.st[1];
        if (nloc == 0u) { xcd_barrier_complete(bar, b.x, nloc, nx); b.st[0] = nloc; b.st[1] = nx; }
        const unsigned old = xb_add(&bar[XB_XSUB(b.x)], 1u);
        const unsigned gen = old / nloc;
        if (old + 1u == (gen + 1u) * nloc) {
            __builtin_amdgcn_fence(__ATOMIC_RELEASE, "agent");
            asm volatile("s_waitcnt vmcnt(0)" ::: "memory");
            const unsigned og = xb_add(&bar[XB_TOP], 1u);
            const unsigned tg = og / nx;
            if (og + 1u == (tg + 1u) * nx) xb_add(&bar[XB_TOPGEN], 1u);
            else XB_SPIN(xb_ld(&bar[XB_TOPGEN]) == tg, bar);
            __builtin_amdgcn_fence(__ATOMIC_ACQUIRE, "agent");
            xb_add(&bar[XB_XGEN(b.x)], 1u);
            asm volatile("s_waitcnt vmcnt(0)" ::: "memory");
        } else {
            XB_SPIN(xb_ld(&bar[XB_XGEN(b.x)]) == gen, bar);
            __builtin_amdgcn_fence(__ATOMIC_ACQUIRE, "agent");
            asm volatile("s_waitcnt vmcnt(0)" ::: "memory");
        }
    }
    __syncthreads();
}
#ifndef RJ_SKIP
#define RJ_SKIP 0
#endif
#define MFMA32(a, b, c) __builtin_amdgcn_mfma_f32_32x32x16_bf16((a), (b), (c), 0, 0, 0)
__device__ __forceinline__ void ret_job(LAS unsigned char* lds, const Params& p_, const bool sample, const int b, const int h) {
    const Params p = fresh_params(p_);
    const int tid = tid_fresh(), lane = tid & 63, wid = __builtin_amdgcn_readfirstlane(tid >> 6), r32 = lane & 31, hi = lane >> 5;
    constexpr int PQK = 272, PT = 144;
    LAS unsigned char* Qr = lds; LAS unsigned char* Kr = lds + 17408; LAS unsigned char* Kdt = lds + 34816; LAS unsigned char* Vt = lds + 53248;
    LAS unsigned char* St = lds + 71680; LAS unsigned char* Am = lds + 106496; LAS f32x2* stats = (LAS f32x2*)(lds + 115712);
    const float lg2 = h == 0 ? -0.045803689613124746f : h == 1 ? -0.022720076500083907f : h == 2 ? -0.011315313227834146f : -0.005646563141142062f;
    const float cdec = __builtin_amdgcn_exp2f(lg2 * 64.0f);
    const int nch = sample ? 1 : TSEQ / 64; const size_t row0 = sample ? (size_t)MP + b * NSMP : (size_t)b * TSEQ;
    const bf16* Z = (const bf16*)(p.ws + WS_Z); bf16* MIX = (bf16*)(p.ws + WS_MIX);
    const int dkb = wid & 3, dvh = wid >> 2;
    f32x16 S0, S1;
    if (sample) { const float* sp = p.sr + (size_t)(b * 4 + h) * 16384 + 64 * dvh + r32;
#pragma unroll
        for (int r = 0; r < 16; ++r) { const int dk = 32 * dkb + crow(r, hi); S0[r] = sp[dk * 128]; S1[r] = sp[dk * 128 + 32]; } }
    else {
#pragma unroll
        for (int r = 0; r < 16; ++r) { S0[r] = 0.f; S1[r] = 0.f; } }
    u32x4 pq0, pq1, pk0, pk1, pv0, pv1; u32x2 pg[4];
#define RJ_LOAD(c_) do { const bf16* zr = Z + (row0 + (size_t)(c_) * 64 + 2 * (tid & 31)) * NZ + h * 128 + (tid >> 5) * 8; \
        pq0 = *(const u32x4*)zr; pq1 = *(const u32x4*)(zr + NZ); pk0 = *(const u32x4*)(zr + 512); pk1 = *(const u32x4*)(zr + NZ + 512); pv0 = *(const u32x4*)(zr + 1024); pv1 = *(const u32x4*)(zr + NZ + 1024); } while (0)
    RJ_LOAD(0);
    f32x4 gnv[4];
#pragma unroll
    for (int g = 0; g < 4; ++g) gnv[g] = *(const f32x4*)(p.gn + h * 128 + 32 * (wid >> 1) + 8 * g + 4 * hi);
    for (int c = 0; c < nch; ++c) {
        const size_t r0 = row0 + (size_t)c * 64;
#if !(RJ_SKIP & 1)
        { const int jp = tid & 31, ch = tid >> 5;
            *(LAS u32x4*)(Qr + (2 * jp) * PQK + ch * 16) = pq0; *(LAS u32x4*)(Qr + (2 * jp + 1) * PQK + ch * 16) = pq1;
            *(LAS u32x4*)(Kr + (2 * jp) * PQK + ch * 16) = pk0; *(LAS u32x4*)(Kr + (2 * jp + 1) * PQK + ch * 16) = pk1;
            const float kd0 = __builtin_amdgcn_exp2f(lg2 * (float)(63 - 2 * jp)), kd1 = __builtin_amdgcn_exp2f(lg2 * (float)(62 - 2 * jp));
#pragma unroll
            for (int e = 0; e < 8; ++e) { const unsigned a0 = pk0[e >> 1], a1 = pk1[e >> 1], b0 = pv0[e >> 1], b1 = pv1[e >> 1];
                const float f0 = (e & 1) ? __uint_as_float(a0 & 0xffff0000u) : __uint_as_float(a0 << 16), f1 = (e & 1) ? __uint_as_float(a1 & 0xffff0000u) : __uint_as_float(a1 << 16);
                *(LAS unsigned*)(Kdt + (ch * 8 + e) * PT + jp * 4) = pk2(f0 * kd0, f1 * kd1);
                *(LAS unsigned*)(Vt + (ch * 8 + e) * PT + jp * 4) = (e & 1) ? ((b0 >> 16) | (b1 & 0xffff0000u)) : ((b0 & 0xffffu) | (b1 << 16)); } }
#pragma unroll
        for (int g = 0; g < 4; ++g) { const int dk0 = 32 * dkb + 8 * g + 4 * hi;
            u32x2 w0, w1; w0.x = pk2(S0[4 * g], S0[4 * g + 1]); w0.y = pk2(S0[4 * g + 2], S0[4 * g + 3]); w1.x = pk2(S1[4 * g], S1[4 * g + 1]); w1.y = pk2(S1[4 * g + 2], S1[4 * g + 3]);
            *(LAS u32x2*)(St + (64 * dvh + r32) * PQK + dk0 * 2) = w0; *(LAS u32x2*)(St + (64 * dvh + 32 + r32) * PQK + dk0 * 2) = w1; }
        if (c + 1 < nch) RJ_LOAD(c + 1);
        { const bf16* grow = Z + (r0 + 32 * (wid & 1) + r32) * NZ + 1536 + h * 128 + 32 * (wid >> 1) + 4 * hi;
#pragma unroll
          for (int g = 0; g < 4; ++g) pg[g] = *(const u32x2*)(grow + 8 * g); }
#endif
        __syncthreads();
#if !(RJ_SKIP & 2)
        if (wid < 4) { const int jb = wid >> 1, ib = wid & 1; f32x16 a;
#pragma unroll
            for (int r = 0; r < 16; ++r) a[r] = 0.f;
#pragma unroll 2
            for (int ks = 0; ks < 8; ++ks) { const bf16x8 kf = *(const LAS bf16x8*)(Kr + (32 * jb + r32) * PQK + (16 * ks + 8 * hi) * 2), qf = *(const LAS bf16x8*)(Qr + (32 * ib + r32) * PQK + (16 * ks + 8 * hi) * 2);
                a = MFMA32(kf, qf, a); }
            const int i = 32 * ib + r32;
#pragma unroll
            for (int g = 0; g < 4; ++g) { const int j0 = 32 * jb + 8 * g + 4 * hi; float t[4];
#pragma unroll
                for (int e = 0; e < 4; ++e) t[e] = a[4 * g + e] * __builtin_amdgcn_exp2f(lg2 * fabsf((float)(i - (j0 + e))));
                u32x2 w; w.x = pk2(t[0], t[1]); w.y = pk2(t[2], t[3]); *(LAS u32x2*)(Am + i * PT + j0 * 2) = w; } }
#endif
        __syncthreads();
#if !(RJ_SKIP & 4)
        { const int dvb = wid >> 1, ib = wid & 1; f32x16 oi, ox;
#pragma unroll
            for (int r = 0; r < 16; ++r) { oi[r] = 0.f; ox[r] = 0.f; }
#pragma unroll
            for (int ks = 0; ks < 4; ++ks) { const bf16x8 vf = *(const LAS bf16x8*)(Vt + (32 * dvb + r32) * PT + (16 * ks + 8 * hi) * 2), af = *(const LAS bf16x8*)(Am + (32 * ib + r32) * PT + (16 * ks + 8 * hi) * 2);
                oi = MFMA32(vf, af, oi); }
#pragma unroll 2
            for (int ks = 0; ks < 8; ++ks) { const bf16x8 sf = *(const LAS bf16x8*)(St + (32 * dvb + r32) * PQK + (16 * ks + 8 * hi) * 2), qf = *(const LAS bf16x8*)(Qr + (32 * ib + r32) * PQK + (16 * ks + 8 * hi) * 2);
                ox = MFMA32(sf, qf, ox); }
            const int i = 32 * ib + r32; const float qd = __builtin_amdgcn_exp2f(lg2 * (float)(i + 1)); float s1 = 0.f, s2 = 0.f;
#pragma unroll
            for (int r = 0; r < 16; ++r) { oi[r] += ox[r] * qd; s1 += oi[r]; s2 += oi[r] * oi[r]; }
            s1 += __shfl_xor(s1, 32); s2 += __shfl_xor(s2, 32);
            if (hi == 0) stats[i * 4 + dvb] = (f32x2){s1, s2};
            __syncthreads();
            float m1 = 0.f, m2 = 0.f;
#pragma unroll
            for (int t = 0; t < 4; ++t) { const f32x2 st = stats[i * 4 + t]; m1 += st.x; m2 += st.y; }
            const float mu = m1 * (1.0f / 128.0f), var = fmaxf(m2 * (1.0f / 128.0f) - mu * mu, 0.f), rstd = 1.0f / sqrtf(var + 1e-5f);
            bf16* mrow = MIX + (r0 + i) * DM + h * 128;
#pragma unroll
            for (int g = 0; g < 4; ++g) { const int dv0 = 32 * dvb + 8 * g + 4 * hi; const u32x2 gw = pg[g]; const f32x4 gn = gnv[g];
                const float g0 = bf2f(gw.x & 0xffffu), g1 = bf2f(gw.x >> 16), g2 = bf2f(gw.y & 0xffffu), g3 = bf2f(gw.y >> 16);
                const float y0 = (oi[4 * g] - mu) * rstd * gn[0] * pg8::silu_f(g0), y1 = (oi[4 * g + 1] - mu) * rstd * gn[1] * pg8::silu_f(g1);
                const float y2 = (oi[4 * g + 2] - mu) * rstd * gn[2] * pg8::silu_f(g2), y3 = (oi[4 * g + 3] - mu) * rstd * gn[3] * pg8::silu_f(g3);
                u32x2 w; w.x = pk2(y0, y1); w.y = pk2(y2, y3); *(u32x2*)(mrow + dv0) = w; } }
#endif
#if !(RJ_SKIP & 8)
#pragma unroll
        for (int r = 0; r < 16; ++r) { S0[r] *= cdec; S1[r] *= cdec; }
#pragma unroll
        for (int ks = 0; ks < 4; ++ks) { const bf16x8 kdf = *(const LAS bf16x8*)(Kdt + (32 * dkb + r32) * PT + (16 * ks + 8 * hi) * 2);
            const bf16x8 v0 = *(const LAS bf16x8*)(Vt + (64 * dvh + r32) * PT + (16 * ks + 8 * hi) * 2), v1 = *(const LAS bf16x8*)(Vt + (64 * dvh + 32 + r32) * PT + (16 * ks + 8 * hi) * 2);
            S0 = MFMA32(kdf, v0, S0); S1 = MFMA32(kdf, v1, S1); }
#endif
        __syncthreads();
    }
#undef RJ_LOAD
    { float* so = p.out + (sample ? O_SRS : O_SRP) + (size_t)(b * 4 + h) * 16384 + 64 * dvh + r32;
#pragma unroll
        for (int r = 0; r < 16; ++r) { const int dk = 32 * dkb + crow(r, hi); so[dk * 128] = S0[r]; so[dk * 128 + 32] = S1[r]; } }
}

constexpr size_t WS_PART = WS_END + 6 * MiB;
constexpr int PART_STRIDE = 4224;
__device__ __forceinline__ void fs_chunk_job(LAS unsigned char* lds, const Params& p_, const int b, const int c) {
    const Params p = fresh_params(p_);
    const int tid = tid_fresh(), lane = tid & 63, wid = __builtin_amdgcn_readfirstlane(tid >> 6), r32 = lane & 31, hi = lane >> 5;
    const int h = wid;
    LAS float* ab = (LAS float*)(lds + wid * 1280);
    LAS float* red = (LAS float*)(lds + 10240);
    LAS unsigned char* vtw = lds + 12288 + wid * 5120;
    { const float* clf = p.clf + (size_t)b * PAST * 8; float acc = 0.f;
      for (int j = 256 * (c + 1) + (tid >> 3); j < PAST; j += 64) acc += clf[(size_t)j * 8 + (tid & 7)];
      acc += __shfl_xor(acc, 8); acc += __shfl_xor(acc, 16); acc += __shfl_xor(acc, 32);
      if (lane < 8) red[wid * 8 + lane] = acc;
      __syncthreads();
      float Sh = 0.f;
#pragma unroll
      for (int w = 0; w < NWAVES; ++w) Sh += red[w * 8 + h];
      float v[4]; float tt = 0.f;
#pragma unroll
      for (int e = 0; e < 4; ++e) { v[e] = clf[(size_t)(256 * c + 4 * lane + e) * 8 + h]; tt += v[e]; }
      float inc = tt;
#pragma unroll
      for (int o = 1; o < 64; o <<= 1) { const float n = __shfl_up(inc, o); if (lane >= o) inc += n; }
      const float tot = __shfl(inc, 63); float suf = Sh + (tot - inc);
#pragma unroll
      for (int e = 3; e >= 0; --e) { ab[4 * lane + e] = suf * LOG2E; suf += v[e]; }
      if (c == 15) { float x = p.out[O_LFS + (size_t)(b * NSMP + lane) * 8 + h];
#pragma unroll
          for (int o = 1; o < 64; o <<= 1) { const float n = __shfl_up(x, o); if (lane >= o) x += n; }
          ab[256 + lane] = -x * LOG2E; } }
    const bf16* Zq = (const bf16*)(p.ws + WS_Z) + ((size_t)MP + b * NSMP) * NZ + 2048 + h * 64;
    bf16x8 qr[2][4];
#pragma unroll
    for (int qb = 0; qb < 2; ++qb)
#pragma unroll
        for (int d0 = 0; d0 < 4; ++d0) qr[qb][d0] = *(const bf16x8*)(Zq + (size_t)(32 * qb + r32) * NZ + 16 * d0 + 8 * hi);
    f32x16 o[2][2]; float mrun[2] = {-1e30f, -1e30f}, lrun[2] = {0.f, 0.f};
#pragma unroll
    for (int a = 0; a < 2; ++a)
#pragma unroll
        for (int cc = 0; cc < 2; ++cc)
#pragma unroll
            for (int r = 0; r < 16; ++r) o[a][cc][r] = 0.f;
    const size_t hoff = (size_t)h * 64;
    const float* ckb = p.ck + ((size_t)b * PAST + 256 * c) * 512 + hoff; const float* cvb = p.cv + ((size_t)b * PAST + 256 * c) * 512 + hoff;
    const float* nkb = p.out + O_FKS + (size_t)b * NSMP * 512 + hoff; const float* nvb = p.out + O_FVS + (size_t)b * NSMP * 512 + hoff;
    const int nstep = (c == 15) ? 10 : 8;
    f32x4 kraw[8], vraw[8];
#define FS_LOAD(s_) do { const int s__ = (s_); const float* kp = s__ < 8 ? ckb + (size_t)s__ * 32 * 512 : nkb + (size_t)(s__ - 8) * 32 * 512; \
        const float* vp = s__ < 8 ? cvb + (size_t)s__ * 32 * 512 : nvb + (size_t)(s__ - 8) * 32 * 512; \
        _Pragma("unroll") for (int d0 = 0; d0 < 4; ++d0) { kraw[2 * d0] = *(const f32x4*)(kp + r32 * 512 + 16 * d0 + 8 * hi); kraw[2 * d0 + 1] = *(const f32x4*)(kp + r32 * 512 + 16 * d0 + 8 * hi + 4); } \
        _Pragma("unroll") for (int i = 0; i < 4; ++i) { const int pr = 4 * i + (lane >> 4); vraw[2 * i] = *(const f32x4*)(vp + (2 * pr) * 512 + 4 * (lane & 15)); vraw[2 * i + 1] = *(const f32x4*)(vp + (2 * pr + 1) * 512 + 4 * (lane & 15)); } } while (0)
    FS_LOAD(0);
    for (int s = 0; s < nstep; ++s) {
        bf16x8 kf[4];
#pragma unroll
        for (int d0 = 0; d0 < 4; ++d0) { u32x4 w; w.x = pk2(kraw[2 * d0][0], kraw[2 * d0][1]); w.y = pk2(kraw[2 * d0][2], kraw[2 * d0][3]); w.z = pk2(kraw[2 * d0 + 1][0], kraw[2 * d0 + 1][1]); w.w = pk2(kraw[2 * d0 + 1][2], kraw[2 * d0 + 1][3]);
            kf[d0] = __builtin_bit_cast(bf16x8, w); }
#pragma unroll
        for (int i = 0; i < 4; ++i) { const int kap = 2 * (4 * i + (lane >> 4)); const int pos = (kap & ~12) | ((kap & 4) << 1) | ((kap & 8) >> 1);
#pragma unroll
            for (int e = 0; e < 4; ++e) *(LAS unsigned*)(vtw + (4 * (lane & 15) + e) * 80 + pos * 2) = pk2(vraw[2 * i][e], vraw[2 * i + 1][e]); }
        if (s + 1 < nstep) FS_LOAD(s + 1);
        f32x16 sc[2];
#pragma unroll
        for (int qb = 0; qb < 2; ++qb) {
#pragma unroll
            for (int r = 0; r < 16; ++r) sc[qb][r] = 0.f;
#pragma unroll
            for (int d0 = 0; d0 < 4; ++d0) sc[qb] = MFMA32(kf[d0], qr[qb][d0], sc[qb]); }
        const int key0 = 32 * s;
#pragma unroll
        for (int g = 0; g < 4; ++g) { const f32x4 bv = *(const LAS f32x4*)(ab + key0 + 8 * g + 4 * hi);
#pragma unroll
            for (int e = 0; e < 4; ++e) { sc[0][4 * g + e] += bv[e]; sc[1][4 * g + e] += bv[e]; } }
        if (s >= 8) {
#pragma unroll
            for (int qb = 0; qb < 2; ++qb)
#pragma unroll
                for (int r = 0; r < 16; ++r) { const int kn = key0 - 256 + crow(r, hi); if (kn > 32 * qb + r32) sc[qb][r] = -INFINITY; } }
        bf16x8 pf[2][2];
#pragma unroll
        for (int qb = 0; qb < 2; ++qb) { float rm = sc[qb][0];
#pragma unroll
            for (int r = 1; r < 16; ++r) rm = fmaxf(rm, sc[qb][r]);
            rm = fmaxf(rm, __shfl_xor(rm, 32));
            const float mn = fmaxf(mrun[qb], rm), alpha = __builtin_amdgcn_exp2f(mrun[qb] - mn); mrun[qb] = mn; float ps = 0.f;
#pragma unroll
            for (int r = 0; r < 16; ++r) { const float e_ = __builtin_amdgcn_exp2f(sc[qb][r] - mn); sc[qb][r] = e_; ps += e_; }
            lrun[qb] = lrun[qb] * alpha + ps;
#pragma unroll
            for (int r = 0; r < 16; ++r) { o[qb][0][r] *= alpha; o[qb][1][r] *= alpha; }
#pragma unroll
            for (int ks = 0; ks < 2; ++ks) { u32x4 w; w.x = pk2(sc[qb][8 * ks], sc[qb][8 * ks + 1]); w.y = pk2(sc[qb][8 * ks + 2], sc[qb][8 * ks + 3]); w.z = pk2(sc[qb][8 * ks + 4], sc[qb][8 * ks + 5]); w.w = pk2(sc[qb][8 * ks + 6], sc[qb][8 * ks + 7]);
                pf[qb][ks] = __builtin_bit_cast(bf16x8, w); } }
#pragma unroll
        for (int db = 0; db < 2; ++db)
#pragma unroll
            for (int ks = 0; ks < 2; ++ks) { const bf16x8 vf = *(const LAS bf16x8*)(vtw + (32 * db + r32) * 80 + (16 * ks + 8 * hi) * 2);
                o[0][db] = MFMA32(vf, pf[0][ks], o[0][db]); o[1][db] = MFMA32(vf, pf[1][ks], o[1][db]); }
    }
#undef FS_LOAD
    lrun[0] += __shfl_xor(lrun[0], 32); lrun[1] += __shfl_xor(lrun[1], 32);
    float* part = (float*)(p.ws + WS_PART) + (size_t)((b * 8 + h) * 16 + c) * PART_STRIDE;
#pragma unroll
    for (int qb = 0; qb < 2; ++qb) { const int q = 32 * qb + r32;
        if (hi == 0) { part[4096 + q] = mrun[qb]; part[4160 + q] = lrun[qb]; }
#pragma unroll
        for (int db = 0; db < 2; ++db)
#pragma unroll
            for (int g = 0; g < 4; ++g) *(f32x4*)(part + q * 64 + 32 * db + 8 * g + 4 * hi) = (f32x4){o[qb][db][4 * g], o[qb][db][4 * g + 1], o[qb][db][4 * g + 2], o[qb][db][4 * g + 3]}; }
}
__device__ __forceinline__ void fs_combine_job(const Params& p_, const int b, const int h) {
    const Params p = fresh_params(p_);
    const int tid = tid_fresh(), q = tid >> 3, dg = tid & 7;
    const float* part = (const float*)(p.ws + WS_PART) + (size_t)((b * 8 + h) * 16) * PART_STRIDE;
    float M = -3e38f;
#pragma unroll
    for (int c = 0; c < 16; ++c) M = fmaxf(M, part[(size_t)c * PART_STRIDE + 4096 + q]);
    float L = 0.f; f32x4 a0 = {0.f, 0.f, 0.f, 0.f}, a1 = a0;
#pragma unroll
    for (int c = 0; c < 16; ++c) { const float* pc = part + (size_t)c * PART_STRIDE; const float wg = __builtin_amdgcn_exp2f(pc[4096 + q] - M); L += wg * pc[4160 + q];
        a0 += *(const f32x4*)(pc + q * 64 + 8 * dg) * wg; a1 += *(const f32x4*)(pc + q * 64 + 8 * dg + 4) * wg; }
    const float inv = 1.0f / L; u32x4 w; w.x = pk2(a0[0] * inv, a0[1] * inv); w.y = pk2(a0[2] * inv, a0[3] * inv); w.z = pk2(a1[0] * inv, a1[1] * inv); w.w = pk2(a1[2] * inv, a1[3] * inv);
    *(u32x4*)((bf16*)(p.ws + WS_MIX) + ((size_t)MP + b * NSMP + q) * DM + 512 + h * 64 + 8 * dg) = w;
}
constexpr int NFP = NB * 8 * (TSEQ / 256);
constexpr int Q_FSC = NB * 16, Q_RETS = NB * 4, Q_RETP = NB * 4, Q_FSM = NB * 8, Q_P3S = 16, Q_FP1 = 300, Q_P4S = 4 * 22, Q_FP2 = 300, Q_P5S = 64;
constexpr int Q_FP3 = NFP - Q_FP1 - Q_FP2;
constexpr int NJOBS = Q_FSC + Q_RETS + Q_RETP + Q_FSM + Q_P3S + Q_FP1 + Q_P4S + Q_FP2 + Q_P5S + Q_FP3;
constexpr size_t WS_HS = WS_END;
constexpr size_t WS_END2 = WS_PART + (size_t)NB * 8 * 16 * PART_STRIDE * 4;
__device__ __forceinline__ void gate_wait(unsigned* c, unsigned target) {
    if (tid_fresh() == 0) { unsigned sp = 0; while (__hip_atomic_load(c, RLX_AGENT) < target && ++sp < (1u << 22)) __builtin_amdgcn_s_sleep(4);
        __builtin_amdgcn_fence(__ATOMIC_ACQUIRE, "agent"); asm volatile("s_waitcnt vmcnt(0)" ::: "memory"); }
    __syncthreads();
}
__device__ __forceinline__ void job_signal(unsigned* c) {
    asm volatile("s_waitcnt vmcnt(0)" ::: "memory");
    __syncthreads();
    if (tid_fresh() == 0) { __builtin_amdgcn_fence(__ATOMIC_RELEASE, "agent"); asm volatile("s_waitcnt vmcnt(0)" ::: "memory"); __hip_atomic_fetch_add(c, 1u, RLX_AGENT); }
}
__global__ void __launch_bounds__(NTHR, 2) hybrid_fwd(Params p) {
    extern __shared__ __attribute__((aligned(16))) unsigned char lds_raw[];
    LAS unsigned char* lds = (LAS unsigned char*)lds_raw;
    cg::grid_group grid = cg::this_grid();
    const int G = gridDim.x, bx = blockIdx.x, vcu = (G % 8 == 0) ? (bx % 8) * (G / 8) + bx / 8 : bx;
    unsigned char* ws = p.ws;
    volatile LAS unsigned* MISCU = (volatile LAS unsigned*)(lds + MISC_OFF);
    if (threadIdx.x < 32) MISCU[threadIdx.x] = 0u;
    __syncthreads();
    if (p.ws == nullptr) grid.sync();
    const XcdBarrier xbar = xcd_barrier_post((unsigned*)(ws + WS_CTL) + 4096, MISCU + 8);
    p0_prep(p, lds, vcu, G);
    xcd_barrier(xbar);
    p1_cumsum(p, lds);
    __syncthreads();
    { pg8::Gemm g{(const bf16*)(ws + WS_XN), (const bf16*)(ws + WS_WIN), MTOK, NZ, DM, DM}; pg8::StaticOrder S; S.init(MTOK, NZ, G, bx);
      pg8::EpiInProj E{(bf16*)(ws + WS_Z), p.out, (const float*)(ws + WS_CS)};
      pg8::gemm_phase<pg8::EpiInProj, pg8::StaticOrder, true, true>(lds, g, S, E); }
    xcd_barrier(xbar);
    { volatile LAS int* MISC = (volatile LAS int*)(lds + MISC_OFF);
      for (;;) {
          if (tid_fresh() == 0) MISC[0] = (int)atomicAdd((unsigned*)(ws + WS_CTL), 1u);
          __syncthreads();
          int job = __builtin_amdgcn_readfirstlane(MISC[0]);
          __syncthreads();
#ifndef DUP_KIND
#define DUP_KIND 0
#endif
          constexpr int NDUP = DUP_KIND == 1 ? 2560 : DUP_KIND == 2 ? 1024 : 0;
          if (job >= NJOBS + NDUP) break;
          if (job >= NJOBS) { const int d = job - NJOBS;
              if (DUP_KIND == 2) { const Params q = fresh_params(p); bf16* Z = (bf16*)(q.ws + WS_Z); attn_body::attn_unit<8>((d & 127) >> 3, d & 7, 7 - (d >> 7), (const attn_body::bf16*)(Z + 2048), (const attn_body::bf16*)(Z + 2560), (const attn_body::bf16*)(Z + 3072), (attn_body::bf16*)((bf16*)(q.ws + WS_MIX) + 512), (const float*)(q.ws + WS_CB), (char*)lds_raw); }
              __syncthreads(); continue; }
          const Params q = fresh_params(p);
          unsigned char* qws = q.ws; unsigned* cnt = (unsigned*)(qws + WS_CTL);
          bf16* Z = (bf16*)(qws + WS_Z); bf16* MIX = (bf16*)(qws + WS_MIX); bf16* XN = (bf16*)(qws + WS_XN);
          int fp = -1;
          if (job < Q_FSC) { fs_chunk_job(lds, p, job >> 4, job & 15); job_signal(cnt + 64 + 64 * (job >> 4)); }
          else if ((job -= Q_FSC) < Q_RETS) { ret_job(lds, p, true, job >> 2, job & 3); job_signal(cnt + 1216); }
          else if ((job -= Q_RETS) < Q_RETP) ret_job(lds, p, false, job >> 2, job & 3);
          else if ((job -= Q_RETP) < Q_FSM) { gate_wait(cnt + 64 + 64 * (job >> 3), 16); fs_combine_job(p, job >> 3, job & 7); job_signal(cnt + 1216); }
          else if ((job -= Q_FSM) < Q_P3S) { gate_wait(cnt + 1216, Q_RETS + Q_FSM);
              pg8::Gemm g{MIX, (const bf16*)(qws + WS_WO), MTOK, DM, DM, DM}; pg8::OneUnit S{MP / 256 + job / 4, job % 4};
              pg8::EpiResid E{q.xp, q.xs, q.out + O_Y, XN, (float*)(qws + WS_SS1), nullptr};
              pg8::gemm_phase<pg8::EpiResid, pg8::OneUnit, true, true>(lds, g, S, E); job_signal(cnt + 1280); }
          else if ((job -= Q_P3S) < Q_FP1) fp = job;
          else if ((job -= Q_FP1) < Q_P4S) { gate_wait(cnt + 1280, Q_P3S);
              pg8::Gemm g{XN, (const bf16*)(qws + WS_WGU), MTOK, NGU, DM, DM}; pg8::OneUnit S{MP / 256 + job / 22, job % 22};
              pg8::EpiGateUp E{(bf16*)(qws + WS_HS) - (size_t)MP * DFF, (const float*)(qws + WS_SS1)};
              pg8::gemm_phase<pg8::EpiGateUp, pg8::OneUnit, true, true>(lds, g, S, E); job_signal(cnt + 1344); }
          else if ((job -= Q_P4S) < Q_FP2) fp = Q_FP1 + job;
          else if ((job -= Q_FP2) < Q_P5S) { gate_wait(cnt + 1344, Q_P4S);
              const int kq = job & 3, un = job >> 2, koff = (kq == 0 ? 0 : kq == 1 ? 768 : kq == 2 ? 1408 : 2176), klen = (kq & 1) ? 640 : 768;
              pg8::Gemm g{(const bf16*)(qws + WS_HS) - (size_t)MP * DFF + koff, (const bf16*)(qws + WS_WD) + koff, MTOK, DM, klen, DFF}; pg8::OneUnit S{MP / 256 + un / 4, un % 4};
              pg8::EpiAtomic E{q.out + O_Y};
              pg8::gemm_phase<pg8::EpiAtomic, pg8::OneUnit, true, true>(lds, g, S, E); }
          else fp = Q_FP1 + Q_FP2 + (job - Q_P5S);
          if (fp >= 0) { const int qb = (TSEQ / 256 - 1) - (fp >> 7), bh = fp & 127;
              attn_body::attn_unit<16>(bh >> 3, bh & 7, qb, (const attn_body::bf16*)(Z + 2048), (const attn_body::bf16*)(Z + 2560), (const attn_body::bf16*)(Z + 3072),
                                      (attn_body::bf16*)(MIX + 512), (const float*)(qws + WS_CB), (char*)lds_raw); }
          __syncthreads();
      } }
    xcd_barrier(xbar);
#ifndef REP_G
#define REP_G 1
#endif
    { pg8::Gemm g{(const bf16*)(ws + WS_MIX), (const bf16*)(ws + WS_WO), MP, DM, DM, DM}; pg8::StaticOrder S; S.init(MP, DM, G, bx);
      pg8::EpiResid E{p.xp, p.xs, nullptr, (bf16*)(ws + WS_XN), (float*)(ws + WS_SS1), nullptr};
      pg8::gemm_phase<pg8::EpiResid, pg8::StaticOrder, true, true>(lds, g, S, E);
    xcd_barrier(xbar); }
    { pg8::Gemm g{(const bf16*)(ws + WS_XN), (const bf16*)(ws + WS_WGU), MP, NGU, DM, DM}; pg8::StaticOrder S; S.init(MP, NGU, G, bx);
      pg8::EpiGateUp E{(bf16*)(ws + WS_H), (const float*)(ws + WS_SS1)};
      pg8::gemm_phase<pg8::EpiGateUp, pg8::StaticOrder, true, true>(lds, g, S, E);
    xcd_barrier(xbar); }
    { pg8::Gemm g{(const bf16*)(ws + WS_H), (const bf16*)(ws + WS_WD), MP, DM, DFF, DFF}; pg8::StaticOrder S; S.init(MP, DM, G, bx);
      pg8::EpiResid E{nullptr, nullptr, p.out + O_Y, nullptr, nullptr, (const bf16*)(ws + WS_XN)};
      pg8::gemm_phase<pg8::EpiResid, pg8::StaticOrder, true, true>(lds, g, S, E);
    xcd_barrier(xbar); }
    p6_final(p, vcu, G);
}

extern "C" void kernel_launch(void* const* d_in, const int* in_sizes, int n_in, void* d_out, int out_size, void* d_ws, size_t ws_size, hipStream_t stream) {
    static int grid = 0;
    if (grid == 0) {
        if (n_in != 16 || out_size != (int)O_END || ws_size < WS_END2) { fprintf(stderr, "kernel_launch: unexpected shapes (n_in %d, out %d, ws %zu); nothing launched\n", n_in, out_size, ws_size); grid = -1; return; }
        int dev = 0, cus = 0, per_cu = 0;
        if (hipGetDevice(&dev) != hipSuccess || hipDeviceGetAttribute(&cus, hipDeviceAttributeMultiprocessorCount, dev) != hipSuccess) { grid = -1; return; }
        if (hipFuncSetAttribute((const void*)hybrid_fwd, hipFuncAttributeMaxDynamicSharedMemorySize, LDS_BYTES) != hipSuccess) { fprintf(stderr, "kernel_launch: hipFuncSetAttribute failed\n"); grid = -1; return; }
        if (hipOccupancyMaxActiveBlocksPerMultiprocessor(&per_cu, (const void*)hybrid_fwd, NTHR, LDS_BYTES) != hipSuccess || per_cu < 1) { fprintf(stderr, "kernel_launch: occupancy query says %d blocks per CU\n", per_cu); per_cu = 1; }
        (void)hipGetLastError();
        grid = cus * per_cu;
    }
    if (grid < 0) return;
    Params p{};
    p.xp = (const float*)d_in[0]; p.xs = (const float*)d_in[1]; p.ck = (const float*)d_in[2]; p.cv = (const float*)d_in[3]; p.clf = (const float*)d_in[4]; p.sr = (const float*)d_in[5];
    p.win = (const float*)d_in[6]; p.bfg = (const float*)d_in[7]; p.gn = (const float*)d_in[8]; p.wout = (const float*)d_in[9]; p.gmix = (const float*)d_in[10]; p.gffn = (const float*)d_in[11];
    p.wg = (const float*)d_in[12]; p.wu = (const float*)d_in[13]; p.wd = (const float*)d_in[14]; p.gfin = (const float*)d_in[15];
    p.out = (float*)d_out; p.ws = (unsigned char*)d_ws;
    void* args[] = {&p};
    (void)hipMemsetAsync((char*)d_ws + WS_CTL + 4096 * 4, 0, XCD_BAR_WORDS * 4, stream);
    const hipError_t e = hipLaunchCooperativeKernel((const void*)hybrid_fwd, dim3(grid), dim3(NTHR), args, LDS_BYTES, stream);
    if (e != hipSuccess) fprintf(stderr, "kernel_launch: cooperative launch failed: %s (grid %d)\n", hipGetErrorString(e), grid);
}
```
